# Optimizing an MI355X kernel written in HIP

```python
import math
import jax, jax.numpy as jnp
from jax import lax
import numpy as np

D_MODEL = 1024
BATCH = 4
SEQ = 4096
DEPTH = 2
DEC_BATCH = 8
DEC_SEQ = 4096
PAST_LEN = 128

ROPE_THETA = 10000.0
EPS = 1e-6
NEG_INF = -1e30
QBLK = 128
N_BRANCH = 4

A_HEADS = 4
A_HD = 64
A_QK_W = A_HEADS * 2 * A_HD
A_V_W = A_HEADS * 2 * A_HD
A_OUT = A_V_W
B_PATTERNS = ((128, 1), (512, 4), (2048, 16))
B_HEADS = 4
B_HD = 64
B_BLK = 64
B_W = B_HEADS * B_HD
B_OUT = B_W
C_HEADS = 8
C_Q_RANK = 256
C_KV_RANK = 128
C_NOPE = 64
C_ROPE = 32
C_VD = 64
C_OUT = C_HEADS * C_VD
D_QHEADS = 8
D_KVHEADS = 2
D_HD = 64
D_WIN = 128
D_BLK = 128
D_Q_W = D_QHEADS * D_HD
D_KV_W = D_KVHEADS * D_HD
D_OUT = D_Q_W
D_FF = -(-8 * D_MODEL // (3 * 256)) * 256

IN_SIZES = (A_QK_W, A_QK_W, A_V_W) + (B_W,) * (3 * len(B_PATTERNS)) + (C_Q_RANK, C_KV_RANK, C_ROPE, D_Q_W, D_KV_W, D_KV_W)
N_IN = sum(IN_SIZES)
SPLIT_IDX = tuple(int(i) for i in np.cumsum(IN_SIZES)[:-1])

kernel_name = "hybrid_gated_encoder_4mixer"


def lambda_init(layer):
    return 0.8 - 0.6 * math.exp(-0.3 * layer)


def rms_norm(x, g):
    xf = x.astype(jnp.float32)
    y = xf * lax.rsqrt(jnp.mean(xf * xf, axis=-1, keepdims=True) + EPS)
    return (y * g.astype(jnp.float32)).astype(x.dtype)


def rope(x, pos):
    half = x.shape[-1] // 2
    inv = jnp.power(ROPE_THETA, -jnp.arange(half, dtype=jnp.float32) / half)
    ang = pos.astype(jnp.float32)[:, None] * inv[None, :]
    cos = jnp.cos(ang)[None, :, None, :]
    sin = jnp.sin(ang)[None, :, None, :]
    xf = x.astype(jnp.float32)
    x1, x2 = xf[..., :half], xf[..., half:]
    return jnp.concatenate([x1 * cos - x2 * sin, x2 * cos + x1 * sin], axis=-1).astype(x.dtype)


def _qblocks(t):
    b, s = t.shape[:2]
    return jnp.moveaxis(t.reshape(b, s // QBLK, QBLK, *t.shape[2:]), 1, 0)


def _unblock(t):
    t = jnp.moveaxis(t, 0, 1)
    return t.reshape(t.shape[0], -1, *t.shape[3:])


def _to_residues(t, dil):
    b, s = t.shape[:2]
    return t.reshape(b, s // dil, dil, *t.shape[2:]).swapaxes(1, 2).reshape(b * dil, s // dil, *t.shape[2:])


def _from_residues(t, dil, b):
    n, m = t.shape[:2]
    return t.reshape(b, dil, m, *t.shape[2:]).swapaxes(1, 2).reshape(b, dil * m, *t.shape[2:])


def banded_attention(q, k, v, half_w, blk, sink=None):
    n, L, hq, d = q.shape
    hk = k.shape[2]
    rep = hq // hk
    nblk = -(-L // blk)
    lp = nblk * blk
    nb = -(-half_w // blk)
    kw_len = (2 * nb + 1) * blk
    q = jnp.pad(q, ((0, 0), (0, lp - L), (0, 0), (0, 0)))
    kv_pad = ((0, 0), (nb * blk, lp - L + nb * blk), (0, 0), (0, 0))
    kb = jnp.pad(k, kv_pad).reshape(n, nblk + 2 * nb, blk, hk, d)
    vb = jnp.pad(v, kv_pad).reshape(n, nblk + 2 * nb, blk, hk, d)
    kw = jnp.concatenate([kb[:, j:j + nblk] for j in range(2 * nb + 1)], axis=2)
    vw = jnp.concatenate([vb[:, j:j + nblk] for j in range(2 * nb + 1)], axis=2)
    qb = q.reshape(n, nblk, blk, hk, rep, d)
    s = jnp.einsum("nbqgrd,nbkgd->nbgrqk", qb, kw).astype(jnp.float32) * (d ** -0.5)
    qpos = jnp.arange(lp).reshape(nblk, blk)
    kpos = (jnp.arange(nblk)[:, None] - nb) * blk + jnp.arange(kw_len)[None, :]
    valid = (jnp.abs(qpos[:, :, None] - kpos[:, None, :]) <= half_w) & ((kpos >= 0) & (kpos < L))[:, None, :]
    s = jnp.where(valid[None, :, None, None], s, NEG_INF)
    m = jnp.max(s, axis=-1, keepdims=True)
    if sink is not None:
        sk = sink.astype(jnp.float32).reshape(1, 1, hk, rep, 1, 1)
        m = jnp.maximum(m, sk)
        e = jnp.exp(s - m)
        l = jnp.sum(e, axis=-1, keepdims=True) + jnp.exp(sk - m)
    else:
        e = jnp.exp(s - m)
        l = jnp.sum(e, axis=-1, keepdims=True)
    p = e / l
    o = jnp.einsum("nbgrqk,nbkgd->nbqgrd", p.astype(v.dtype), vw).reshape(n, lp, hq, d)[:, :L]
    lse = (m + jnp.log(l))[..., 0]
    lse = jnp.moveaxis(lse, 4, 2).reshape(n, lp, hq)[:, :L]
    return o, lse


def diff_attention(a_q, a_k, a_v, qn_g, kn_g, lam_p, subln_g, lam_init, pos):
    b, s, _ = a_q.shape
    q = rope(rms_norm(a_q.reshape(b, s, 2 * A_HEADS, A_HD), qn_g), pos).reshape(b, s, A_HEADS, 2, A_HD)
    k = rope(rms_norm(a_k.reshape(b, s, 2 * A_HEADS, A_HD), kn_g), pos).reshape(b, s, A_HEADS, 2, A_HD)
    v = a_v.reshape(b, s, A_HEADS, 2 * A_HD)
    lp = lam_p.astype(jnp.float32)
    lam = jnp.exp(jnp.sum(lp[0] * lp[1])) - jnp.exp(jnp.sum(lp[2] * lp[3])) + lam_init

    def block(qb):
        sc = jnp.einsum("bqhcd,bkhcd->bhcqk", qb, k).astype(jnp.float32) * (A_HD ** -0.5)
        p = jax.nn.softmax(sc, axis=-1)
        w = p[:, :, 0] - lam * p[:, :, 1]
        return jnp.einsum("bhqk,bkhe->bqhe", w.astype(v.dtype), v)

    o = _unblock(lax.map(block, _qblocks(q)))
    o = rms_norm(o, subln_g) * (1.0 - lam_init)
    return o.reshape(b, s, A_OUT)


def dilated_attention(cols, qn_g, kn_g, pos):
    b, s, _ = cols[0].shape
    outs, lses = [], []
    for g, (window, dil) in enumerate(B_PATTERNS):
        q, k, v = (c.reshape(b, s, B_HEADS, B_HD) for c in cols[3 * g:3 * g + 3])
        q = rope(rms_norm(q, qn_g[g]), pos)
        k = rope(rms_norm(k, kn_g[g]), pos)
        o, lse = banded_attention(_to_residues(q, dil), _to_residues(k, dil), _to_residues(v, dil),
                                  window // (2 * dil), B_BLK)
        outs.append(_from_residues(o, dil, b))
        lses.append(_from_residues(lse, dil, b))
    wts = jax.nn.softmax(jnp.stack(lses, axis=0), axis=0)
    out = jnp.einsum("gbsh,gbshd->bshd", wts, jnp.stack(outs, axis=0).astype(jnp.float32))
    return out.astype(cols[0].dtype).reshape(b, s, B_OUT)


def mla_attention(c_q, c_kv, k_rope, qa_g, kva_g, w_uq, w_ukv, qn_g, kn_g, pos):
    b, s, _ = c_q.shape
    q = (rms_norm(c_q, qa_g) @ w_uq).reshape(b, s, C_HEADS, C_NOPE + C_ROPE)
    kv = (rms_norm(c_kv, kva_g) @ w_ukv).reshape(b, s, C_HEADS, C_NOPE + C_VD)
    v = kv[..., C_NOPE:]
    k = jnp.concatenate([kv[..., :C_NOPE], jnp.broadcast_to(k_rope[:, :, None, :], (b, s, C_HEADS, C_ROPE))], axis=-1)
    q = rms_norm(q, qn_g)
    k = rms_norm(k, kn_g)
    q = jnp.concatenate([q[..., :C_NOPE], rope(q[..., C_NOPE:], pos)], axis=-1)
    k = jnp.concatenate([k[..., :C_NOPE], rope(k[..., C_NOPE:], pos)], axis=-1)
    scale = (C_NOPE + C_ROPE) ** -0.5

    def block(qb):
        sc = jnp.einsum("bqhd,bkhd->bhqk", qb, k).astype(jnp.float32) * scale
        p = jax.nn.softmax(sc, axis=-1)
        return jnp.einsum("bhqk,bkhe->bqhe", p.astype(v.dtype), v)

    o = _unblock(lax.map(block, _qblocks(q)))
    return o.reshape(b, s, C_OUT)


def window_gqa_sink(d_q, d_k, d_v, qn_g, kn_g, sink, pos):
    b, s, _ = d_q.shape
    q = rope(rms_norm(d_q.reshape(b, s, D_QHEADS, D_HD), qn_g), pos)
    k = rope(rms_norm(d_k.reshape(b, s, D_KVHEADS, D_HD), kn_g), pos)
    v = d_v.reshape(b, s, D_KVHEADS, D_HD)
    o, _ = banded_attention(q, k, v, D_WIN, D_BLK, sink)
    return o.reshape(b, s, D_OUT)


def encoder_layer(x, lam_init, norm1_g, w_in, w_gate, a_qnorm_g, a_knorm_g, a_lambda, a_subln_g,
                  b_qnorm_g, b_knorm_g, c_qa_norm_g, c_kva_norm_g, c_w_uq, c_w_ukv, c_qnorm_g, c_knorm_g,
                  d_qnorm_g, d_knorm_g, d_sink, w_br_a, w_br_b, w_br_c, w_br_d, w_o,
                  norm2_g, w_ffn_gate, w_ffn_up, w_ffn_down):
    b, s, _ = x.shape
    pos = jnp.arange(s)
    h = rms_norm(x, norm1_g)
    cols = jnp.split(h @ w_in, SPLIT_IDX, axis=-1)
    y_a = diff_attention(cols[0], cols[1], cols[2], a_qnorm_g, a_knorm_g, a_lambda, a_subln_g, lam_init, pos) @ w_br_a
    y_b = dilated_attention(cols[3:12], b_qnorm_g, b_knorm_g, pos) @ w_br_b
    y_c = mla_attention(cols[12], cols[13], cols[14], c_qa_norm_g, c_kva_norm_g, c_w_uq, c_w_ukv,
                        c_qnorm_g, c_knorm_g, pos) @ w_br_c
    y_d = window_gqa_sink(cols[15], cols[16], cols[17], d_qnorm_g, d_knorm_g, d_sink, pos) @ w_br_d
    gates = jax.nn.sigmoid((h @ w_gate).astype(jnp.float32)).reshape(b, s, N_BRANCH, D_MODEL)
    branches = jnp.stack([y_a, y_b, y_c, y_d], axis=2).astype(jnp.float32)
    merged = jnp.sum(gates * branches, axis=2).astype(x.dtype)
    x = x + merged @ w_o
    hf = rms_norm(x, norm2_g)
    x = x + (jax.nn.silu(hf @ w_ffn_gate) * (hf @ w_ffn_up)) @ w_ffn_down
    return x


def _trunk(x, params):
    for l in range(DEPTH):
        x = encoder_layer(x, lambda_init(l), *[p[l] for p in params])
    return x


def setup_inputs(seed: int = 0) -> dict:
    key = jax.random.key(seed)
    ks = iter(jax.random.split(key, 40))

    def nrm(shape, scale):
        return jax.random.normal(next(ks), shape, jnp.float32) * scale

    def gain(shape):
        return 1.0 + nrm(shape, 0.02)

    L = DEPTH
    return {
        "x_prompt": nrm((BATCH, SEQ, D_MODEL), 1.0),
        "x_sample": nrm((DEC_BATCH, DEC_SEQ, D_MODEL), 1.0),
        "norm1_g": gain((L, D_MODEL)),
        "w_in": nrm((L, D_MODEL, N_IN), D_MODEL ** -0.5),
        "w_gate": nrm((L, D_MODEL, N_BRANCH * D_MODEL), D_MODEL ** -0.5),
        "a_qnorm_g": gain((L, A_HD)),
        "a_knorm_g": gain((L, A_HD)),
        "a_lambda": nrm((L, 4, A_HD), 0.1),
        "a_subln_g": gain((L, 2 * A_HD)),
        "b_qnorm_g": gain((L, len(B_PATTERNS), B_HD)),
        "b_knorm_g": gain((L, len(B_PATTERNS), B_HD)),
        "c_qa_norm_g": gain((L, C_Q_RANK)),
        "c_kva_norm_g": gain((L, C_KV_RANK)),
        "c_w_uq": nrm((L, C_Q_RANK, C_HEADS * (C_NOPE + C_ROPE)), C_Q_RANK ** -0.5),
        "c_w_ukv": nrm((L, C_KV_RANK, C_HEADS * (C_NOPE + C_VD)), C_KV_RANK ** -0.5),
        "c_qnorm_g": gain((L, C_NOPE + C_ROPE)),
        "c_knorm_g": gain((L, C_NOPE + C_ROPE)),
        "d_qnorm_g": gain((L, D_HD)),
        "d_knorm_g": gain((L, D_HD)),
        "d_sink": nrm((L, D_QHEADS), 0.5),
        "w_br_a": nrm((L, A_OUT, D_MODEL), A_OUT ** -0.5),
        "w_br_b": nrm((L, B_OUT, D_MODEL), B_OUT ** -0.5),
        "w_br_c": nrm((L, C_OUT, D_MODEL), C_OUT ** -0.5),
        "w_br_d": nrm((L, D_OUT, D_MODEL), D_OUT ** -0.5),
        "w_o": nrm((L, D_MODEL, D_MODEL), D_MODEL ** -0.5),
        "norm2_g": gain((L, D_MODEL)),
        "w_ffn_gate": nrm((L, D_MODEL, D_FF), D_MODEL ** -0.5),
        "w_ffn_up": nrm((L, D_MODEL, D_FF), D_MODEL ** -0.5),
        "w_ffn_down": nrm((L, D_FF, D_MODEL), D_FF ** -0.5),
    }


def reference(x_prompt, x_sample, norm1_g, w_in, w_gate, a_qnorm_g, a_knorm_g, a_lambda, a_subln_g,
              b_qnorm_g, b_knorm_g, c_qa_norm_g, c_kva_norm_g, c_w_uq, c_w_ukv, c_qnorm_g, c_knorm_g,
              d_qnorm_g, d_knorm_g, d_sink, w_br_a, w_br_b, w_br_c, w_br_d, w_o,
              norm2_g, w_ffn_gate, w_ffn_up, w_ffn_down):
    params = (norm1_g, w_in, w_gate, a_qnorm_g, a_knorm_g, a_lambda, a_subln_g,
              b_qnorm_g, b_knorm_g, c_qa_norm_g, c_kva_norm_g, c_w_uq, c_w_ukv, c_qnorm_g, c_knorm_g,
              d_qnorm_g, d_knorm_g, d_sink, w_br_a, w_br_b, w_br_c, w_br_d, w_o,
              norm2_g, w_ffn_gate, w_ffn_up, w_ffn_down)
    y_prompt = _trunk(x_prompt, params)
    y_sample = _trunk(x_sample, params)
    return (y_prompt, y_sample)
```

```cpp
#include <hip/hip_runtime.h>
#include <hip/hip_cooperative_groups.h>
#include <cstdio>
#include <cmath>
namespace cg = cooperative_groups;

typedef unsigned short u16;
typedef short bf16x8 __attribute__((ext_vector_type(8)));
typedef short s16x4 __attribute__((ext_vector_type(4)));
typedef float f32x16 __attribute__((ext_vector_type(16)));
typedef float f32x4 __attribute__((ext_vector_type(4)));
typedef float f32x2 __attribute__((ext_vector_type(2)));
typedef unsigned u32x4 __attribute__((ext_vector_type(4)));
typedef unsigned u32x2 __attribute__((ext_vector_type(2)));
typedef __bf16 bf16x2_t __attribute__((ext_vector_type(2)));

#define DI __device__ __forceinline__
#define MFMA(a, b, c) __builtin_amdgcn_mfma_f32_32x32x16_bf16(a, b, c, 0, 0, 0)

constexpr int DM = 1024, SEQ = 4096, CT = 16384, NCH = 3, NINP = 5120, DFF = 2816, NGU = 5632;
constexpr int QKVC_LD = 2048, OUT_LD = 1792, DEPTH = 2;
constexpr float LOG2E = 1.4426950408889634f;
constexpr float QS64 = 0.125f * LOG2E, QS96 = 0.10206207261596575f * LOG2E;
constexpr float EPS = 1e-6f;
constexpr int PITCH = 144;
constexpr int WAVE_LDS = 17408;
constexpr size_t LDS_BYTES = 147456;

constexpr size_t al256(size_t x) { return (x + 255) / 256 * 256; }
constexpr size_t OFF_WIN = 0;
constexpr size_t OFF_WGATE = OFF_WIN + al256((size_t)DEPTH * NINP * 1024 * 2);
constexpr size_t OFF_WUQ = OFF_WGATE + al256((size_t)DEPTH * 4096 * 1024 * 2);
constexpr size_t OFF_WUKV = OFF_WUQ + al256((size_t)DEPTH * 768 * 256 * 2);
constexpr size_t OFF_WBR = OFF_WUKV + al256((size_t)DEPTH * 1024 * 128 * 2);
constexpr size_t OFF_WO = OFF_WBR + al256((size_t)DEPTH * 1024 * 1792 * 2);
constexpr size_t OFF_WGU = OFF_WO + al256((size_t)DEPTH * 1024 * 1024 * 2);
constexpr size_t OFF_WDN = OFF_WGU + al256((size_t)DEPTH * NGU * 1024 * 2);
constexpr size_t OFF_COS64 = OFF_WDN + al256((size_t)DEPTH * 1024 * DFF * 2);
constexpr size_t OFF_SIN64 = OFF_COS64 + (size_t)SEQ * 32 * 4;
constexpr size_t OFF_COS32 = OFF_SIN64 + (size_t)SEQ * 32 * 4;
constexpr size_t OFF_SIN32 = OFF_COS32 + (size_t)SEQ * 16 * 4;
constexpr size_t OFF_LAM = OFF_SIN32 + (size_t)SEQ * 16 * 4;
constexpr size_t OFF_XN = OFF_LAM + 256;
constexpr size_t OFF_QKV = OFF_XN + (size_t)CT * 1024 * 2;
constexpr size_t OFF_QKVC = OFF_QKV + (size_t)CT * NINP * 2;
constexpr size_t OFF_OUTS = OFF_QKVC + (size_t)CT * QKVC_LD * 2;
constexpr size_t OFF_BO = OFF_OUTS + (size_t)CT * OUT_LD * 2;
constexpr size_t OFF_BLSE = OFF_BO + (size_t)3 * CT * 256 * 2;
constexpr size_t WS_END = OFF_BLSE + (size_t)3 * CT * 4 * 4;
constexpr size_t OFF_MERGED = OFF_QKV;
constexpr size_t OFF_ACT = OFF_QKV + (size_t)CT * 1024 * 2;

struct Params {
  const float* in[29];
  float* out;
  char* ws;
  float inv64[32];
  float inv32[16];
  float lam_init[2];
  float oml[2];
  int pad[2];
};

DI int crow(int reg, int h) { return (reg & 3) + 8 * (reg >> 2) + 4 * h; }
DI unsigned cvtpk(float lo, float hi) {
  f32x2 f = {lo, hi};
  bf16x2_t b = __builtin_convertvector(f, bf16x2_t);
  return __builtin_bit_cast(unsigned, b);
}
DI float bflo(unsigned u) { return __uint_as_float(u << 16); }
DI float bfhi(unsigned u) { return __uint_as_float(u & 0xffff0000u); }
DI float swapadd(float x) {
  auto rr = __builtin_amdgcn_permlane32_swap(__float_as_uint(x), __float_as_uint(x), false, false);
  return __uint_as_float(rr[0]) + __uint_as_float(rr[1]);
}
DI float swapmax(float x) {
  auto rr = __builtin_amdgcn_permlane32_swap(__float_as_uint(x), __float_as_uint(x), false, false);
  return fmaxf(__uint_as_float(rr[0]), __uint_as_float(rr[1]));
}
DI int opaque(int x) { asm volatile("" : "+v"(x)); return x; }
DI int tidx() { return opaque((int)threadIdx.x); }
DI int wave_id() { return __builtin_amdgcn_readfirstlane(tidx() >> 6); }
DI char* lws(char* w) { asm volatile("" : "+s"(w)); return w; }
DI void lds_fence() { asm volatile("s_waitcnt lgkmcnt(0)" ::: "memory"); }
DI void tile_map(int t, int& nt, int& mt) {
  int round = t >> 8, b = t & 255, xcd = b & 7, slot = b >> 3;
  nt = round * 2 + (slot & 1);
  mt = xcd * 16 + (slot >> 1);
}

template <int NB, int AN = NB, bool LOWREG = false>
DI void gemm_core(f32x16 (&acc)[AN][2], const u16* __restrict__ Ag, int lda, const u16* __restrict__ Bg, int ldb, int K, char* lds) {
  constexpr int AR = 128 * NB;
  constexpr int ACH = AR * 8 / 512;
  constexpr int STAGE = (AR + 128) * PITCH;
  const int tid = tidx(), lane = tid & 63, wid = wave_id(), r = lane & 31, h = lane >> 5;
  const int wn = wid & 3, wm = wid >> 2;
  const int crow0 = tid >> 3, ccol = tid & 7;
  const u16* ap = Ag + (size_t)crow0 * lda + ccol * 8;
  const u16* bp = Bg + (size_t)crow0 * ldb + ccol * 8;
  const int wofs = crow0 * PITCH + ccol * 16;
  const int aoff = (wn * 32 * NB + r) * PITCH + h * 16;
  const int boff = AR * PITCH + (wm * 64 + r) * PITCH + h * 16;
  const int nk = K >> 6;
  u32x4 ra[ACH], rb[2];
#pragma unroll
  for (int i = 0; i < NB; ++i)
#pragma unroll
    for (int j = 0; j < 2; ++j)
#pragma unroll
      for (int e = 0; e < 16; ++e) acc[i][j][e] = 0.f;
  __syncthreads();
#pragma unroll
  for (int i = 0; i < ACH; ++i) ra[i] = *(const u32x4*)(ap + (size_t)i * 64 * lda);
#pragma unroll
  for (int i = 0; i < 2; ++i) rb[i] = *(const u32x4*)(bp + (size_t)i * 64 * ldb);
#pragma unroll
  for (int i = 0; i < ACH; ++i) *(u32x4*)(lds + wofs + i * 64 * PITCH) = ra[i];
#pragma unroll
  for (int i = 0; i < 2; ++i) *(u32x4*)(lds + AR * PITCH + wofs + i * 64 * PITCH) = rb[i];
  __syncthreads();
#pragma nounroll
  for (int kt = 0; kt < nk; ++kt) {
    const bool more = kt + 1 < nk;
    if (more) {
#pragma unroll
      for (int i = 0; i < ACH; ++i) ra[i] = *(const u32x4*)(ap + (size_t)i * 64 * lda + (kt + 1) * 64);
#pragma unroll
      for (int i = 0; i < 2; ++i) rb[i] = *(const u32x4*)(bp + (size_t)i * 64 * ldb + (kt + 1) * 64);
    }
    const char* base = lds + (kt & 1) * STAGE;
#pragma unroll
    for (int s = 0; s < 4; ++s) {
      bf16x8 af[NB], bfr[2];
#pragma unroll
      for (int i = 0; i < NB; ++i) af[i] = *(const bf16x8*)(base + aoff + i * 32 * PITCH + s * 32);
#pragma unroll
      for (int j = 0; j < 2; ++j) bfr[j] = *(const bf16x8*)(base + boff + j * 32 * PITCH + s * 32);
#pragma unroll
      for (int i = 0; i < NB; ++i)
#pragma unroll
        for (int j = 0; j < 2; ++j) acc[i][j] = MFMA(af[i], bfr[j], acc[i][j]);
      if (LOWREG) __builtin_amdgcn_sched_barrier(0);
    }
    if (more) {
      char* nb = lds + ((kt + 1) & 1) * STAGE;
#pragma unroll
      for (int i = 0; i < ACH; ++i) *(u32x4*)(nb + wofs + i * 64 * PITCH) = ra[i];
#pragma unroll
      for (int i = 0; i < 2; ++i) *(u32x4*)(nb + AR * PITCH + wofs + i * 64 * PITCH) = rb[i];
    }
    __syncthreads();
  }
}

template <int NB, int AN = NB>
DI void store_wave_bf16(const f32x16 (&v)[AN][2], u16* __restrict__ wdst, int ldd, char* wl) {
  constexpr int TP = NB * 64 + 16;
  const int lane = (tidx() & 63), r = lane & 31, h = lane >> 5;
#pragma unroll
  for (int i = 0; i < NB; ++i)
#pragma unroll
    for (int j = 0; j < 2; ++j)
#pragma unroll
      for (int g = 0; g < 4; ++g) {
        u32x2 w = {cvtpk(v[i][j][4 * g], v[i][j][4 * g + 1]), cvtpk(v[i][j][4 * g + 2], v[i][j][4 * g + 3])};
        *(u32x2*)(wl + (j * 32 + r) * TP + (i * 32 + 8 * g + 4 * h) * 2) = w;
      }
  lds_fence();
  constexpr int CPR = NB * 4;
#pragma unroll
  for (int it = 0; it < CPR; ++it) {
    int c = lane + 64 * it, row = c / CPR, ch = c % CPR;
    u32x4 d = *(const u32x4*)(wl + row * TP + ch * 16);
    *(u32x4*)(wdst + (size_t)row * ldd + ch * 8) = d;
  }
  lds_fence();
}

DI void store_wave_f32_res(const f32x16 (&v)[2][2], const float* __restrict__ res, float* __restrict__ wdst, char* wl) {
  constexpr int TP = 272;
  const int lane = (tidx() & 63), r = lane & 31, h = lane >> 5;
#pragma unroll
  for (int i = 0; i < 2; ++i)
#pragma unroll
    for (int j = 0; j < 2; ++j)
#pragma unroll
      for (int g = 0; g < 4; ++g) {
        f32x4 w = {v[i][j][4 * g], v[i][j][4 * g + 1], v[i][j][4 * g + 2], v[i][j][4 * g + 3]};
        *(f32x4*)(wl + (j * 32 + r) * TP + (i * 32 + 8 * g + 4 * h) * 4) = w;
      }
  lds_fence();
#pragma unroll
  for (int it = 0; it < 16; ++it) {
    int c = lane + 64 * it, row = c >> 4, ch = c & 15;
    f32x4 d = *(const f32x4*)(wl + row * TP + ch * 16);
    f32x4 x = *(const f32x4*)(res + (size_t)row * DM + ch * 4);
    d += x;
    *(f32x4*)(wdst + (size_t)row * DM + ch * 4) = d;
  }
  lds_fence();
}

DI void norm_rope64(f32x16 (&v)[2][2], const float* __restrict__ gain, float scale, int pos0, const float* __restrict__ cs, const float* __restrict__ sn) {
  const int lane = (tidx() & 63), r = lane & 31, h = lane >> 5;
#pragma unroll
  for (int j = 0; j < 2; ++j) {
    float ss = 0.f;
#pragma unroll
    for (int e = 0; e < 16; ++e) ss += v[0][j][e] * v[0][j][e] + v[1][j][e] * v[1][j][e];
    ss = swapadd(ss);
    const float rstd = __builtin_amdgcn_rsqf(ss * (1.f / 64.f) + EPS);
    const int pos = pos0 + j * 32 + r;
#pragma unroll
    for (int g = 0; g < 4; ++g) {
      const int d = 8 * g + 4 * h;
      f32x4 c4 = *(const f32x4*)(cs + pos * 32 + d), s4 = *(const f32x4*)(sn + pos * 32 + d);
      f32x4 g1 = *(const f32x4*)(gain + d), g2 = *(const f32x4*)(gain + 32 + d);
#pragma unroll
      for (int e = 0; e < 4; ++e) {
        float x1 = v[0][j][4 * g + e] * rstd * g1[e], x2 = v[1][j][4 * g + e] * rstd * g2[e];
        v[0][j][4 * g + e] = (x1 * c4[e] - x2 * s4[e]) * scale;
        v[1][j][4 * g + e] = (x2 * c4[e] + x1 * s4[e]) * scale;
      }
    }
  }
}

DI void norm96_rope_store(f32x16 (&v)[3][2], const float* __restrict__ gain, float scale, int pos0, const float* __restrict__ cs, const float* __restrict__ sn,
                          u16* __restrict__ wdst, char* wl) {
  const int lane = (tidx() & 63), r = lane & 31, h = lane >> 5;
#pragma unroll
  for (int j = 0; j < 2; ++j) {
    float ss = 0.f;
#pragma unroll
    for (int i = 0; i < 3; ++i)
#pragma unroll
      for (int e = 0; e < 16; ++e) ss += v[i][j][e] * v[i][j][e];
    ss = swapadd(ss);
    const float rstd = __builtin_amdgcn_rsqf(ss * (1.f / 96.f) + EPS);
    const int pos = pos0 + j * 32 + r;
#pragma unroll
    for (int i = 0; i < 3; ++i)
#pragma unroll
      for (int g = 0; g < 4; ++g) {
        f32x4 g4 = *(const f32x4*)(gain + i * 32 + 8 * g + 4 * h);
#pragma unroll
        for (int e = 0; e < 4; ++e) v[i][j][4 * g + e] *= rstd * g4[e];
      }
#pragma unroll
    for (int g = 0; g < 2; ++g) {
      f32x4 c4 = *(const f32x4*)(cs + pos * 16 + 8 * g + 4 * h), s4 = *(const f32x4*)(sn + pos * 16 + 8 * g + 4 * h);
#pragma unroll
      for (int e = 0; e < 4; ++e) {
        float a = v[2][j][4 * g + e], b = v[2][j][4 * g + e + 8];
        v[2][j][4 * g + e] = a * c4[e] - b * s4[e];
        v[2][j][4 * g + e + 8] = b * c4[e] + a * s4[e];
      }
    }
#pragma unroll
    for (int i = 0; i < 3; ++i)
#pragma unroll
      for (int e = 0; e < 16; ++e) v[i][j][e] *= scale;
  }
  store_wave_bf16<3>(v, wdst, QKVC_LD, wl);
}

DI float row_ssq(const u16* __restrict__ p, int nchunk) {
  float ss = 0.f;
#pragma unroll 2
  for (int c = 0; c < nchunk; ++c) {
    u32x4 d = *(const u32x4*)(p + c * 8);
    unsigned w[4] = {d[0], d[1], d[2], d[3]};
#pragma unroll
    for (int e = 0; e < 4; ++e) { float a = bflo(w[e]), b = bfhi(w[e]); ss += a * a + b * b; }
  }
  return ss;
}

DI void repack_tile(const float* __restrict__ src, const float* __restrict__ src2, int nsrc, u16* __restrict__ dst, int K, int n0, int k0, int mode,
                    const float* __restrict__ gain, char* lds) {
  float* tile = (float*)lds;
  const int tid = tidx();
  {
    const int nn = tid & 63, kk0 = tid >> 6;
    const int np = n0 + nn;
    const float* s = src; int col = np; bool valid = true;
    if (mode == 1) {
      if (np < 3840) col = np; else if (np < 4608) col = 4256 + (np - 3840); else if (np < 5024) col = 3840 + (np - 4608); else valid = false;
    } else if (mode == 2) {
      int t = np >> 6, i = np & 63;
      if (i < 32) col = 32 * t + i; else { s = src2; col = 32 * t + i - 32; }
    }
#pragma unroll
    for (int i = 0; i < 8; ++i) {
      int kk = kk0 + 8 * i;
      float v = valid ? s[(size_t)(k0 + kk) * nsrc + col] : 0.f;
      if (gain) v *= gain[k0 + kk];
      tile[kk * 65 + nn] = v;
    }
  }
  __syncthreads();
  {
    const int n = tid >> 3, kc = (tid & 7) * 8;
    float f[8];
#pragma unroll
    for (int i = 0; i < 8; ++i) f[i] = tile[(kc + i) * 65 + n];
    u32x4 w = {cvtpk(f[0], f[1]), cvtpk(f[2], f[3]), cvtpk(f[4], f[5]), cvtpk(f[6], f[7])};
    *(u32x4*)(dst + (size_t)(n0 + n) * K + k0 + kc) = w;
  }
  __syncthreads();
}

DI void sincos_acc(float ang, float& c, float& s) {
  double a = (double)ang;
  double t = a * 0.15915494309189535;
  double fr = t - rint(t);
  double x = fr * 6.283185307179586;
  double x2 = x * x;
  double ts = x, tc = 1.0, ssum = x, csum = 1.0;
  for (int n = 1; n <= 14; ++n) {
    tc *= -x2 / (double)((2 * n - 1) * (2 * n));
    ts *= -x2 / (double)((2 * n) * (2 * n + 1));
    csum += tc; ssum += ts;
  }
  c = (float)csum; s = (float)ssum;
}

__device__ __forceinline__ void phase_w(const Params& p, char* lds) {
  char* const ws = lws(p.ws);
  constexpr int PER_LAYER = 5200;
  for (int t = blockIdx.x; t < PER_LAYER * DEPTH; t += gridDim.x) {
    const int l = t / PER_LAYER; int u = t % PER_LAYER;
    if (u < 1280) {
      repack_tile(p.in[3] + (size_t)l * 1024 * 5024, nullptr, 5024, (u16*)(ws + OFF_WIN) + (size_t)l * NINP * 1024, 1024, (u >> 4) * 64, (u & 15) * 64, 1, nullptr, lds);
      continue;
    }
    u -= 1280;
    if (u < 1024) {
      repack_tile(p.in[4] + (size_t)l * 1024 * 4096, nullptr, 4096, (u16*)(ws + OFF_WGATE) + (size_t)l * 4096 * 1024, 1024, (u >> 4) * 64, (u & 15) * 64, 0, nullptr, lds);
      continue;
    }
    u -= 1024;
    if (u < 48) {
      repack_tile(p.in[13] + (size_t)l * 256 * 768, nullptr, 768, (u16*)(ws + OFF_WUQ) + (size_t)l * 768 * 256, 256, (u >> 2) * 64, (u & 3) * 64, 0, p.in[11] + l * 256, lds);
      continue;
    }
    u -= 48;
    if (u < 32) {
      repack_tile(p.in[14] + (size_t)l * 128 * 1024, nullptr, 1024, (u16*)(ws + OFF_WUKV) + (size_t)l * 1024 * 128, 128, (u >> 1) * 64, (u & 1) * 64, 0, p.in[12] + l * 128, lds);
      continue;
    }
    u -= 32;
    if (u < 448) {
      u16* wbr = (u16*)(ws + OFF_WBR) + (size_t)l * 1024 * 1792;
      if (u < 128) repack_tile(p.in[20] + (size_t)l * 512 * 1024, nullptr, 1024, wbr, 512, (u >> 3) * 64, (u & 7) * 64, 0, nullptr, lds);
      else if (u < 192) { u -= 128; repack_tile(p.in[21] + (size_t)l * 256 * 1024, nullptr, 1024, wbr + 1024 * 512, 256, (u >> 2) * 64, (u & 3) * 64, 0, nullptr, lds); }
      else if (u < 320) { u -= 192; repack_tile(p.in[22] + (size_t)l * 512 * 1024, nullptr, 1024, wbr + 1024 * 768, 512, (u >> 3) * 64, (u & 7) * 64, 0, nullptr, lds); }
      else { u -= 320; repack_tile(p.in[23] + (size_t)l * 512 * 1024, nullptr, 1024, wbr + 1024 * 1280, 512, (u >> 3) * 64, (u & 7) * 64, 0, nullptr, lds); }
      continue;
    }
    u -= 448;
    if (u < 256) {
      repack_tile(p.in[24] + (size_t)l * 1024 * 1024, nullptr, 1024, (u16*)(ws + OFF_WO) + (size_t)l * 1024 * 1024, 1024, (u >> 4) * 64, (u & 15) * 64, 0, nullptr, lds);
      continue;
    }
    u -= 256;
    if (u < 1408) {
      repack_tile(p.in[26] + (size_t)l * 1024 * DFF, p.in[27] + (size_t)l * 1024 * DFF, DFF, (u16*)(ws + OFF_WGU) + (size_t)l * NGU * 1024, 1024, (u >> 4) * 64, (u & 15) * 64, 2, nullptr, lds);
      continue;
    }
    u -= 1408;
    repack_tile(p.in[28] + (size_t)l * DFF * 1024, nullptr, 1024, (u16*)(ws + OFF_WDN) + (size_t)l * 1024 * DFF, DFF, (u / 44) * 64, (u % 44) * 64, 0, nullptr, lds);
  }
  const int gt = blockIdx.x * 512 + tidx(), ngt = gridDim.x * 512;
  float* c64 = (float*)(ws + OFF_COS64); float* s64 = (float*)(ws + OFF_SIN64);
  float* c32 = (float*)(ws + OFF_COS32); float* s32 = (float*)(ws + OFF_SIN32);
  for (int i = gt; i < SEQ * 32; i += ngt) {
    int pos = i >> 5, f = i & 31; float c, s;
    sincos_acc((float)pos * p.inv64[f], c, s);
    c64[i] = c; s64[i] = s;
  }
  for (int i = gt; i < SEQ * 16; i += ngt) {
    int pos = i >> 4, f = i & 15; float c, s;
    sincos_acc((float)pos * p.inv32[f], c, s);
    c32[i] = c; s32[i] = s;
  }
  if (gt < DEPTH) {
    const float* lp = p.in[7] + gt * 256;
    float a = 0.f, b = 0.f;
    for (int i = 0; i < 64; ++i) { a += lp[i] * lp[64 + i]; b += lp[128 + i] * lp[192 + i]; }
    ((float*)(ws + OFF_LAM))[gt] = expf(a) - expf(b) + p.lam_init[gt];
  }
}

__device__ __forceinline__ void phase_norm(const float* __restrict__ x, const float* __restrict__ g, u16* __restrict__ xn) {
  const int lane = tidx() & 63, wid = wave_id();
  for (int row = blockIdx.x * 8 + wid; row < CT; row += gridDim.x * 8) {
    const f32x4* xr = (const f32x4*)(x + (size_t)row * DM);
    f32x4 v[4]; float ss = 0.f;
#pragma unroll
    for (int i = 0; i < 4; ++i) { v[i] = xr[lane + 64 * i]; ss += v[i][0] * v[i][0] + v[i][1] * v[i][1] + v[i][2] * v[i][2] + v[i][3] * v[i][3]; }
    ss = swapadd(ss);
#pragma unroll
    for (int o = 16; o >= 1; o >>= 1) ss += __int_as_float(__builtin_amdgcn_ds_bpermute((lane ^ o) << 2, __float_as_int(ss)));
    const float rstd = __builtin_amdgcn_rsqf(ss * (1.f / 1024.f) + EPS);
#pragma unroll
    for (int i = 0; i < 4; ++i) {
      f32x4 g4 = ((const f32x4*)g)[lane + 64 * i];
      u32x2 w = {cvtpk(v[i][0] * rstd * g4[0], v[i][1] * rstd * g4[1]), cvtpk(v[i][2] * rstd * g4[2], v[i][3] * rstd * g4[3])};
      *(u32x2*)(xn + (size_t)row * DM + (lane + 64 * i) * 4) = w;
    }
  }
}

__device__ __forceinline__ void phase_p1(const Params& p, int layer, char* lds) {
  char* const ws = lws(p.ws);
  const u16* Wt = (const u16*)(ws + OFF_WIN) + (size_t)layer * NINP * 1024;
  const u16* xn = (const u16*)(ws + OFF_XN);
  u16* qkv = (u16*)(ws + OFF_QKV);
  const float* c64 = (const float*)(ws + OFF_COS64); const float* s64 = (const float*)(ws + OFF_SIN64);
  const int wid = wave_id(), wn = wid & 3, wm = wid >> 2;
  for (int t = blockIdx.x; t < 20 * 128; t += gridDim.x) {
    int nt, mt; tile_map(t, nt, mt);
    const int n0 = nt * 256, m0 = mt * 128;
    f32x16 acc[2][2];
    gemm_core<2>(acc, Wt + (size_t)n0 * 1024, 1024, xn + (size_t)m0 * 1024, 1024, 1024, lds);
    const int n64 = (n0 >> 6) + wn;
    const float* gain = nullptr; float scale = 1.f;
    if (n64 < 8) { gain = p.in[5] + layer * 64; scale = QS64; }
    else if (n64 < 16) { gain = p.in[6] + layer * 64; }
    else if (n64 < 24) {}
    else if (n64 < 60) {
      int tt = n64 - 24, g = tt / 12, jj = (tt % 12) >> 2;
      if (jj == 0) { gain = p.in[9] + (layer * 3 + g) * 64; scale = QS64; }
      else if (jj == 1) { gain = p.in[10] + (layer * 3 + g) * 64; }
    }
    else if (n64 < 68) { gain = p.in[17] + layer * 64; scale = QS64; }
    else if (n64 < 70) { gain = p.in[18] + layer * 64; }
    if (gain) norm_rope64(acc, gain, scale, (m0 + wm * 64) & (SEQ - 1), c64, s64);
    store_wave_bf16<2>(acc, qkv + (size_t)(m0 + wm * 64) * NINP + n0 + wn * 64, NINP, lds + wid * WAVE_LDS);
  }
}

__device__ __forceinline__ void phase_p1c(const Params& p, int layer, char* lds) {
  char* const ws = lws(p.ws);
  const u16* Wuq = (const u16*)(ws + OFF_WUQ) + (size_t)layer * 768 * 256;
  const u16* Wukv = (const u16*)(ws + OFF_WUKV) + (size_t)layer * 1024 * 128;
  const u16* qkv = (const u16*)(ws + OFF_QKV);
  u16* qc = (u16*)(ws + OFF_QKVC);
  const float* c32 = (const float*)(ws + OFF_COS32); const float* s32 = (const float*)(ws + OFF_SIN32);
  const int tid = tidx(), wid = wave_id(), wn = wid & 3, wm = wid >> 2;
  char* wl = lds + wid * WAVE_LDS;
  for (int t = blockIdx.x; t < 2 * 128; t += gridDim.x) {
    int nt, mt; tile_map(t, nt, mt);
    const int n0 = nt * 384, m0 = mt * 128;
    f32x16 acc[3][2];
    gemm_core<3>(acc, Wuq + (size_t)n0 * 256, 256, qkv + (size_t)m0 * NINP + 4608, NINP, 256, lds);
    const int lane2 = (tidx() & 63), r = lane2 & 31, h = lane2 >> 5;
#pragma unroll
    for (int j = 0; j < 2; ++j) {
      const int m = m0 + wm * 64 + j * 32 + r;
      float ss = swapadd(row_ssq(qkv + (size_t)m * NINP + 4608 + h * 128, 16));
      const float rq = __builtin_amdgcn_rsqf(ss * (1.f / 256.f) + EPS);
#pragma unroll
      for (int i = 0; i < 3; ++i)
#pragma unroll
        for (int e = 0; e < 16; ++e) acc[i][j][e] *= rq;
    }
    norm96_rope_store(acc, p.in[15] + layer * 96, QS96, (m0 + wm * 64) & (SEQ - 1), c32, s32, qc + (size_t)(m0 + wm * 64) * QKVC_LD + n0 + wn * 96, wl);
  }
  for (int t = blockIdx.x; t < 4 * 128; t += gridDim.x) {
    int nt, mt; tile_map(t, nt, mt);
    const int n0 = nt * 256, m0 = mt * 128;
    f32x16 acc[3][2];
    gemm_core<2, 3>(acc, Wukv + (size_t)n0 * 128, 128, qkv + (size_t)m0 * NINP + 4864, NINP, 128, lds);
    const int n64 = (n0 >> 6) + wn, head = n64 >> 1, isv = n64 & 1;
    const int lane2 = (tidx() & 63), r = lane2 & 31, h = lane2 >> 5;
#pragma unroll
    for (int j = 0; j < 2; ++j) {
      const int m = m0 + wm * 64 + j * 32 + r;
      float ss = swapadd(row_ssq(qkv + (size_t)m * NINP + 4864 + h * 64, 8));
      const float rk = __builtin_amdgcn_rsqf(ss * (1.f / 128.f) + EPS);
#pragma unroll
      for (int i = 0; i < 2; ++i)
#pragma unroll
        for (int e = 0; e < 16; ++e) acc[i][j][e] *= rk;
    }
    if (isv) {
      store_wave_bf16<2, 3>(acc, qc + (size_t)(m0 + wm * 64) * QKVC_LD + 1536 + head * 64, QKVC_LD, wl);
    } else {
      f32x16 (&y)[3][2] = acc;
#pragma unroll
      for (int j = 0; j < 2; ++j) {
        const int m = m0 + wm * 64 + j * 32 + r;
#pragma unroll
        for (int g = 0; g < 4; ++g) {
          u32x2 d = *(const u32x2*)(qkv + (size_t)m * NINP + 4992 + 8 * g + 4 * h);
          y[2][j][4 * g] = bflo(d[0]); y[2][j][4 * g + 1] = bfhi(d[0]); y[2][j][4 * g + 2] = bflo(d[1]); y[2][j][4 * g + 3] = bfhi(d[1]);
        }
      }
      norm96_rope_store(y, p.in[16] + layer * 96, 1.f, (m0 + wm * 64) & (SEQ - 1), c32, s32, qc + (size_t)(m0 + wm * 64) * QKVC_LD + 768 + head * 96, wl);
    }
  }
}

constexpr int QLDS_OFF = 71680, QLDS_WAVE = 64 * 144;
template <int DQK, int DV, int NKT, bool BANDED, bool QLDS = false>
DI void attn_loop(f32x16 (&O)[2][DV / 32], float (&mrun)[2], float (&lrun)[2], const bf16x8 (&qf)[2][DQK / 16],
                  const u16* __restrict__ k0p, const u16* __restrict__ k1p, size_t kld, const u16* __restrict__ vp, size_t vld,
                  int t0, int t1, bool wact, int qbase, int W, char* lds) {
  constexpr int KP = DQK * 2 + 16, VP = DV * 2 + 16;
  constexpr int KC = DQK / 8, VC = DV / 8;
  constexpr int KTOT = NKT * 64 * KC, VTOT = 64 * VC, TOT = KTOT + VTOT, NIT = (TOT + 511) / 512;
  constexpr int SB = NKT * 64 * KP + 64 * VP;
  constexpr float THR = 8.f;
  const int tid = tidx(), lane = tid & 63, r = lane & 31, h = lane >> 5;
  const int dk1 = NKT == 2 ? (int)(k1p - k0p) : 0, dvo = (int)(vp - k0p);
  const int ldi = (int)kld;
  int soff[NIT]; int doff[NIT]; bool sval[NIT];
#pragma unroll
  for (int it = 0; it < NIT; ++it) {
    const int c = tid + it * 512;
    const bool allK = (it + 1) * 512 <= KTOT, allV = it * 512 >= KTOT;
    const bool isK = allK ? true : (allV ? false : (c < KTOT));
    const int kt = c / (64 * KC), rem = c % (64 * KC), krow = rem / KC, kcol = rem % KC;
    const int c2 = c - KTOT, vrow = c2 / VC, vcol = c2 % VC;
    const int so_k = (kt ? dk1 : 0) + krow * ldi + kcol * 8, do_k = kt * 64 * KP + krow * KP + kcol * 16;
    const int so_v = dvo + vrow * ldi + vcol * 8, do_v = NKT * 64 * KP + vrow * VP + vcol * 16;
    soff[it] = isK ? so_k : so_v;
    doff[it] = isK ? do_k : do_v;
    sval[it] = ((it + 1) * 512 <= TOT) ? true : (c < TOT);
  }
  u32x4 rg[NIT];
  const int kaddr = r * KP + h * 16;
  const int vaddr = NKT * 64 * KP + (4 * h + ((lane & 15) >> 2)) * VP + (((lane >> 4) & 1) * 16 + (lane & 3) * 4) * 2;
  if (t1 <= t0) return;
  __syncthreads();
#pragma unroll
  for (int it = 0; it < NIT; ++it) if (sval[it]) rg[it] = *(const u32x4*)(k0p + (soff[it] + t0 * 64 * ldi));
#pragma unroll
  for (int it = 0; it < NIT; ++it) if (sval[it]) *(u32x4*)(lds + doff[it]) = rg[it];
  __syncthreads();
#pragma nounroll
  for (int t = t0; t < t1; ++t) {
    const int buf = (t - t0) & 1;
    const bool more = t + 1 < t1;
    if (more) {
#pragma unroll
      for (int it = 0; it < NIT; ++it) if (sval[it]) rg[it] = *(const u32x4*)(k0p + (soff[it] + (t + 1) * 64 * ldi));
    }
    bool doit = wact;
    if (BANDED) doit = wact && (t * 64 + 63 >= qbase - W) && (t * 64 <= qbase + 63 + W);
    if (doit) {
      const char* base = lds + buf * SB;
      bf16x8 pf[2][4];
      if (NKT == 1) {
        f32x16 S[2][2];
#pragma unroll
        for (int j = 0; j < 2; ++j)
#pragma unroll
          for (int kb = 0; kb < 2; ++kb)
#pragma unroll
            for (int e = 0; e < 16; ++e) S[j][kb][e] = 0.f;
#pragma unroll
        for (int s = 0; s < DQK / 16; ++s)
#pragma unroll
          for (int kb = 0; kb < 2; ++kb) {
            bf16x8 kf = *(const bf16x8*)(base + kaddr + kb * 32 * KP + s * 32);
#pragma unroll
            for (int j = 0; j < 2; ++j) S[j][kb] = MFMA(kf, qf[j][s], S[j][kb]);
          }
#pragma unroll
        for (int j = 0; j < 2; ++j) {
          if (BANDED) {
            const int qi = qbase + j * 32 + r;
#pragma unroll
            for (int kb = 0; kb < 2; ++kb)
#pragma unroll
              for (int e = 0; e < 16; ++e) {
                int ki = t * 64 + kb * 32 + crow(e, h);
                int dd = qi - ki; dd = dd < 0 ? -dd : dd;
                if (dd > W) S[j][kb][e] = -1e30f;
              }
          }
          float pmax = S[j][0][0];
#pragma unroll
          for (int e = 1; e < 16; ++e) pmax = fmaxf(pmax, S[j][0][e]);
#pragma unroll
          for (int e = 0; e < 16; ++e) pmax = fmaxf(pmax, S[j][1][e]);
          pmax = swapmax(pmax);
          if (!__all(pmax - mrun[j] <= THR)) {
            float mn = fmaxf(mrun[j], pmax);
            float alpha = __builtin_amdgcn_exp2f(mrun[j] - mn);
            mrun[j] = mn; lrun[j] *= alpha;
#pragma unroll
            for (int d = 0; d < DV / 32; ++d)
#pragma unroll
              for (int e = 0; e < 16; ++e) O[j][d][e] *= alpha;
          }
          float ps = 0.f; const float mm = mrun[j];
#pragma unroll
          for (int kb = 0; kb < 2; ++kb)
#pragma unroll
            for (int e = 0; e < 16; ++e) { float pv = __builtin_amdgcn_exp2f(S[j][kb][e] - mm); S[j][kb][e] = pv; ps += pv; }
          lrun[j] += ps;
#pragma unroll
          for (int ks = 0; ks < 4; ++ks) {
            const int kb = ks >> 1, b8 = (ks & 1) * 8;
            u32x4 w = {cvtpk(S[j][kb][b8], S[j][kb][b8 + 1]), cvtpk(S[j][kb][b8 + 2], S[j][kb][b8 + 3]),
                       cvtpk(S[j][kb][b8 + 4], S[j][kb][b8 + 5]), cvtpk(S[j][kb][b8 + 6], S[j][kb][b8 + 7])};
            pf[j][ks] = __builtin_bit_cast(bf16x8, w);
          }
        }
      } else {
#pragma unroll
        for (int j = 0; j < 2; ++j) {
          f32x16 S[2];
#pragma unroll
          for (int kb = 0; kb < 2; ++kb)
#pragma unroll
            for (int e = 0; e < 16; ++e) S[kb][e] = 0.f;
#pragma unroll
          for (int s = 0; s < DQK / 16; ++s)
#pragma unroll
            for (int kb = 0; kb < 2; ++kb) {
              bf16x8 kf = *(const bf16x8*)(base + j * 64 * KP + kaddr + kb * 32 * KP + s * 32);
              bf16x8 qq;
              if (QLDS) qq = *(const bf16x8*)(lds + QLDS_OFF + wave_id() * QLDS_WAVE + (j * 32 + r) * 144 + h * 16 + s * 32);
              else qq = qf[j][s];
              S[kb] = MFMA(kf, qq, S[kb]);
            }
          float pmax = S[0][0];
#pragma unroll
          for (int e = 1; e < 16; ++e) pmax = fmaxf(pmax, S[0][e]);
#pragma unroll
          for (int e = 0; e < 16; ++e) pmax = fmaxf(pmax, S[1][e]);
          pmax = swapmax(pmax);
          if (!__all(pmax - mrun[j] <= THR)) {
            float mn = fmaxf(mrun[j], pmax);
            float alpha = __builtin_amdgcn_exp2f(mrun[j] - mn);
            mrun[j] = mn; lrun[j] *= alpha;
#pragma unroll
            for (int d = 0; d < DV / 32; ++d)
#pragma unroll
              for (int e = 0; e < 16; ++e) O[j][d][e] *= alpha;
          }
          float ps = 0.f; const float mm = mrun[j];
#pragma unroll
          for (int kb = 0; kb < 2; ++kb)
#pragma unroll
            for (int e = 0; e < 16; ++e) { float pv = __builtin_amdgcn_exp2f(S[kb][e] - mm); S[kb][e] = pv; ps += pv; }
          lrun[j] += ps;
#pragma unroll
          for (int ks = 0; ks < 4; ++ks) {
            const int kb = ks >> 1, b8 = (ks & 1) * 8;
            u32x4 w = {cvtpk(S[kb][b8], S[kb][b8 + 1]), cvtpk(S[kb][b8 + 2], S[kb][b8 + 3]),
                       cvtpk(S[kb][b8 + 4], S[kb][b8 + 5]), cvtpk(S[kb][b8 + 6], S[kb][b8 + 7])};
            pf[j][ks] = __builtin_bit_cast(bf16x8, w);
          }
#pragma unroll
          for (int ks = 0; ks < 4; ++ks)
#pragma unroll
            for (int d = 0; d < DV / 32; ++d) {
              const char* va = base + vaddr + ks * 16 * VP + d * 64;
              s16x4 lo = __builtin_amdgcn_ds_read_tr16_b64_v4i16((__attribute__((address_space(3))) s16x4*)(va));
              s16x4 hi = __builtin_amdgcn_ds_read_tr16_b64_v4i16((__attribute__((address_space(3))) s16x4*)(va + 8 * VP));
              bf16x8 vf = {lo[0], lo[1], lo[2], lo[3], hi[0], hi[1], hi[2], hi[3]};
              O[j][d] = MFMA(vf, pf[j][ks], O[j][d]);
            }
        }
      }
      if (NKT == 1) {
#pragma unroll
        for (int ks = 0; ks < 4; ++ks)
#pragma unroll
          for (int d = 0; d < DV / 32; ++d) {
            const char* va = base + vaddr + ks * 16 * VP + d * 64;
            s16x4 lo = __builtin_amdgcn_ds_read_tr16_b64_v4i16((__attribute__((address_space(3))) s16x4*)(va));
            s16x4 hi = __builtin_amdgcn_ds_read_tr16_b64_v4i16((__attribute__((address_space(3))) s16x4*)(va + 8 * VP));
            bf16x8 vf = {lo[0], lo[1], lo[2], lo[3], hi[0], hi[1], hi[2], hi[3]};
#pragma unroll
            for (int j = 0; j < 2; ++j) O[j][d] = MFMA(vf, pf[j][ks], O[j][d]);
          }
      }
    }
    if (more) {
      char* nb = lds + (buf ^ 1) * SB;
#pragma unroll
      for (int it = 0; it < NIT; ++it) if (sval[it]) *(u32x4*)(nb + doff[it]) = rg[it];
    }
    __syncthreads();
  }
}

template <int NS>
DI void load_qf(bf16x8 (&qf)[NS], const u16* __restrict__ qrow) {
#pragma unroll
  for (int s = 0; s < NS; ++s) qf[s] = *(const bf16x8*)(qrow + s * 16);
}

template <int ND>
DI void store_o(const f32x16 (&o)[ND], float scale, u16* __restrict__ dst, int h) {
#pragma unroll
  for (int d = 0; d < ND; ++d)
#pragma unroll
    for (int g = 0; g < 4; ++g) {
      u32x2 w = {cvtpk(o[d][4 * g] * scale, o[d][4 * g + 1] * scale), cvtpk(o[d][4 * g + 2] * scale, o[d][4 * g + 3] * scale)};
      *(u32x2*)(dst + d * 32 + 8 * g + 4 * h) = w;
    }
}

DI void item_map(int idx, int nqb, int& sh, int& qb) {
  int xcd = idx & 7, slot = idx >> 3;
  sh = xcd * (32 / nqb) + slot / nqb;
  qb = slot % nqb;
}

__device__ __forceinline__ void attn_A(const Params& p, int layer, int idx, char* lds) {
  char* const ws = lws(p.ws);
  const int tid = tidx(), lane = tid & 63, wid = wave_id(), r = lane & 31, h = lane >> 5;
  int sh, qb; item_map(idx, 16, sh, qb);
  const int seq = sh >> 2, head = sh & 3;
  const u16* qkv = (const u16*)(ws + OFF_QKV) + (size_t)seq * SEQ * NINP;
  u16* outs = (u16*)(ws + OFF_OUTS) + (size_t)seq * SEQ * OUT_LD;
  const int q0 = qb * 256 + wid * 32;
  bf16x8 qf[2][4];
  __syncthreads();
#pragma unroll
  for (int j = 0; j < 2; ++j) {
    load_qf<4>(qf[j], qkv + (size_t)(q0 + r) * NINP + (head * 2 + j) * 64 + h * 8);
#pragma unroll
    for (int s = 0; s < 4; ++s) *(bf16x8*)(lds + QLDS_OFF + wid * QLDS_WAVE + (j * 32 + r) * 144 + h * 16 + s * 32) = qf[j][s];
  }
  lds_fence();
  f32x16 O[2][4]; float mrun[2] = {-1e29f, -1e29f}, lrun[2] = {0.f, 0.f};
#pragma unroll
  for (int j = 0; j < 2; ++j)
#pragma unroll
    for (int d = 0; d < 4; ++d)
#pragma unroll
      for (int e = 0; e < 16; ++e) O[j][d][e] = 0.f;
  attn_loop<64, 128, 2, false, true>(O, mrun, lrun, qf, qkv + 512 + (head * 2) * 64, qkv + 512 + (head * 2 + 1) * 64, NINP, qkv + 1024 + head * 128, NINP,
                               0, 64, true, 0, 0, lds);
  const int lane2 = (tidx() & 63), r2 = lane2 & 31, h2 = lane2 >> 5;
  const float lam = ((const float*)(ws + OFF_LAM))[layer];
  const float i0 = 1.f / swapadd(lrun[0]), i1 = lam / swapadd(lrun[1]);
  float ss = 0.f;
#pragma unroll
  for (int d = 0; d < 4; ++d)
#pragma unroll
    for (int e = 0; e < 16; ++e) { float o = O[0][d][e] * i0 - O[1][d][e] * i1; O[0][d][e] = o; ss += o * o; }
  ss = swapadd(ss);
  const float rstd = __builtin_amdgcn_rsqf(ss * (1.f / 128.f) + EPS) * p.oml[layer];
  const float* sg = p.in[8] + layer * 128;
  u16* dst = outs + (size_t)(q0 + r2) * OUT_LD + head * 128;
#pragma unroll
  for (int d = 0; d < 4; ++d)
#pragma unroll
    for (int g = 0; g < 4; ++g) {
      f32x4 g4 = *(const f32x4*)(sg + d * 32 + 8 * g + 4 * h2);
      u32x2 w = {cvtpk(O[0][d][4 * g] * rstd * g4[0], O[0][d][4 * g + 1] * rstd * g4[1]), cvtpk(O[0][d][4 * g + 2] * rstd * g4[2], O[0][d][4 * g + 3] * rstd * g4[3])};
      *(u32x2*)(dst + d * 32 + 8 * g + 4 * h2) = w;
    }
}

__device__ __forceinline__ void attn_C(const Params& p, int layer, int idx, char* lds) {
  char* const ws = lws(p.ws);
  const int tid = tidx(), lane = tid & 63, wid = wave_id(), r = lane & 31, h = lane >> 5;
  int sh, qb; item_map(idx, 8, sh, qb);
  const int seq = sh >> 3, head = sh & 7;
  const u16* qc = (const u16*)(ws + OFF_QKVC) + (size_t)seq * SEQ * QKVC_LD;
  u16* outs = (u16*)(ws + OFF_OUTS) + (size_t)seq * SEQ * OUT_LD;
  const int q0 = qb * 512 + wid * 64;
  bf16x8 qf[2][6];
  load_qf<6>(qf[0], qc + (size_t)(q0 + r) * QKVC_LD + head * 96 + h * 8);
  load_qf<6>(qf[1], qc + (size_t)(q0 + 32 + r) * QKVC_LD + head * 96 + h * 8);
  f32x16 O[2][2]; float mrun[2] = {-1e29f, -1e29f}, lrun[2] = {0.f, 0.f};
#pragma unroll
  for (int j = 0; j < 2; ++j)
#pragma unroll
    for (int d = 0; d < 2; ++d)
#pragma unroll
      for (int e = 0; e < 16; ++e) O[j][d][e] = 0.f;
  attn_loop<96, 64, 1, false>(O, mrun, lrun, qf, qc + 768 + head * 96, nullptr, QKVC_LD, qc + 1536 + head * 64, QKVC_LD, 0, 64, true, 0, 0, lds);
  const int lane2 = (tidx() & 63), r2 = lane2 & 31, h2 = lane2 >> 5;
#pragma unroll
  for (int j = 0; j < 2; ++j) {
    const float inv = 1.f / swapadd(lrun[j]);
    store_o<2>(O[j], inv, outs + (size_t)(q0 + j * 32 + r2) * OUT_LD + 768 + head * 64, h2);
  }
}

__device__ __forceinline__ void attn_D(const Params& p, int layer, int idx, char* lds) {
  char* const ws = lws(p.ws);
  const int tid = tidx(), lane = tid & 63, wid = wave_id(), r = lane & 31, h = lane >> 5;
  const int xcd = idx & 7, qb = idx >> 3;
  const int seq = xcd >> 1, kvh = xcd & 1;
  const u16* qkv = (const u16*)(ws + OFF_QKV) + (size_t)seq * SEQ * NINP;
  u16* outs = (u16*)(ws + OFF_OUTS) + (size_t)seq * SEQ * OUT_LD;
  const int qhead = kvh * 4 + (wid >> 1);
  const int q0 = qb * 128 + (wid & 1) * 64;
  bf16x8 qf[2][4];
  load_qf<4>(qf[0], qkv + (size_t)(q0 + r) * NINP + 3840 + qhead * 64 + h * 8);
  load_qf<4>(qf[1], qkv + (size_t)(q0 + 32 + r) * NINP + 3840 + qhead * 64 + h * 8);
  f32x16 O[2][2]; float mrun[2] = {-1e29f, -1e29f}, lrun[2] = {0.f, 0.f};
#pragma unroll
  for (int j = 0; j < 2; ++j)
#pragma unroll
    for (int d = 0; d < 2; ++d)
#pragma unroll
      for (int e = 0; e < 16; ++e) O[j][d][e] = 0.f;
  int t0 = qb * 2 - 2; if (t0 < 0) t0 = 0;
  int t1 = qb * 2 + 4; if (t1 > 64) t1 = 64;
  attn_loop<64, 64, 1, true>(O, mrun, lrun, qf, qkv + 4352 + kvh * 64, nullptr, NINP, qkv + 4480 + kvh * 64, NINP, t0, t1, true, q0, 128, lds);
  const float sink2 = p.in[19][layer * 8 + qhead] * LOG2E;
  const int lane2 = (tidx() & 63), r2 = lane2 & 31, h2 = lane2 >> 5;
#pragma unroll
  for (int j = 0; j < 2; ++j) {
    const float l = swapadd(lrun[j]);
    const float mf = fmaxf(mrun[j], sink2);
    const float a = __builtin_amdgcn_exp2f(mrun[j] - mf);
    const float lf = l * a + __builtin_amdgcn_exp2f(sink2 - mf);
    store_o<2>(O[j], a / lf, outs + (size_t)(q0 + j * 32 + r2) * OUT_LD + 1280 + qhead * 64, h2);
  }
}

__device__ __forceinline__ void attn_B(const Params& p, int layer, int idx, char* lds) {
  char* const ws = lws(p.ws);
  const int tid = tidx(), lane = tid & 63, wid = wave_id(), r = lane & 31, h = lane >> 5;
  const int sub = idx & 31, sh = idx >> 5, seq = sh >> 2, head = sh & 3;
  int g, res, m0;
  if (sub < 8) { g = 0; res = 0; m0 = sub * 512; }
  else if (sub < 16) { g = 1; res = (sub - 8) >> 1; m0 = ((sub - 8) & 1) * 512; }
  else { g = 2; res = sub - 16; m0 = 0; }
  const int dil = g == 0 ? 1 : (g == 1 ? 4 : 16);
  const int Lg = SEQ / dil;
  int nact = (Lg - m0) / 64; if (nact > 8) nact = 8;
  const bool wact = wid < nact;
  const size_t ld = (size_t)dil * NINP;
  const u16* base = (const u16*)(ws + OFF_QKV) + ((size_t)seq * SEQ + res) * NINP + 1536 + g * 768 + head * 64;
  int q0 = m0 + wid * 64; if (!wact) q0 = m0;
  bf16x8 qf[2][4];
  load_qf<4>(qf[0], base + (size_t)(q0 + r) * ld + h * 8);
  load_qf<4>(qf[1], base + (size_t)(q0 + 32 + r) * ld + h * 8);
  f32x16 O[2][2]; float mrun[2] = {-1e29f, -1e29f}, lrun[2] = {0.f, 0.f};
#pragma unroll
  for (int j = 0; j < 2; ++j)
#pragma unroll
    for (int d = 0; d < 2; ++d)
#pragma unroll
      for (int e = 0; e < 16; ++e) O[j][d][e] = 0.f;
  int t0 = m0 / 64 - 1; if (t0 < 0) t0 = 0;
  int t1 = m0 / 64 + 9; if (t1 > Lg / 64) t1 = Lg / 64;
  attn_loop<64, 64, 1, true>(O, mrun, lrun, qf, base + 256, nullptr, ld, base + 512, ld, t0, t1, wact, q0, 64, lds);
  if (wact) {
    const int lane2 = (tidx() & 63), r2 = lane2 & 31, h2 = lane2 >> 5;
    u16* bo = (u16*)(ws + OFF_BO) + (size_t)g * CT * 256;
    float* blse = (float*)(ws + OFF_BLSE) + (size_t)g * CT * 4;
#pragma unroll
    for (int j = 0; j < 2; ++j) {
      const float l = swapadd(lrun[j]);
      const size_t tok = (size_t)seq * SEQ + (size_t)(q0 + j * 32 + r2) * dil + res;
      store_o<2>(O[j], 1.f / l, bo + tok * 256 + head * 64, h2);
      if (h2 == 0) blse[tok * 4 + head] = mrun[j] + __builtin_amdgcn_logf(l);
    }
  }
}

__device__ __forceinline__ void phase_combine(const Params& p) {
  char* const ws = lws(p.ws);
  const u16* bo = (const u16*)(ws + OFF_BO);
  const float* blse = (const float*)(ws + OFF_BLSE);
  u16* outs = (u16*)(ws + OFF_OUTS);
  for (int i = blockIdx.x * 512 + tidx(); i < CT * 32; i += gridDim.x * 512) {
    const int tok = i >> 5, ch = i & 31, head = ch >> 3;
    float l0 = blse[(size_t)tok * 4 + head], l1 = blse[((size_t)CT + tok) * 4 + head], l2 = blse[((size_t)2 * CT + tok) * 4 + head];
    float mx = fmaxf(l0, fmaxf(l1, l2));
    float w0 = __builtin_amdgcn_exp2f(l0 - mx), w1 = __builtin_amdgcn_exp2f(l1 - mx), w2 = __builtin_amdgcn_exp2f(l2 - mx);
    float inv = 1.f / (w0 + w1 + w2); w0 *= inv; w1 *= inv; w2 *= inv;
    u32x4 a = *(const u32x4*)(bo + (size_t)tok * 256 + ch * 8);
    u32x4 b = *(const u32x4*)(bo + ((size_t)CT + tok) * 256 + ch * 8);
    u32x4 c = *(const u32x4*)(bo + ((size_t)2 * CT + tok) * 256 + ch * 8);
    unsigned aa[4] = {a[0], a[1], a[2], a[3]}, bb[4] = {b[0], b[1], b[2], b[3]}, cc[4] = {c[0], c[1], c[2], c[3]}, oo[4];
#pragma unroll
    for (int e = 0; e < 4; ++e) {
      float lo = w0 * bflo(aa[e]) + w1 * bflo(bb[e]) + w2 * bflo(cc[e]);
      float hi = w0 * bfhi(aa[e]) + w1 * bfhi(bb[e]) + w2 * bfhi(cc[e]);
      oo[e] = cvtpk(lo, hi);
    }
    u32x4 o = {oo[0], oo[1], oo[2], oo[3]};
    *(u32x4*)(outs + (size_t)tok * OUT_LD + 512 + ch * 8) = o;
  }
}

__device__ __forceinline__ void phase_merge(const Params& p, int layer, char* lds) {
  char* const ws = lws(p.ws);
  const u16* Wbr = (const u16*)(ws + OFF_WBR) + (size_t)layer * 1024 * 1792;
  const u16* Wg = (const u16*)(ws + OFF_WGATE) + (size_t)layer * 4096 * 1024;
  const u16* xn = (const u16*)(ws + OFF_XN);
  const u16* outs = (const u16*)(ws + OFF_OUTS);
  u16* merged = (u16*)(ws + OFF_MERGED);
  const int wid = wave_id(), wn = wid & 3, wm = wid >> 2;
  for (int t = blockIdx.x; t < 4 * 128; t += gridDim.x) {
    int nt, mt; tile_map(t, nt, mt);
    const int n0 = nt * 256, m0 = mt * 128;
    f32x16 mg[2][2];
#pragma unroll
    for (int i = 0; i < 2; ++i)
#pragma unroll
      for (int j = 0; j < 2; ++j)
#pragma unroll
        for (int e = 0; e < 16; ++e) mg[i][j][e] = 0.f;
    for (int br = 0; br < 4; ++br) {
      const int Kb = br == 1 ? 256 : 512;
      const int cofs = br == 0 ? 0 : (br == 1 ? 512 : (br == 2 ? 768 : 1280));
      f32x16 acc[2][2];
      gemm_core<2, 2, true>(acc, Wbr + (size_t)1024 * cofs + (size_t)n0 * Kb, Kb, outs + (size_t)m0 * OUT_LD + cofs, OUT_LD, Kb, lds);
      unsigned yp[2][2][8];
#pragma unroll
      for (int i = 0; i < 2; ++i)
#pragma unroll
        for (int j = 0; j < 2; ++j)
#pragma unroll
          for (int e = 0; e < 8; ++e) yp[i][j][e] = cvtpk(acc[i][j][2 * e], acc[i][j][2 * e + 1]);
      gemm_core<2, 2, true>(acc, Wg + (size_t)(br * 1024 + n0) * 1024, 1024, xn + (size_t)m0 * 1024, 1024, 1024, lds);
#pragma unroll
      for (int i = 0; i < 2; ++i)
#pragma unroll
        for (int j = 0; j < 2; ++j)
#pragma unroll
          for (int e = 0; e < 8; ++e) {
            float s0 = __builtin_amdgcn_rcpf(1.f + __builtin_amdgcn_exp2f(-acc[i][j][2 * e] * LOG2E));
            float s1 = __builtin_amdgcn_rcpf(1.f + __builtin_amdgcn_exp2f(-acc[i][j][2 * e + 1] * LOG2E));
            mg[i][j][2 * e] += s0 * bflo(yp[i][j][e]);
            mg[i][j][2 * e + 1] += s1 * bfhi(yp[i][j][e]);
          }
    }
    store_wave_bf16<2>(mg, merged + (size_t)(m0 + wm * 64) * 1024 + n0 + wn * 64, 1024, lds + wid * WAVE_LDS);
  }
}

__device__ __forceinline__ void phase_proj_res(const u16* __restrict__ Wt, const u16* __restrict__ act, int K, const float* resid, float* xout, char* lds) {
  const int wid = wave_id(), wn = wid & 3, wm = wid >> 2;
  for (int t = blockIdx.x; t < 4 * 128; t += gridDim.x) {
    int nt, mt; tile_map(t, nt, mt);
    const int n0 = nt * 256, m0 = mt * 128;
    f32x16 acc[2][2];
    gemm_core<2>(acc, Wt + (size_t)n0 * K, K, act + (size_t)m0 * K, K, K, lds);
    const size_t o = (size_t)(m0 + wm * 64) * DM + n0 + wn * 64;
    store_wave_f32_res(acc, resid + o, xout + o, lds + wid * WAVE_LDS);
  }
}

__device__ __forceinline__ void phase_ffn_up(const Params& p, int layer, char* lds) {
  char* const ws = lws(p.ws);
  const u16* Wgu = (const u16*)(ws + OFF_WGU) + (size_t)layer * NGU * 1024;
  const u16* xn = (const u16*)(ws + OFF_XN);
  u16* act = (u16*)(ws + OFF_ACT);
  const int wid = wave_id(), wn = wid & 3, wm = wid >> 2;
  for (int t = blockIdx.x; t < 22 * 128; t += gridDim.x) {
    int nt, mt; tile_map(t, nt, mt);
    const int n0 = nt * 256, m0 = mt * 128;
    f32x16 acc[2][2];
    gemm_core<2>(acc, Wgu + (size_t)n0 * 1024, 1024, xn + (size_t)m0 * 1024, 1024, 1024, lds);
    f32x16 a1[1][2];
#pragma unroll
    for (int j = 0; j < 2; ++j)
#pragma unroll
      for (int e = 0; e < 16; ++e) {
        float gte = acc[0][j][e];
        a1[0][j][e] = gte * __builtin_amdgcn_rcpf(1.f + __builtin_amdgcn_exp2f(-gte * LOG2E)) * acc[1][j][e];
      }
    store_wave_bf16<1>(a1, act + (size_t)(m0 + wm * 64) * DFF + (n0 >> 1) + wn * 32, DFF, lds + wid * WAVE_LDS);
  }
}

extern "C" __global__ void __launch_bounds__(512, 2) mega(Params p) {
  extern __shared__ __attribute__((aligned(16))) char lds[];
  cg::grid_group grid = cg::this_grid();
#define PWS lws(p.ws)
#define POUT ((float*)lws((char*)p.out))
  phase_w(p, lds);
  grid.sync();
#pragma nounroll
  for (int ch = 0; ch < NCH; ++ch) {
#pragma nounroll
    for (int layer = 0; layer < DEPTH; ++layer) {
      {
        const float* xin = ch == 0 ? p.in[0] : p.in[1] + (size_t)(ch - 1) * CT * DM;
        const float* xcur = layer == 0 ? xin : POUT + (size_t)ch * CT * DM;
        phase_norm(xcur, p.in[2] + layer * DM, (u16*)(PWS + OFF_XN));
      }
      grid.sync();
      phase_p1(p, layer, lds);
      grid.sync();
      phase_p1c(p, layer, lds);
      grid.sync();
#pragma nounroll
      for (int it = blockIdx.x; it < 1280; it += gridDim.x) {
        if (it < 256) attn_A(p, layer, it, lds);
        else if (it < 512) attn_C(p, layer, it - 256, lds);
        else if (it < 768) attn_D(p, layer, it - 512, lds);
        else attn_B(p, layer, it - 768, lds);
      }
      grid.sync();
      phase_combine(p);
      grid.sync();
      phase_merge(p, layer, lds);
      grid.sync();
      {
        const float* xin = ch == 0 ? p.in[0] : p.in[1] + (size_t)(ch - 1) * CT * DM;
        float* xo = POUT + (size_t)ch * CT * DM;
        const float* xcur = layer == 0 ? xin : xo;
        phase_proj_res((const u16*)(PWS + OFF_WO) + (size_t)layer * 1024 * 1024, (const u16*)(PWS + OFF_MERGED), 1024, xcur, xo, lds);
      }
      grid.sync();
      {
        phase_norm(POUT + (size_t)ch * CT * DM, p.in[25] + layer * DM, (u16*)(PWS + OFF_XN));
      }
      grid.sync();
      phase_ffn_up(p, layer, lds);
      grid.sync();
      {
        float* xo = POUT + (size_t)ch * CT * DM;
        phase_proj_res((const u16*)(PWS + OFF_WDN) + (size_t)layer * 1024 * DFF, (const u16*)(PWS + OFF_ACT), DFF, xo, xo, lds);
      }
      grid.sync();
    }
  }
}

extern "C" void kernel_launch(void* const* d_in, const int* in_sizes, int n_in, void* d_out, int out_size, void* d_ws, size_t ws_size, hipStream_t stream) {
  static int grid_blocks = 0;
  if (!grid_blocks) {
    int dev = 0, cus = 0, per_cu = 0;
    (void)hipGetDevice(&dev);
    (void)hipDeviceGetAttribute(&cus, hipDeviceAttributeMultiprocessorCount, dev);
    (void)hipFuncSetAttribute((const void*)mega, hipFuncAttributeMaxDynamicSharedMemorySize, (int)LDS_BYTES);
    (void)hipOccupancyMaxActiveBlocksPerMultiprocessor(&per_cu, mega, 512, LDS_BYTES);
    if (per_cu < 1) fprintf(stderr, "kernel_launch: occupancy query returned %d\n", per_cu);
    grid_blocks = cus > 0 ? cus : 256;
    if (ws_size < WS_END) fprintf(stderr, "kernel_launch: workspace too small: %zu < %zu\n", ws_size, (size_t)WS_END);
  }
  Params p{};
  for (int i = 0; i < 29; ++i) p.in[i] = (const float*)d_in[i];
  p.out = (float*)d_out;
  p.ws = (char*)d_ws;
  for (int i = 0; i < 32; ++i) p.inv64[i] = (float)pow(10000.0, -(double)i / 32.0);
  for (int i = 0; i < 16; ++i) p.inv32[i] = (float)pow(10000.0, -(double)i / 16.0);
  for (int l = 0; l < 2; ++l) {
    double li = 0.8 - 0.6 * exp(-0.3 * (double)l);
    p.lam_init[l] = (float)li;
    p.oml[l] = (float)(1.0 - li);
  }
  void* args[] = {&p};
  hipError_t e = hipLaunchCooperativeKernel((void*)mega, dim3(grid_blocks), dim3(512), args, LDS_BYTES, stream);
  if (e != hipSuccess) fprintf(stderr, "cooperative launch failed: %s (grid %d)\n", hipGetErrorString(e), grid_blocks);
}
```

```cpp
#include <hip/hip_runtime.h>
#include <hip/hip_cooperative_groups.h>
#include <cstdio>
#include <cmath>
namespace cg = cooperative_groups;

typedef unsigned short u16;
typedef short bf16x8 __attribute__((ext_vector_type(8)));
typedef short s16x4 __attribute__((ext_vector_type(4)));
typedef float f32x16 __attribute__((ext_vector_type(16)));
typedef float f32x4 __attribute__((ext_vector_type(4)));
typedef float f32x2 __attribute__((ext_vector_type(2)));
typedef unsigned u32x4 __attribute__((ext_vector_type(4)));
typedef unsigned u32x2 __attribute__((ext_vector_type(2)));
typedef __bf16 bf16x2_t __attribute__((ext_vector_type(2)));

#define DI __device__ __forceinline__
#define MFMA(a, b, c) __builtin_amdgcn_mfma_f32_32x32x16_bf16(a, b, c, 0, 0, 0)

constexpr int DM = 1024, SEQ = 4096, CT = 16384, NCH = 3, NINP = 5120, DFF = 2816, NGU = 5632;
constexpr int QKVC_LD = 2048, OUT_LD = 1792, DEPTH = 2;
constexpr float LOG2E = 1.4426950408889634f;
constexpr float QS64 = 0.125f * LOG2E, QS96 = 0.10206207261596575f * LOG2E;
constexpr float EPS = 1e-6f;
constexpr int PITCH = 144;
constexpr int WAVE_LDS = 17408;
constexpr size_t LDS_BYTES = 155648;

constexpr size_t al256(size_t x) { return (x + 255) / 256 * 256; }
constexpr size_t OFF_WIN = 0;
constexpr size_t OFF_WGATE = OFF_WIN + al256((size_t)DEPTH * NINP * 1024 * 2);
constexpr size_t OFF_WUQ = OFF_WGATE + al256((size_t)DEPTH * 4096 * 1024 * 2);
constexpr size_t OFF_WUKV = OFF_WUQ + al256((size_t)DEPTH * 768 * 256 * 2);
constexpr size_t OFF_WBR = OFF_WUKV + al256((size_t)DEPTH * 1024 * 128 * 2);
constexpr size_t OFF_WO = OFF_WBR + al256((size_t)DEPTH * 1024 * 1792 * 2);
constexpr size_t OFF_WGU = OFF_WO + al256((size_t)DEPTH * 1024 * 1024 * 2);
constexpr size_t OFF_WDN = OFF_WGU + al256((size_t)DEPTH * NGU * 1024 * 2);
constexpr size_t OFF_COS64 = OFF_WDN + al256((size_t)DEPTH * 1024 * DFF * 2);
constexpr size_t OFF_SIN64 = OFF_COS64 + (size_t)SEQ * 32 * 4;
constexpr size_t OFF_COS32 = OFF_SIN64 + (size_t)SEQ * 32 * 4;
constexpr size_t OFF_SIN32 = OFF_COS32 + (size_t)SEQ * 16 * 4;
constexpr size_t OFF_LAM = OFF_SIN32 + (size_t)SEQ * 16 * 4;
constexpr size_t OFF_BAR = OFF_LAM + 256;
constexpr size_t OFF_XN = OFF_BAR + 16384;
constexpr size_t OFF_QKV = OFF_XN + (size_t)CT * 1024 * 2;
constexpr size_t OFF_QKVC = OFF_QKV + (size_t)CT * NINP * 2;
constexpr size_t OFF_OUTS = OFF_QKVC + (size_t)CT * QKVC_LD * 2;
constexpr size_t OFF_BO = OFF_OUTS + (size_t)CT * OUT_LD * 2;
constexpr size_t OFF_BLSE = OFF_BO + (size_t)3 * CT * 256 * 2;
constexpr size_t WS_END = OFF_BLSE + (size_t)3 * CT * 4 * 4;
constexpr size_t OFF_MERGED = OFF_QKV;
constexpr size_t OFF_ACT = OFF_QKV + (size_t)CT * 1024 * 2;

struct Params {
  const float* in[29];
  float* out;
  char* ws;
  float inv64[32];
  float inv32[16];
  float lam_init[2];
  float oml[2];
  int pad[2];
};

DI int crow(int reg, int h) { return (reg & 3) + 8 * (reg >> 2) + 4 * h; }
DI unsigned cvtpk(float lo, float hi) {
  f32x2 f = {lo, hi};
  bf16x2_t b = __builtin_convertvector(f, bf16x2_t);
  return __builtin_bit_cast(unsigned, b);
}
DI float bflo(unsigned u) { return __uint_as_float(u << 16); }
DI float bfhi(unsigned u) { return __uint_as_float(u & 0xffff0000u); }
DI float swapadd(float x) {
  auto rr = __builtin_amdgcn_permlane32_swap(__float_as_uint(x), __float_as_uint(x), false, false);
  return __uint_as_float(rr[0]) + __uint_as_float(rr[1]);
}
DI float swapmax(float x) {
  auto rr = __builtin_amdgcn_permlane32_swap(__float_as_uint(x), __float_as_uint(x), false, false);
  return fmaxf(__uint_as_float(rr[0]), __uint_as_float(rr[1]));
}
DI int opaque(int x) { asm volatile("" : "+v"(x)); return x; }
DI int tidx() { return opaque((int)threadIdx.x); }
DI int wave_id() { return __builtin_amdgcn_readfirstlane(tidx() >> 6); }
DI char* lws(char* w) { asm volatile("" : "+s"(w)); return w; }
DI void lds_fence() { asm volatile("s_waitcnt lgkmcnt(0)" ::: "memory"); }
DI void tile_map(int t, int& nt, int& mt) {
  int round = t >> 8, b = t & 255, xcd = b & 7, slot = b >> 3;
  nt = round * 2 + (slot & 1);
  mt = xcd * 16 + (slot >> 1);
}

template <int NB, int AN = NB, bool LOWREG = false>
DI void gemm_core(f32x16 (&acc)[AN][2], const u16* __restrict__ Ag, int lda, const u16* __restrict__ Bg, int ldb, int K, char* lds) {
  constexpr int AR = 128 * NB;
  constexpr int ACH = AR * 8 / 512;
  constexpr int STAGE = (AR + 128) * PITCH;
  const int tid = tidx(), lane = tid & 63, wid = wave_id(), r = lane & 31, h = lane >> 5;
  const int wn = wid & 3, wm = wid >> 2;
  const int crow0 = tid >> 3, ccol = tid & 7;
  const __amdgpu_buffer_rsrc_t arsrc = __builtin_amdgcn_make_buffer_rsrc((void*)Ag, 0, 0x7fffffff, 0x00020000);
  const __amdgpu_buffer_rsrc_t brsrc = __builtin_amdgcn_make_buffer_rsrc((void*)Bg, 0, 0x7fffffff, 0x00020000);
  const int avo = (crow0 * lda + ccol * 8) * 2, bvo = (crow0 * ldb + ccol * 8) * 2;
  const int astep = 64 * lda * 2, bstep = 64 * ldb * 2;
  const int wofs = crow0 * PITCH + ccol * 16;
  const int aoff = (wn * 32 * NB + r) * PITCH + h * 16;
  const int boff = AR * PITCH + (wm * 64 + r) * PITCH + h * 16;
  const int nk = K >> 6;
  u32x4 ra[ACH], rb[2];
#pragma unroll
  for (int i = 0; i < NB; ++i)
#pragma unroll
    for (int j = 0; j < 2; ++j)
#pragma unroll
      for (int e = 0; e < 16; ++e) acc[i][j][e] = 0.f;
  __syncthreads();
#pragma unroll
  for (int i = 0; i < ACH; ++i) ra[i] = __builtin_amdgcn_raw_buffer_load_b128(arsrc, avo + i * astep, 0, 0);
#pragma unroll
  for (int i = 0; i < 2; ++i) rb[i] = __builtin_amdgcn_raw_buffer_load_b128(brsrc, bvo + i * bstep, 0, 0);
#pragma unroll
  for (int i = 0; i < ACH; ++i) *(u32x4*)(lds + wofs + i * 64 * PITCH) = ra[i];
#pragma unroll
  for (int i = 0; i < 2; ++i) *(u32x4*)(lds + AR * PITCH + wofs + i * 64 * PITCH) = rb[i];
  __syncthreads();
#pragma nounroll
  for (int kt = 0; kt < nk; ++kt) {
    const bool more = kt + 1 < nk;
    if (more) {
#pragma unroll
      for (int i = 0; i < ACH; ++i) ra[i] = __builtin_amdgcn_raw_buffer_load_b128(arsrc, avo + i * astep, (kt + 1) * 128, 0);
#pragma unroll
      for (int i = 0; i < 2; ++i) rb[i] = __builtin_amdgcn_raw_buffer_load_b128(brsrc, bvo + i * bstep, (kt + 1) * 128, 0);
    }
    const char* base = lds + (kt & 1) * STAGE;
    if (LOWREG) {
#pragma unroll
      for (int s = 0; s < 4; ++s) {
        bf16x8 af[NB], bfr[2];
#pragma unroll
        for (int i = 0; i < NB; ++i) af[i] = *(const bf16x8*)(base + aoff + i * 32 * PITCH + s * 32);
#pragma unroll
        for (int j = 0; j < 2; ++j) bfr[j] = *(const bf16x8*)(base + boff + j * 32 * PITCH + s * 32);
#pragma unroll
        for (int i = 0; i < NB; ++i)
#pragma unroll
          for (int j = 0; j < 2; ++j) acc[i][j] = MFMA(af[i], bfr[j], acc[i][j]);
      }
    } else {
    bf16x8 afA[NB], bfA[2], afB[NB], bfB[2];
#pragma unroll
    for (int i = 0; i < NB; ++i) afA[i] = *(const bf16x8*)(base + aoff + i * 32 * PITCH);
#pragma unroll
    for (int j = 0; j < 2; ++j) bfA[j] = *(const bf16x8*)(base + boff + j * 32 * PITCH);
    __builtin_amdgcn_sched_barrier(0);
#pragma unroll
    for (int s = 0; s < 4; s += 2) {
#pragma unroll
      for (int i = 0; i < NB; ++i) afB[i] = *(const bf16x8*)(base + aoff + i * 32 * PITCH + (s + 1) * 32);
#pragma unroll
      for (int j = 0; j < 2; ++j) bfB[j] = *(const bf16x8*)(base + boff + j * 32 * PITCH + (s + 1) * 32);
      __builtin_amdgcn_sched_barrier(0);
#pragma unroll
      for (int i = 0; i < NB; ++i)
#pragma unroll
        for (int j = 0; j < 2; ++j) acc[i][j] = MFMA(afA[i], bfA[j], acc[i][j]);
      __builtin_amdgcn_sched_barrier(0);
      if (s + 2 < 4) {
#pragma unroll
        for (int i = 0; i < NB; ++i) afA[i] = *(const bf16x8*)(base + aoff + i * 32 * PITCH + (s + 2) * 32);
#pragma unroll
        for (int j = 0; j < 2; ++j) bfA[j] = *(const bf16x8*)(base + boff + j * 32 * PITCH + (s + 2) * 32);
      }
      __builtin_amdgcn_sched_barrier(0);
#pragma unroll
      for (int i = 0; i < NB; ++i)
#pragma unroll
        for (int j = 0; j < 2; ++j) acc[i][j] = MFMA(afB[i], bfB[j], acc[i][j]);
      __builtin_amdgcn_sched_barrier(0);
    }
    }
    if (more) {
      char* nb = lds + ((kt + 1) & 1) * STAGE;
#pragma unroll
      for (int i = 0; i < ACH; ++i) *(u32x4*)(nb + wofs + i * 64 * PITCH) = ra[i];
#pragma unroll
      for (int i = 0; i < 2; ++i) *(u32x4*)(nb + AR * PITCH + wofs + i * 64 * PITCH) = rb[i];
    }
    __syncthreads();
  }
}

template <int NB, int AN = NB>
DI void store_wave_bf16(const f32x16 (&v)[AN][2], u16* __restrict__ wdst, int ldd, char* wl) {
  constexpr int TP = NB * 64 + 16;
  const int lane = (tidx() & 63), r = lane & 31, h = lane >> 5;
#pragma unroll
  for (int i = 0; i < NB; ++i)
#pragma unroll
    for (int j = 0; j < 2; ++j)
#pragma unroll
      for (int g = 0; g < 4; ++g) {
        u32x2 w = {cvtpk(v[i][j][4 * g], v[i][j][4 * g + 1]), cvtpk(v[i][j][4 * g + 2], v[i][j][4 * g + 3])};
        *(u32x2*)(wl + (j * 32 + r) * TP + (i * 32 + 8 * g + 4 * h) * 2) = w;
      }
  lds_fence();
  constexpr int CPR = NB * 4;
#pragma unroll
  for (int it = 0; it < CPR; ++it) {
    int c = lane + 64 * it, row = c / CPR, ch = c % CPR;
    u32x4 d = *(const u32x4*)(wl + row * TP + ch * 16);
    *(u32x4*)(wdst + (size_t)row * ldd + ch * 8) = d;
  }
  lds_fence();
}

DI void store_wave_f32_res(const f32x16 (&v)[2][2], const float* __restrict__ res, float* __restrict__ wdst, char* wl) {
  constexpr int TP = 272;
  const int lane = (tidx() & 63), r = lane & 31, h = lane >> 5;
#pragma unroll
  for (int i = 0; i < 2; ++i)
#pragma unroll
    for (int j = 0; j < 2; ++j)
#pragma unroll
      for (int g = 0; g < 4; ++g) {
        f32x4 w = {v[i][j][4 * g], v[i][j][4 * g + 1], v[i][j][4 * g + 2], v[i][j][4 * g + 3]};
        *(f32x4*)(wl + (j * 32 + r) * TP + (i * 32 + 8 * g + 4 * h) * 4) = w;
      }
  lds_fence();
#pragma unroll
  for (int it = 0; it < 16; ++it) {
    int c = lane + 64 * it, row = c >> 4, ch = c & 15;
    f32x4 d = *(const f32x4*)(wl + row * TP + ch * 16);
    f32x4 x = *(const f32x4*)(res + (size_t)row * DM + ch * 4);
    d += x;
    *(f32x4*)(wdst + (size_t)row * DM + ch * 4) = d;
  }
  lds_fence();
}

DI void norm_rope64(f32x16 (&v)[2][2], const float* __restrict__ gain, float scale, int pos0, const float* __restrict__ cs, const float* __restrict__ sn) {
  const int lane = (tidx() & 63), r = lane & 31, h = lane >> 5;
#pragma unroll
  for (int j = 0; j < 2; ++j) {
    float ss = 0.f;
#pragma unroll
    for (int e = 0; e < 16; ++e) ss += v[0][j][e] * v[0][j][e] + v[1][j][e] * v[1][j][e];
    ss = swapadd(ss);
    const float rstd = __builtin_amdgcn_rsqf(ss * (1.f / 64.f) + EPS);
    const int pos = pos0 + j * 32 + r;
#pragma unroll
    for (int g = 0; g < 4; ++g) {
      const int d = 8 * g + 4 * h;
      f32x4 c4 = *(const f32x4*)(cs + pos * 32 + d), s4 = *(const f32x4*)(sn + pos * 32 + d);
      f32x4 g1 = *(const f32x4*)(gain + d), g2 = *(const f32x4*)(gain + 32 + d);
#pragma unroll
      for (int e = 0; e < 4; ++e) {
        float x1 = v[0][j][4 * g + e] * rstd * g1[e], x2 = v[1][j][4 * g + e] * rstd * g2[e];
        v[0][j][4 * g + e] = (x1 * c4[e] - x2 * s4[e]) * scale;
        v[1][j][4 * g + e] = (x2 * c4[e] + x1 * s4[e]) * scale;
      }
    }
  }
}

DI void norm96_rope_store(f32x16 (&v)[3][2], const float* __restrict__ gain, float scale, int pos0, const float* __restrict__ cs, const float* __restrict__ sn,
                          u16* __restrict__ wdst, char* wl) {
  const int lane = (tidx() & 63), r = lane & 31, h = lane >> 5;
#pragma unroll
  for (int j = 0; j < 2; ++j) {
    float ss = 0.f;
#pragma unroll
    for (int i = 0; i < 3; ++i)
#pragma unroll
      for (int e = 0; e < 16; ++e) ss += v[i][j][e] * v[i][j][e];
    ss = swapadd(ss);
    const float rstd = __builtin_amdgcn_rsqf(ss * (1.f / 96.f) + EPS);
    const int pos = pos0 + j * 32 + r;
#pragma unroll
    for (int i = 0; i < 3; ++i)
#pragma unroll
      for (int g = 0; g < 4; ++g) {
        f32x4 g4 = *(const f32x4*)(gain + i * 32 + 8 * g + 4 * h);
#pragma unroll
        for (int e = 0; e < 4; ++e) v[i][j][4 * g + e] *= rstd * g4[e];
      }
#pragma unroll
    for (int g = 0; g < 2; ++g) {
      f32x4 c4 = *(const f32x4*)(cs + pos * 16 + 8 * g + 4 * h), s4 = *(const f32x4*)(sn + pos * 16 + 8 * g + 4 * h);
#pragma unroll
      for (int e = 0; e < 4; ++e) {
        float a = v[2][j][4 * g + e], b = v[2][j][4 * g + e + 8];
        v[2][j][4 * g + e] = a * c4[e] - b * s4[e];
        v[2][j][4 * g + e + 8] = b * c4[e] + a * s4[e];
      }
    }
#pragma unroll
    for (int i = 0; i < 3; ++i)
#pragma unroll
      for (int e = 0; e < 16; ++e) v[i][j][e] *= scale;
  }
  store_wave_bf16<3>(v, wdst, QKVC_LD, wl);
}

DI float row_ssq(const u16* __restrict__ p, int nchunk) {
  float ss = 0.f;
#pragma unroll 2
  for (int c = 0; c < nchunk; ++c) {
    u32x4 d = *(const u32x4*)(p + c * 8);
    unsigned w[4] = {d[0], d[1], d[2], d[3]};
#pragma unroll
    for (int e = 0; e < 4; ++e) { float a = bflo(w[e]), b = bfhi(w[e]); ss += a * a + b * b; }
  }
  return ss;
}

namespace pg8 {
#define PG8_LAS __attribute__((address_space(3)))
typedef unsigned short bf16_t;
typedef short bf16x8 __attribute__((ext_vector_type(8)));
typedef float f32x4 __attribute__((ext_vector_type(4)));
typedef unsigned u32x4 __attribute__((ext_vector_type(4)));
constexpr int BM = 256, BK = 64, HALF = 128, HTB = HALF * BK * 2  , STAGE_BYTES = 8 * HTB, NXCD = 8, WGM = 8;

__host__ __device__ __forceinline__ int lds_byte(int r, int c) { const int st = (r >> 4) * 2 + (c >> 5), rr = r & 15, cc = c & 31, ob = rr * 64 + cc * 2; return st * 1024 + (ob ^ (((ob >> 9) & 1) << 5)); }
__host__ __device__ __forceinline__ void stage_rc(int b, int& R, int& C) { const int st = b / 1024, sb = b % 1024, swz = sb ^ (((sb >> 9) & 1) << 5); R = (st >> 1) * 16 + swz / 64; C = (st & 1) * 32 + (swz % 64) / 2; }
__host__ __device__ __forceinline__ int perm32(int rho) { const int n = rho >> 4, i = rho & 15; return 8 * (i >> 2) + 4 * n + (i & 3); }

struct Unit { int pm, pn; };
struct Gemm { const bf16_t* A; const bf16_t* Bt; int M, N, K; };
struct StaticOrder {
    int nM, nN, nwg, G, c;
    __host__ __device__ void init(int M, int N, int G_, int c_) { nM = M / BM; nN = N / BM; nwg = nM * nN; G = G_; c = c_; }
    __host__ __device__ bool next(int i, Unit& u) const {
        const long L = (long)i * G + c; if (L >= nwg) return false;
        int wgid = (int)L; { const int q = nwg / NXCD, r = nwg % NXCD, xcd = wgid % NXCD, off = wgid / NXCD; wgid = (xcd < r ? xcd * (q + 1) : r * (q + 1) + (xcd - r) * q) + off; }
        const int nig = WGM * nN, gid = wgid / nig, fm = gid * WGM, gsz = (nM - fm) < WGM ? (nM - fm) : WGM;
        u.pm = fm + ((wgid % nig) % gsz); u.pn = (wgid % nig) / gsz; return true;
    }
    __device__ __forceinline__ void a_ready(const Unit&) const {}
    __device__ __forceinline__ void done(const Unit&) const {}
};
template <class Epi, class Sched, bool STAMP = false>
__device__ __forceinline__ void gemm_phase(PG8_LAS unsigned char* lds, const Gemm g, const Sched& S, const Epi& E, unsigned long long* stamps) {
    const int tid = tidx(), wid = __builtin_amdgcn_readfirstlane(tid >> 6), lane = tid & 63, wr = wid >> 2, wc = wid & 3, fr = lane & 15, fq = lane >> 4;
    const int K = g.K, nt = K / BK;
    int ts_lo = 0, ts_hi = 0, nts = 0; const unsigned long long rt_entry = STAMP ? (unsigned long long)wall_clock64() : 0ull;
#define PG8_STAMP() do { if (STAMP && wid == 0 && nts < 64) { const unsigned long long _c = (unsigned long long)clock64(); \
        ts_lo = (lane == nts) ? (int)(unsigned)_c : ts_lo; ts_hi = (lane == nts) ? (int)(unsigned)(_c >> 32) : ts_hi; ++nts; } } while (0)
    PG8_STAMP();
    unsigned voffA[2], voffB[2];
#pragma unroll
    for (int i = 0; i < 2; ++i) { int R, C; stage_rc(tid * 16 + i * 8192, R, C); const int Rb = Epi::PERM ? ((R & ~31) + perm32(R & 31)) : R;
        voffA[i] = (unsigned)(R * K + C) * 2u; voffB[i] = (unsigned)(Rb * K + C) * 2u; }
    const size_t kstep = (size_t)(BK * 2);
    const size_t hstep = (size_t)HALF * K * 2;
    const size_t tstep = 2 * hstep;
    const unsigned ldsw = (unsigned)wid * 1024u;
    const int aoff = lds_byte(wr * 64 + fr, fq * 8), boff = lds_byte(wc * 32 + fr, fq * 8);
#define PG8_SA(b, h) (((b) * 2 + (h)) * HTB)
#define PG8_SB(b, h) ((4 + (b) * 2 + (h)) * HTB)
#define PG8_STAGE(bufoff, gbase, voff) do { _Pragma("unroll") for (int _i = 0; _i < 2; ++_i) \
        __builtin_amdgcn_global_load_lds((const unsigned*)((const char*)(gbase) + (voff)[_i]), (PG8_LAS unsigned*)(lds + (bufoff) + ldsw + _i * 8192), 16, 0, 0); } while (0)
#define PG8_LDA(dst, b, h) do { _Pragma("unroll") for (int m = 0; m < 4; ++m) _Pragma("unroll") for (int k = 0; k < 2; ++k) dst[m][k] = *(const PG8_LAS bf16x8*)(lds + PG8_SA(b, h) + aoff + m * 2048 + k * 1024); } while (0)
#define PG8_LDB(dst, b, h) do { _Pragma("unroll") for (int n = 0; n < 2; ++n) _Pragma("unroll") for (int k = 0; k < 2; ++k) dst[n][k] = *(const PG8_LAS bf16x8*)(lds + PG8_SB(b, h) + boff + n * 2048 + k * 1024); } while (0)
#define PG8_MMA(ai, bj, At, Bt) do { __builtin_amdgcn_s_setprio(1); _Pragma("unroll") for (int m = 0; m < 4; ++m) _Pragma("unroll") for (int n = 0; n < 2; ++n) _Pragma("unroll") for (int k = 0; k < 2; ++k) \
        acc[ai][bj][m][n] = __builtin_amdgcn_mfma_f32_16x16x32_bf16(Bt[n][k], At[m][k], acc[ai][bj][m][n], 0, 0, 0); __builtin_amdgcn_s_setprio(0); } while (0)
#define PG8_WAIT_V(n) asm volatile("s_waitcnt vmcnt(" #n ")" ::: "memory")
#define PG8_WAIT_L(n) asm volatile("s_waitcnt lgkmcnt(" #n ")" ::: "memory")
#define PG8_BAR __builtin_amdgcn_s_barrier()
#define PG8_SCHED __builtin_amdgcn_sched_barrier(0)
    Unit cur, nxt; int ui = 0;
    if (!S.next(0, cur)) return;
    f32x4 acc[2][2][4][2];
#pragma unroll
    for (int a = 0; a < 2; ++a)
#pragma unroll
        for (int b = 0; b < 2; ++b)
#pragma unroll
            for (int m = 0; m < 4; ++m)
#pragma unroll
                for (int n = 0; n < 2; ++n) acc[a][b][m][n] = (f32x4){0.f, 0.f, 0.f, 0.f};
    bf16x8 At[4][2], B0[2][2], B1[2][2];
    const char* cA = (const char*)g.A + (size_t)cur.pm * tstep; const char* cB = (const char*)g.Bt + (size_t)cur.pn * tstep;
    S.a_ready(cur);
    PG8_STAGE(PG8_SB(0, 0), cB, voffB); PG8_STAGE(PG8_SA(0, 0), cA, voffA); PG8_STAGE(PG8_SB(0, 1), cB + hstep, voffB); PG8_STAGE(PG8_SA(0, 1), cA + hstep, voffA);
    if (wr == 1) PG8_BAR;
    PG8_WAIT_V(4); PG8_BAR;
    PG8_STAGE(PG8_SB(1, 0), cB + kstep, voffB); PG8_STAGE(PG8_SA(1, 0), cA + kstep, voffA); PG8_STAGE(PG8_SB(1, 1), cB + hstep + kstep, voffB);
    PG8_WAIT_V(6); PG8_BAR;
    PG8_STAMP();
    for (;;) {
        const bool has_next = S.next(ui + 1, nxt);
        const char* nA = has_next ? (const char*)g.A + (size_t)nxt.pm * tstep : cA; const char* nB = has_next ? (const char*)g.Bt + (size_t)nxt.pn * tstep : cB;
        for (int t = 0; t < nt; t += 2) {
            const bool last = (t == nt - 2);
            const char* a1 = cA + (size_t)(t + 1) * kstep;
            const char* a2 = last ? nA : cA + (size_t)(t + 2) * kstep; const char* b2 = last ? nB : cB + (size_t)(t + 2) * kstep;
            const char* a3 = a2 + kstep; const char* b3 = b2 + kstep;
            if (last && has_next) S.a_ready(nxt);
            PG8_LDB(B0, 0, 0); PG8_SCHED; PG8_LDA(At, 0, 0); PG8_STAGE(PG8_SA(1, 1), a1 + hstep, voffA);
            PG8_WAIT_L(8); PG8_BAR; PG8_WAIT_L(0); PG8_MMA(0, 0, At, B0); PG8_BAR; PG8_SCHED;
            PG8_LDB(B1, 0, 1); PG8_STAGE(PG8_SB(0, 0), b2, voffB);
            PG8_BAR; PG8_WAIT_L(0); PG8_MMA(0, 1, At, B1); PG8_BAR;
            PG8_LDA(At, 0, 1); PG8_STAGE(PG8_SA(0, 0), a2, voffA);
            PG8_BAR; PG8_WAIT_L(0); PG8_MMA(1, 0, At, B0); PG8_BAR; PG8_SCHED;
            PG8_STAGE(PG8_SB(0, 1), b2 + hstep, voffB);
            PG8_WAIT_V(6); PG8_BAR; PG8_MMA(1, 1, At, B1); PG8_BAR;
            PG8_LDB(B0, 1, 0); PG8_SCHED; PG8_LDA(At, 1, 0); PG8_STAGE(PG8_SA(0, 1), a2 + hstep, voffA);
            PG8_WAIT_L(8); PG8_BAR; PG8_WAIT_L(0); PG8_MMA(0, 0, At, B0); PG8_BAR; PG8_SCHED;
            PG8_LDB(B1, 1, 1); PG8_STAGE(PG8_SB(1, 0), b3, voffB);
            PG8_BAR; PG8_WAIT_L(0); PG8_MMA(0, 1, At, B1); PG8_BAR;
            PG8_LDA(At, 1, 1); PG8_STAGE(PG8_SA(1, 0), a3, voffA);
            PG8_BAR; PG8_WAIT_L(0); PG8_MMA(1, 0, At, B0); PG8_BAR; PG8_SCHED;
            PG8_STAGE(PG8_SB(1, 1), b3 + hstep, voffB);
            PG8_WAIT_V(6); PG8_BAR; PG8_MMA(1, 1, At, B1); PG8_BAR;
        }
        PG8_STAMP();
        if constexpr (!Epi::AFTER_DRAIN) { E(acc, cur, wr, wc, fr, fq); S.done(cur); }
        PG8_STAMP();
        if (!has_next) break;
#pragma unroll
        for (int a = 0; a < 2; ++a)
#pragma unroll
            for (int b = 0; b < 2; ++b)
#pragma unroll
                for (int m = 0; m < 4; ++m)
#pragma unroll
                    for (int n = 0; n < 2; ++n) acc[a][b][m][n] = (f32x4){0.f, 0.f, 0.f, 0.f};
        cur = nxt; cA = nA; cB = nB; ++ui;
    }
    PG8_WAIT_V(0);
    if (wr == 0) PG8_BAR;
    PG8_BAR;
    if constexpr (Epi::AFTER_DRAIN) { E.fused(acc, cur, wr, wc, fr, fq, lds, wid, lane); S.done(cur); }
    PG8_STAMP();
    if (STAMP && wid == 0) { stamps[lane] = lane < nts ? (((unsigned long long)(unsigned)ts_hi << 32) | (unsigned)ts_lo) : 0ull;
        if (lane == 62) stamps[62] = rt_entry; if (lane == 63) stamps[63] = (unsigned long long)wall_clock64(); }
#undef PG8_STAMP
#undef PG8_SA
#undef PG8_SB
#undef PG8_STAGE
#undef PG8_LDA
#undef PG8_LDB
#undef PG8_MMA
#undef PG8_WAIT_V
#undef PG8_WAIT_L
#undef PG8_BAR
#undef PG8_SCHED
}
}

DI float quadsum(float x) {
  auto rr = __builtin_amdgcn_permlane16_swap(__float_as_uint(x), __float_as_uint(x), false, false);
  x = __uint_as_float(rr[0]) + __uint_as_float(rr[1]);
  return swapadd(x);
}
struct EpiP1 {
  static constexpr bool PERM = true, AFTER_DRAIN = false;
  u16* qkv; const float* cs; const float* sn; const float* const* in; int layer;
  DI void operator()(const pg8::f32x4 (&acc)[2][2][4][2], const pg8::Unit& u, int wr, int wc, int fr_, int fq_) const {
    const int lane = tidx() & 63, fr = lane & 15, fq = lane >> 4;
    const int n64 = u.pn * 4 + wc;
    const float* gain = nullptr; float scale = 1.f;
    if (n64 < 8) { gain = in[5] + layer * 64; scale = QS64; }
    else if (n64 < 16) { gain = in[6] + layer * 64; }
    else if (n64 < 24) {}
    else if (n64 < 60) {
      int tt = n64 - 24, g = tt / 12, jj = (tt % 12) >> 2;
      if (jj == 0) { gain = in[9] + (layer * 3 + g) * 64; scale = QS64; }
      else if (jj == 1) { gain = in[10] + (layer * 3 + g) * 64; }
    }
    else if (n64 < 68) { gain = in[17] + layer * 64; scale = QS64; }
    else if (n64 < 70) { gain = in[18] + layer * 64; }
#pragma unroll
    for (int ai = 0; ai < 2; ++ai)
#pragma unroll
      for (int m = 0; m < 4; ++m) {
        const int row = u.pm * 256 + ai * 128 + wr * 64 + m * 16 + fr;
        f32x4 v[2][2];
#pragma unroll
        for (int bj = 0; bj < 2; ++bj)
#pragma unroll
          for (int n = 0; n < 2; ++n) v[bj][n] = acc[ai][bj][m][n];
        if (gain) {
          float ss = 0.f;
#pragma unroll
          for (int bj = 0; bj < 2; ++bj)
#pragma unroll
            for (int n = 0; n < 2; ++n)
#pragma unroll
              for (int e = 0; e < 4; ++e) ss += v[bj][n][e] * v[bj][n][e];
          ss = quadsum(ss);
          const float rstd = __builtin_amdgcn_rsqf(ss * (1.f / 64.f) + EPS);
          const int pos = row & (SEQ - 1);
#pragma unroll
          for (int n = 0; n < 2; ++n) {
            const int d = 8 * fq + 4 * n;
            f32x4 c4 = *(const f32x4*)(cs + pos * 32 + d), s4 = *(const f32x4*)(sn + pos * 32 + d);
            f32x4 g1 = *(const f32x4*)(gain + d), g2 = *(const f32x4*)(gain + 32 + d);
#pragma unroll
            for (int e = 0; e < 4; ++e) {
              float x1 = v[0][n][e] * rstd * g1[e], x2 = v[1][n][e] * rstd * g2[e];
              v[0][n][e] = (x1 * c4[e] - x2 * s4[e]) * scale;
              v[1][n][e] = (x2 * c4[e] + x1 * s4[e]) * scale;
            }
          }
        }
        u16* rowp = qkv + (size_t)row * NINP + n64 * 64 + 8 * fq;
#pragma unroll
        for (int bj = 0; bj < 2; ++bj) {
          u32x4 w = {cvtpk(v[bj][0][0], v[bj][0][1]), cvtpk(v[bj][0][2], v[bj][0][3]), cvtpk(v[bj][1][0], v[bj][1][1]), cvtpk(v[bj][1][2], v[bj][1][3])};
          *(u32x4*)(rowp + bj * 32) = w;
        }
      }
  }
};
struct EpiRes {
  static constexpr bool PERM = false, AFTER_DRAIN = false;
  const float* resid; float* out;
  DI void operator()(const pg8::f32x4 (&acc)[2][2][4][2], const pg8::Unit& u, int wr, int wc, int fr_, int fq_) const {
    const int lane = tidx() & 63, fr = lane & 15, fq = lane >> 4;
#pragma unroll
    for (int ai = 0; ai < 2; ++ai)
#pragma unroll
      for (int m = 0; m < 4; ++m) {
        const size_t o = (size_t)(u.pm * 256 + ai * 128 + wr * 64 + m * 16 + fr) * DM + u.pn * 256 + wc * 32 + 4 * fq;
#pragma unroll
        for (int bj = 0; bj < 2; ++bj)
#pragma unroll
          for (int n = 0; n < 2; ++n) {
            f32x4 x = *(const f32x4*)(resid + o + bj * 128 + n * 16);
            *(f32x4*)(out + o + bj * 128 + n * 16) = x + acc[ai][bj][m][n];
          }
      }
  }
};
struct EpiSwiglu {
  static constexpr bool PERM = true, AFTER_DRAIN = false;
  u16* act;
  DI void operator()(const pg8::f32x4 (&acc)[2][2][4][2], const pg8::Unit& u, int wr, int wc, int fr_, int fq_) const {
    const int lane = tidx() & 63, fr = lane & 15, fq = lane >> 4;
#pragma unroll
    for (int ai = 0; ai < 2; ++ai)
#pragma unroll
      for (int m = 0; m < 4; ++m) {
        const int row = u.pm * 256 + ai * 128 + wr * 64 + m * 16 + fr;
        float a[8];
#pragma unroll
        for (int n = 0; n < 2; ++n)
#pragma unroll
          for (int e = 0; e < 4; ++e) {
            float gte = acc[ai][0][m][n][e];
            a[4 * n + e] = gte * __builtin_amdgcn_rcpf(1.f + __builtin_amdgcn_exp2f(-gte * LOG2E)) * acc[ai][1][m][n][e];
          }
        u32x4 w = {cvtpk(a[0], a[1]), cvtpk(a[2], a[3]), cvtpk(a[4], a[5]), cvtpk(a[6], a[7])};
        *(u32x4*)(act + (size_t)row * DFF + u.pn * 128 + wc * 32 + 8 * fq) = w;
      }
  }
};

DI void repack_tile(const float* __restrict__ src, const float* __restrict__ src2, int nsrc, u16* __restrict__ dst, int K, int n0, int k0, int mode,
                    const float* __restrict__ gain, char* lds) {
  float* tile = (float*)lds;
  const int tid = tidx();
  {
    const int nn = tid & 63, kk0 = tid >> 6;
    const int np = n0 + nn;
    const float* s = src; int col = np; bool valid = true;
    if (mode == 1) {
      const int rho = np & 255, lg = ((np >> 8) * 4 + ((rho >> 5) & 3)) * 64 + 32 * (rho >> 7) + (rho & 31);
      if (lg < 3840) col = lg; else if (lg < 4608) col = 4256 + (lg - 3840); else if (lg < 5024) col = 3840 + (lg - 4608); else valid = false;
    } else if (mode == 2) {
      const int rho = np & 255;
      col = (np >> 8) * 128 + (rho & 127);
      if (rho >= 128) s = src2;
    }
#pragma unroll
    for (int i = 0; i < 8; ++i) {
      int kk = kk0 + 8 * i;
      float v = valid ? s[(size_t)(k0 + kk) * nsrc + col] : 0.f;
      if (gain) v *= gain[k0 + kk];
      tile[kk * 65 + nn] = v;
    }
  }
  __syncthreads();
  {
    const int n = tid >> 3, kc = (tid & 7) * 8;
    float f[8];
#pragma unroll
    for (int i = 0; i < 8; ++i) f[i] = tile[(kc + i) * 65 + n];
    u32x4 w = {cvtpk(f[0], f[1]), cvtpk(f[2], f[3]), cvtpk(f[4], f[5]), cvtpk(f[6], f[7])};
    *(u32x4*)(dst + (size_t)(n0 + n) * K + k0 + kc) = w;
  }
  __syncthreads();
}

DI void sincos_acc(float ang, float& c, float& s) {
  double a = (double)ang;
  double t = a * 0.15915494309189535;
  double fr = t - rint(t);
  double x = fr * 6.283185307179586;
  double x2 = x * x;
  double ts = x, tc = 1.0, ssum = x, csum = 1.0;
  for (int n = 1; n <= 14; ++n) {
    tc *= -x2 / (double)((2 * n - 1) * (2 * n));
    ts *= -x2 / (double)((2 * n) * (2 * n + 1));
    csum += tc; ssum += ts;
  }
  c = (float)csum; s = (float)ssum;
}

__device__ __forceinline__ void phase_w(const Params& p, char* lds) {
  char* const ws = lws(p.ws);
  constexpr int PER_LAYER = 5200;
  for (int t = blockIdx.x; t < PER_LAYER * DEPTH; t += gridDim.x) {
    const int l = t / PER_LAYER; int u = t % PER_LAYER;
    if (u < 1280) {
      repack_tile(p.in[3] + (size_t)l * 1024 * 5024, nullptr, 5024, (u16*)(ws + OFF_WIN) + (size_t)l * NINP * 1024, 1024, (u >> 4) * 64, (u & 15) * 64, 1, nullptr, lds);
      continue;
    }
    u -= 1280;
    if (u < 1024) {
      repack_tile(p.in[4] + (size_t)l * 1024 * 4096, nullptr, 4096, (u16*)(ws + OFF_WGATE) + (size_t)l * 4096 * 1024, 1024, (u >> 4) * 64, (u & 15) * 64, 0, nullptr, lds);
      continue;
    }
    u -= 1024;
    if (u < 48) {
      repack_tile(p.in[13] + (size_t)l * 256 * 768, nullptr, 768, (u16*)(ws + OFF_WUQ) + (size_t)l * 768 * 256, 256, (u >> 2) * 64, (u & 3) * 64, 0, p.in[11] + l * 256, lds);
      continue;
    }
    u -= 48;
    if (u < 32) {
      repack_tile(p.in[14] + (size_t)l * 128 * 1024, nullptr, 1024, (u16*)(ws + OFF_WUKV) + (size_t)l * 1024 * 128, 128, (u >> 1) * 64, (u & 1) * 64, 0, p.in[12] + l * 128, lds);
      continue;
    }
    u -= 32;
    if (u < 448) {
      u16* wbr = (u16*)(ws + OFF_WBR) + (size_t)l * 1024 * 1792;
      if (u < 128) repack_tile(p.in[20] + (size_t)l * 512 * 1024, nullptr, 1024, wbr, 512, (u >> 3) * 64, (u & 7) * 64, 0, nullptr, lds);
      else if (u < 192) { u -= 128; repack_tile(p.in[21] + (size_t)l * 256 * 1024, nullptr, 1024, wbr + 1024 * 512, 256, (u >> 2) * 64, (u & 3) * 64, 0, nullptr, lds); }
      else if (u < 320) { u -= 192; repack_tile(p.in[22] + (size_t)l * 512 * 1024, nullptr, 1024, wbr + 1024 * 768, 512, (u >> 3) * 64, (u & 7) * 64, 0, nullptr, lds); }
      else { u -= 320; repack_tile(p.in[23] + (size_t)l * 512 * 1024, nullptr, 1024, wbr + 1024 * 1280, 512, (u >> 3) * 64, (u & 7) * 64, 0, nullptr, lds); }
      continue;
    }
    u -= 448;
    if (u < 256) {
      repack_tile(p.in[24] + (size_t)l * 1024 * 1024, nullptr, 1024, (u16*)(ws + OFF_WO) + (size_t)l * 1024 * 1024, 1024, (u >> 4) * 64, (u & 15) * 64, 0, nullptr, lds);
      continue;
    }
    u -= 256;
    if (u < 1408) {
      repack_tile(p.in[26] + (size_t)l * 1024 * DFF, p.in[27] + (size_t)l * 1024 * DFF, DFF, (u16*)(ws + OFF_WGU) + (size_t)l * NGU * 1024, 1024, (u >> 4) * 64, (u & 15) * 64, 2, nullptr, lds);
      continue;
    }
    u -= 1408;
    repack_tile(p.in[28] + (size_t)l * DFF * 1024, nullptr, 1024, (u16*)(ws + OFF_WDN) + (size_t)l * 1024 * DFF, DFF, (u / 44) * 64, (u % 44) * 64, 0, nullptr, lds);
  }
  const int gt = blockIdx.x * 512 + tidx(), ngt = gridDim.x * 512;
  float* c64 = (float*)(ws + OFF_COS64); float* s64 = (float*)(ws + OFF_SIN64);
  float* c32 = (float*)(ws + OFF_COS32); float* s32 = (float*)(ws + OFF_SIN32);
  for (int i = gt; i < SEQ * 32; i += ngt) {
    int pos = i >> 5, f = i & 31; float c, s;
    sincos_acc((float)pos * p.inv64[f], c, s);
    c64[i] = c; s64[i] = s;
  }
  for (int i = gt; i < SEQ * 16; i += ngt) {
    int pos = i >> 4, f = i & 15; float c, s;
    sincos_acc((float)pos * p.inv32[f], c, s);
    c32[i] = c; s32[i] = s;
  }
  if (blockIdx.x == 0)
    for (int i = tidx(); i < 3456; i += 512) __hip_atomic_store((unsigned*)(ws + OFF_BAR) + i, 0u, __ATOMIC_RELAXED, __HIP_MEMORY_SCOPE_AGENT);
  if (gt < DEPTH) {
    const float* lp = p.in[7] + gt * 256;
    float a = 0.f, b = 0.f;
    for (int i = 0; i < 64; ++i) { a += lp[i] * lp[64 + i]; b += lp[128 + i] * lp[192 + i]; }
    ((float*)(ws + OFF_LAM))[gt] = expf(a) - expf(b) + p.lam_init[gt];
  }
}

__device__ __forceinline__ void phase_norm(const float* __restrict__ x, const float* __restrict__ g, u16* __restrict__ xn) {
  const int lane = tidx() & 63, wid = wave_id();
  for (int row = blockIdx.x * 8 + wid; row < CT; row += gridDim.x * 8) {
    const f32x4* xr = (const f32x4*)(x + (size_t)row * DM);
    f32x4 v[4]; float ss = 0.f;
#pragma unroll
    for (int i = 0; i < 4; ++i) { v[i] = xr[lane + 64 * i]; ss += v[i][0] * v[i][0] + v[i][1] * v[i][1] + v[i][2] * v[i][2] + v[i][3] * v[i][3]; }
    ss = swapadd(ss);
#pragma unroll
    for (int o = 16; o >= 1; o >>= 1) ss += __int_as_float(__builtin_amdgcn_ds_bpermute((lane ^ o) << 2, __float_as_int(ss)));
    const float rstd = __builtin_amdgcn_rsqf(ss * (1.f / 1024.f) + EPS);
#pragma unroll
    for (int i = 0; i < 4; ++i) {
      f32x4 g4 = ((const f32x4*)g)[lane + 64 * i];
      u32x2 w = {cvtpk(v[i][0] * rstd * g4[0], v[i][1] * rstd * g4[1]), cvtpk(v[i][2] * rstd * g4[2], v[i][3] * rstd * g4[3])};
      *(u32x2*)(xn + (size_t)row * DM + (lane + 64 * i) * 4) = w;
    }
  }
}

__device__ __forceinline__ void phase_p1(const Params& p, int layer, char* lds) {
  char* const ws = lws(p.ws);
  pg8::Gemm g{(const u16*)(ws + OFF_XN), (const u16*)(ws + OFF_WIN) + (size_t)layer * NINP * 1024, CT, NINP, 1024};
  pg8::StaticOrder S; S.init(CT, NINP, gridDim.x, blockIdx.x);
  EpiP1 E{(u16*)(ws + OFF_QKV), (const float*)(ws + OFF_COS64), (const float*)(ws + OFF_SIN64), p.in, layer};
  __syncthreads();
  pg8::gemm_phase<EpiP1, pg8::StaticOrder, false>((PG8_LAS unsigned char*)lds, g, S, E, nullptr);
}

__device__ __forceinline__ void phase_p1c(const Params& p, int layer, char* lds) {
  char* const ws = lws(p.ws);
  const u16* Wuq = (const u16*)(ws + OFF_WUQ) + (size_t)layer * 768 * 256;
  const u16* Wukv = (const u16*)(ws + OFF_WUKV) + (size_t)layer * 1024 * 128;
  const u16* qkv = (const u16*)(ws + OFF_QKV);
  u16* qc = (u16*)(ws + OFF_QKVC);
  const float* c32 = (const float*)(ws + OFF_COS32); const float* s32 = (const float*)(ws + OFF_SIN32);
  const int tid = tidx(), wid = wave_id(), wn = wid & 3, wm = wid >> 2;
  char* wl = lds + wid * WAVE_LDS;
  for (int t = blockIdx.x; t < 2 * 128; t += gridDim.x) {
    int nt, mt; tile_map(t, nt, mt);
    const int n0 = nt * 384, m0 = mt * 128;
    f32x16 acc[3][2];
    gemm_core<3>(acc, Wuq + (size_t)n0 * 256, 256, qkv + (size_t)m0 * NINP + 4608, NINP, 256, lds);
    const int lane2 = (tidx() & 63), r = lane2 & 31, h = lane2 >> 5;
#pragma unroll
    for (int j = 0; j < 2; ++j) {
      const int m = m0 + wm * 64 + j * 32 + r;
      float ss = swapadd(row_ssq(qkv + (size_t)m * NINP + 4608 + h * 128, 16));
      const float rq = __builtin_amdgcn_rsqf(ss * (1.f / 256.f) + EPS);
#pragma unroll
      for (int i = 0; i < 3; ++i)
#pragma unroll
        for (int e = 0; e < 16; ++e) acc[i][j][e] *= rq;
    }
    norm96_rope_store(acc, p.in[15] + layer * 96, QS96, (m0 + wm * 64) & (SEQ - 1), c32, s32, qc + (size_t)(m0 + wm * 64) * QKVC_LD + n0 + wn * 96, wl);
  }
  for (int t = blockIdx.x; t < 4 * 128; t += gridDim.x) {
    int nt, mt; tile_map(t, nt, mt);
    const int n0 = nt * 256, m0 = mt * 128;
    f32x16 acc[3][2];
    gemm_core<2, 3>(acc, Wukv + (size_t)n0 * 128, 128, qkv + (size_t)m0 * NINP + 4864, NINP, 128, lds);
    const int n64 = (n0 >> 6) + wn, head = n64 >> 1, isv = n64 & 1;
    const int lane2 = (tidx() & 63), r = lane2 & 31, h = lane2 >> 5;
#pragma unroll
    for (int j = 0; j < 2; ++j) {
      const int m = m0 + wm * 64 + j * 32 + r;
      float ss = swapadd(row_ssq(qkv + (size_t)m * NINP + 4864 + h * 64, 8));
      const float rk = __builtin_amdgcn_rsqf(ss * (1.f / 128.f) + EPS);
#pragma unroll
      for (int i = 0; i < 2; ++i)
#pragma unroll
        for (int e = 0; e < 16; ++e) acc[i][j][e] *= rk;
    }
    if (isv) {
      store_wave_bf16<2, 3>(acc, qc + (size_t)(m0 + wm * 64) * QKVC_LD + 1536 + head * 64, QKVC_LD, wl);
    } else {
      f32x16 (&y)[3][2] = acc;
#pragma unroll
      for (int j = 0; j < 2; ++j) {
        const int m = m0 + wm * 64 + j * 32 + r;
#pragma unroll
        for (int g = 0; g < 4; ++g) {
          u32x2 d = *(const u32x2*)(qkv + (size_t)m * NINP + 4992 + 8 * g + 4 * h);
          y[2][j][4 * g] = bflo(d[0]); y[2][j][4 * g + 1] = bfhi(d[0]); y[2][j][4 * g + 2] = bflo(d[1]); y[2][j][4 * g + 3] = bfhi(d[1]);
        }
      }
      norm96_rope_store(y, p.in[16] + layer * 96, 1.f, (m0 + wm * 64) & (SEQ - 1), c32, s32, qc + (size_t)(m0 + wm * 64) * QKVC_LD + 768 + head * 96, wl);
    }
  }
}

constexpr int QLDS_OFF = 77824, QLDS_WAVE = 64 * 144;
template <int DQK, int DV, int NKT, bool BANDED, bool QLDS = false>
DI void attn_loop(f32x16 (&O)[2][DV / 32], float (&mrun)[2], float (&lrun)[2], const bf16x8 (&qf)[2][DQK / 16],
                  const u16* __restrict__ k0p, const u16* __restrict__ k1p, size_t kld, const u16* __restrict__ vp, size_t vld,
                  int t0, int t1, bool wact, int qbase, int W, char* lds) {
  constexpr int KP = DQK * 2 + 16, VP = DV * 2 + 64;
  constexpr int KC = DQK / 8, VC = DV / 8;
  constexpr int KTOT = NKT * 64 * KC, VTOT = 64 * VC, TOT = KTOT + VTOT, NIT = (TOT + 511) / 512;
  constexpr int SB = NKT * 64 * KP + 64 * VP;
  constexpr float THR = 8.f;
  const int tid = tidx(), lane = tid & 63, r = lane & 31, h = lane >> 5;
  const int dk1 = NKT == 2 ? (int)(k1p - k0p) : 0, dvo = (int)(vp - k0p);
  const int ldi = (int)kld;
  int soff[NIT]; int doff[NIT]; bool sval[NIT];
#pragma unroll
  for (int it = 0; it < NIT; ++it) {
    const int c = tid + it * 512;
    const bool allK = (it + 1) * 512 <= KTOT, allV = it * 512 >= KTOT;
    const bool isK = allK ? true : (allV ? false : (c < KTOT));
    const int kt = c / (64 * KC), rem = c % (64 * KC), krow = rem / KC, kcol = rem % KC;
    const int c2 = c - KTOT, vrow = c2 / VC, vcol = c2 % VC;
    const int so_k = (kt ? dk1 : 0) + krow * ldi + kcol * 8, do_k = kt * 64 * KP + krow * KP + kcol * 16;
    const int so_v = dvo + vrow * ldi + vcol * 8, do_v = NKT * 64 * KP + vrow * VP + vcol * 16;
    soff[it] = isK ? so_k : so_v;
    doff[it] = isK ? do_k : do_v;
    sval[it] = ((it + 1) * 512 <= TOT) ? true : (c < TOT);
  }
  u32x4 rg[NIT];
  const __amdgpu_buffer_rsrc_t krsrc = __builtin_amdgcn_make_buffer_rsrc((void*)k0p, 0, 0x7fffffff, 0x00020000);
  const int kaddr = r * KP + h * 16;
  const char* const qlds = lds + QLDS_OFF + wave_id() * QLDS_WAVE + r * 144 + h * 16;
  const int vaddr = NKT * 64 * KP + (4 * h + ((lane & 15) >> 2)) * VP + (((lane >> 4) & 1) * 16 + (lane & 3) * 4) * 2;
  if (t1 <= t0) return;
  __syncthreads();
#pragma unroll
  for (int it = 0; it < NIT; ++it) if (sval[it]) rg[it] = __builtin_amdgcn_raw_buffer_load_b128(krsrc, soff[it] * 2, t0 * 128 * ldi, 0);
#pragma unroll
  for (int it = 0; it < NIT; ++it) if (sval[it]) *(u32x4*)(lds + doff[it]) = rg[it];
  __syncthreads();
#pragma nounroll
  for (int t = t0; t < t1; ++t) {
    const int buf = (t - t0) & 1;
    const bool more = t + 1 < t1;
    if (more && NKT == 1) {
#pragma unroll
      for (int it = 0; it < NIT; ++it) if (sval[it]) rg[it] = __builtin_amdgcn_raw_buffer_load_b128(krsrc, soff[it] * 2, (t + 1) * 128 * ldi, 0);
    }
    bool doit = wact;
    if (BANDED) doit = wact && (t * 64 + 63 >= qbase - W) && (t * 64 <= qbase + 63 + W);
    if (doit) {
      const char* base = lds + buf * SB;
      bf16x8 pf[2][4];
      if (NKT == 1) {
        f32x16 S[2][2];
#pragma unroll
        for (int j = 0; j < 2; ++j)
#pragma unroll
          for (int kb = 0; kb < 2; ++kb)
#pragma unroll
            for (int e = 0; e < 16; ++e) S[j][kb][e] = 0.f;
#pragma unroll
        for (int s = 0; s < DQK / 16; ++s)
#pragma unroll
          for (int kb = 0; kb < 2; ++kb) {
            bf16x8 kf = *(const bf16x8*)(base + kaddr + kb * 32 * KP + s * 32);
#pragma unroll
            for (int j = 0; j < 2; ++j) S[j][kb] = MFMA(kf, qf[j][s], S[j][kb]);
          }
#pragma unroll
        for (int j = 0; j < 2; ++j) {
          if (BANDED) {
            const int qi = qbase + j * 32 + r;
#pragma unroll
            for (int kb = 0; kb < 2; ++kb)
#pragma unroll
              for (int e = 0; e < 16; ++e) {
                int ki = t * 64 + kb * 32 + crow(e, h);
                int dd = qi - ki; dd = dd < 0 ? -dd : dd;
                if (dd > W) S[j][kb][e] = -1e30f;
              }
          }
          float pmax = S[j][0][0];
#pragma unroll
          for (int e = 1; e < 16; ++e) pmax = fmaxf(pmax, S[j][0][e]);
#pragma unroll
          for (int e = 0; e < 16; ++e) pmax = fmaxf(pmax, S[j][1][e]);
          pmax = swapmax(pmax);
          if (!__all(pmax - mrun[j] <= THR)) {
            float mn = fmaxf(mrun[j], pmax);
            float alpha = __builtin_amdgcn_exp2f(mrun[j] - mn);
            mrun[j] = mn; lrun[j] *= alpha;
#pragma unroll
            for (int d = 0; d < DV / 32; ++d)
#pragma unroll
              for (int e = 0; e < 16; ++e) O[j][d][e] *= alpha;
          }
          float ps = 0.f; const float mm = mrun[j];
#pragma unroll
          for (int kb = 0; kb < 2; ++kb)
#pragma unroll
            for (int e = 0; e < 16; ++e) { float pv = __builtin_amdgcn_exp2f(S[j][kb][e] - mm); S[j][kb][e] = pv; ps += pv; }
          lrun[j] += ps;
#pragma unroll
          for (int ks = 0; ks < 4; ++ks) {
            const int kb = ks >> 1, b8 = (ks & 1) * 8;
            u32x4 w = {cvtpk(S[j][kb][b8], S[j][kb][b8 + 1]), cvtpk(S[j][kb][b8 + 2], S[j][kb][b8 + 3]),
                       cvtpk(S[j][kb][b8 + 4], S[j][kb][b8 + 5]), cvtpk(S[j][kb][b8 + 6], S[j][kb][b8 + 7])};
            pf[j][ks] = __builtin_bit_cast(bf16x8, w);
          }
        }
      } else {
#pragma unroll
        for (int j = 0; j < 2; ++j) {
          f32x16 S[2];
#pragma unroll
          for (int kb = 0; kb < 2; ++kb)
#pragma unroll
            for (int e = 0; e < 16; ++e) S[kb][e] = 0.f;
          {
            constexpr int NS = DQK / 16;
            const char* kbase = base + j * 64 * KP + kaddr;
            const char* qbase_l = qlds + j * 32 * 144;
#define A1_KF(s_, kb_) (*(const bf16x8*)(kbase + (kb_) * 32 * KP + (s_) * 32))
#define A1_QF(s_) (QLDS ? *(const bf16x8*)(qbase_l + (s_) * 32) : qf[j][(s_)])
            bf16x8 ka = A1_KF(0, 0), kb2 = A1_KF(0, 1), qa = A1_QF(0);
            __builtin_amdgcn_sched_barrier(0);
#pragma unroll
            for (int s2 = 0; s2 < NS; ++s2) {
              bf16x8 kn0, kn1, qn;
              if (s2 + 1 < NS) { kn0 = A1_KF(s2 + 1, 0); kn1 = A1_KF(s2 + 1, 1); qn = A1_QF(s2 + 1); }
              __builtin_amdgcn_sched_barrier(0);
              S[0] = MFMA(ka, qa, S[0]);
              S[1] = MFMA(kb2, qa, S[1]);
              __builtin_amdgcn_sched_barrier(0);
              if (s2 + 1 < NS) { ka = kn0; kb2 = kn1; qa = qn; }
            }
#undef A1_KF
#undef A1_QF
          }
          float pmax = S[0][0];
#pragma unroll
          for (int e = 1; e < 16; ++e) pmax = fmaxf(pmax, S[0][e]);
#pragma unroll
          for (int e = 0; e < 16; ++e) pmax = fmaxf(pmax, S[1][e]);
          pmax = swapmax(pmax);
          if (!__all(pmax - mrun[j] <= THR)) {
            float mn = fmaxf(mrun[j], pmax);
            float alpha = __builtin_amdgcn_exp2f(mrun[j] - mn);
            mrun[j] = mn; lrun[j] *= alpha;
#pragma unroll
            for (int d = 0; d < DV / 32; ++d)
#pragma unroll
              for (int e = 0; e < 16; ++e) O[j][d][e] *= alpha;
          }
          float ps = 0.f; const float mm = mrun[j];
#pragma unroll
          for (int kb = 0; kb < 2; ++kb)
#pragma unroll
            for (int e = 0; e < 16; ++e) { float pv = __builtin_amdgcn_exp2f(S[kb][e] - mm); S[kb][e] = pv; ps += pv; }
          lrun[j] += ps;
#pragma unroll
          for (int ks = 0; ks < 4; ++ks) {
            const int kb = ks >> 1, b8 = (ks & 1) * 8;
            u32x4 w = {cvtpk(S[kb][b8], S[kb][b8 + 1]), cvtpk(S[kb][b8 + 2], S[kb][b8 + 3]),
                       cvtpk(S[kb][b8 + 4], S[kb][b8 + 5]), cvtpk(S[kb][b8 + 6], S[kb][b8 + 7])};
            pf[j][ks] = __builtin_bit_cast(bf16x8, w);
          }
          {
            constexpr int ND = DV / 32, NV = 4 * ND;
            const char* vbase = base + vaddr;
            auto vread = [&](int i) -> bf16x8 {
              const char* va = vbase + (i / ND) * 16 * VP + (i % ND) * 64;
              s16x4 lo = __builtin_amdgcn_ds_read_tr16_b64_v4i16((__attribute__((address_space(3))) s16x4*)(va));
              s16x4 hi = __builtin_amdgcn_ds_read_tr16_b64_v4i16((__attribute__((address_space(3))) s16x4*)(va + 8 * VP));
              bf16x8 vf = {lo[0], lo[1], lo[2], lo[3], hi[0], hi[1], hi[2], hi[3]};
              return vf;
            };
            bf16x8 v0 = vread(0), v1 = vread(1);
            __builtin_amdgcn_sched_barrier(0);
#pragma unroll
            for (int i = 0; i < NV; i += 2) {
              O[j][i % ND] = MFMA(v0, pf[j][i / ND], O[j][i % ND]);
              if (i + 2 < NV) v0 = vread(i + 2);
              __builtin_amdgcn_sched_barrier(0);
              O[j][(i + 1) % ND] = MFMA(v1, pf[j][(i + 1) / ND], O[j][(i + 1) % ND]);
              if (i + 3 < NV) v1 = vread(i + 3);
              __builtin_amdgcn_sched_barrier(0);
            }
            if (j == 0 && more) {
#pragma unroll
              for (int it = 0; it < NIT; ++it) if (sval[it]) rg[it] = __builtin_amdgcn_raw_buffer_load_b128(krsrc, soff[it] * 2, (t + 1) * 128 * ldi, 0);
              __builtin_amdgcn_sched_barrier(0);
            }
          }
        }
      }
      if (NKT == 1) {
#pragma unroll
        for (int ks = 0; ks < 4; ++ks)
#pragma unroll
          for (int d = 0; d < DV / 32; ++d) {
            const char* va = base + vaddr + ks * 16 * VP + d * 64;
            s16x4 lo = __builtin_amdgcn_ds_read_tr16_b64_v4i16((__attribute__((address_space(3))) s16x4*)(va));
            s16x4 hi = __builtin_amdgcn_ds_read_tr16_b64_v4i16((__attribute__((address_space(3))) s16x4*)(va + 8 * VP));
            bf16x8 vf = {lo[0], lo[1], lo[2], lo[3], hi[0], hi[1], hi[2], hi[3]};
#pragma unroll
            for (int j = 0; j < 2; ++j) O[j][d] = MFMA(vf, pf[j][ks], O[j][d]);
          }
      }
    }
    if (more) {
      char* nb = lds + (buf ^ 1) * SB;
#pragma unroll
      for (int it = 0; it < NIT; ++it) if (sval[it]) *(u32x4*)(nb + doff[it]) = rg[it];
    }
    __syncthreads();
  }
}

template <int NS>
DI void load_qf(bf16x8 (&qf)[NS], const u16* __restrict__ qrow) {
#pragma unroll
  for (int s = 0; s < NS; ++s) qf[s] = *(const bf16x8*)(qrow + s * 16);
}

template <int ND>
DI void store_o(const f32x16 (&o)[ND], float scale, u16* __restrict__ dst, int h) {
#pragma unroll
  for (int d = 0; d < ND; ++d)
#pragma unroll
    for (int g = 0; g < 4; ++g) {
      u32x2 w = {cvtpk(o[d][4 * g] * scale, o[d][4 * g + 1] * scale), cvtpk(o[d][4 * g + 2] * scale, o[d][4 * g + 3] * scale)};
      *(u32x2*)(dst + d * 32 + 8 * g + 4 * h) = w;
    }
}

DI void item_map(int idx, int nqb, int& sh, int& qb) {
  int xcd = idx & 7, slot = idx >> 3;
  sh = xcd * (32 / nqb) + slot / nqb;
  qb = slot % nqb;
}

__device__ __forceinline__ void attn_A(const Params& p, int layer, int idx, char* lds) {
  char* const ws = lws(p.ws);
  const int tid = tidx(), lane = tid & 63, wid = wave_id(), r = lane & 31, h = lane >> 5;
  int sh, qb; item_map(idx, 16, sh, qb);
  const int seq = sh >> 2, head = sh & 3;
  const u16* qkv = (const u16*)(ws + OFF_QKV) + (size_t)seq * SEQ * NINP;
  u16* outs = (u16*)(ws + OFF_OUTS) + (size_t)seq * SEQ * OUT_LD;
  const int q0 = qb * 256 + wid * 32;
  bf16x8 qf[2][4];
  __syncthreads();
#pragma unroll
  for (int j = 0; j < 2; ++j) {
    load_qf<4>(qf[j], qkv + (size_t)(q0 + r) * NINP + (head * 2 + j) * 64 + h * 8);
#pragma unroll
    for (int s = 0; s < 4; ++s) *(bf16x8*)(lds + QLDS_OFF + wid * QLDS_WAVE + (j * 32 + r) * 144 + h * 16 + s * 32) = qf[j][s];
  }
  lds_fence();
  f32x16 O[2][4]; float mrun[2] = {-1e29f, -1e29f}, lrun[2] = {0.f, 0.f};
#pragma unroll
  for (int j = 0; j < 2; ++j)
#pragma unroll
    for (int d = 0; d < 4; ++d)
#pragma unroll
      for (int e = 0; e < 16; ++e) O[j][d][e] = 0.f;
  attn_loop<64, 128, 2, false, true>(O, mrun, lrun, qf, qkv + 512 + (head * 2) * 64, qkv + 512 + (head * 2 + 1) * 64, NINP, qkv + 1024 + head * 128, NINP,
                               0, 64, true, 0, 0, lds);
  const int lane2 = (tidx() & 63), r2 = lane2 & 31, h2 = lane2 >> 5;
  const float lam = ((const float*)(ws + OFF_LAM))[layer];
  const float i0 = 1.f / swapadd(lrun[0]), i1 = lam / swapadd(lrun[1]);
  float ss = 0.f;
#pragma unroll
  for (int d = 0; d < 4; ++d)
#pragma unroll
    for (int e = 0; e < 16; ++e) { float o = O[0][d][e] * i0 - O[1][d][e] * i1; O[0][d][e] = o; ss += o * o; }
  ss = swapadd(ss);
  const float rstd = __builtin_amdgcn_rsqf(ss * (1.f / 128.f) + EPS) * p.oml[layer];
  const float* sg = p.in[8] + layer * 128;
  u16* dst = outs + (size_t)(q0 + r2) * OUT_LD + head * 128;
#pragma unroll
  for (int d = 0; d < 4; ++d)
#pragma unroll
    for (int g = 0; g < 4; ++g) {
      f32x4 g4 = *(const f32x4*)(sg + d * 32 + 8 * g + 4 * h2);
      u32x2 w = {cvtpk(O[0][d][4 * g] * rstd * g4[0], O[0][d][4 * g + 1] * rstd * g4[1]), cvtpk(O[0][d][4 * g + 2] * rstd * g4[2], O[0][d][4 * g + 3] * rstd * g4[3])};
      *(u32x2*)(dst + d * 32 + 8 * g + 4 * h2) = w;
    }
}

__device__ __forceinline__ void attn_C(const Params& p, int layer, int idx, char* lds) {
  char* const ws = lws(p.ws);
  const int tid = tidx(), lane = tid & 63, wid = wave_id(), r = lane & 31, h = lane >> 5;
  int sh, qb; item_map(idx, 8, sh, qb);
  const int seq = sh >> 3, head = sh & 7;
  const u16* qc = (const u16*)(ws + OFF_QKVC) + (size_t)seq * SEQ * QKVC_LD;
  u16* outs = (u16*)(ws + OFF_OUTS) + (size_t)seq * SEQ * OUT_LD;
  const int q0 = qb * 512 + wid * 64;
  bf16x8 qf[2][6];
  load_qf<6>(qf[0], qc + (size_t)(q0 + r) * QKVC_LD + head * 96 + h * 8);
  load_qf<6>(qf[1], qc + (size_t)(q0 + 32 + r) * QKVC_LD + head * 96 + h * 8);
  f32x16 O[2][2]; float mrun[2] = {-1e29f, -1e29f}, lrun[2] = {0.f, 0.f};
#pragma unroll
  for (int j = 0; j < 2; ++j)
#pragma unroll
    for (int d = 0; d < 2; ++d)
#pragma unroll
      for (int e = 0; e < 16; ++e) O[j][d][e] = 0.f;
  attn_loop<96, 64, 1, false>(O, mrun, lrun, qf, qc + 768 + head * 96, nullptr, QKVC_LD, qc + 1536 + head * 64, QKVC_LD, 0, 64, true, 0, 0, lds);
  const int lane2 = (tidx() & 63), r2 = lane2 & 31, h2 = lane2 >> 5;
#pragma unroll
  for (int j = 0; j < 2; ++j) {
    const float inv = 1.f / swapadd(lrun[j]);
    store_o<2>(O[j], inv, outs + (size_t)(q0 + j * 32 + r2) * OUT_LD + 768 + head * 64, h2);
  }
}

__device__ __forceinline__ void attn_D(const Params& p, int layer, int idx, char* lds) {
  char* const ws = lws(p.ws);
  const int tid = tidx(), lane = tid & 63, wid = wave_id(), r = lane & 31, h = lane >> 5;
  const int xcd = idx & 7, qb = idx >> 3;
  const int seq = xcd >> 1, kvh = xcd & 1;
  const u16* qkv = (const u16*)(ws + OFF_QKV) + (size_t)seq * SEQ * NINP;
  u16* outs = (u16*)(ws + OFF_OUTS) + (size_t)seq * SEQ * OUT_LD;
  const int qhead = kvh * 4 + (wid >> 1);
  const int q0 = qb * 128 + (wid & 1) * 64;
  bf16x8 qf[2][4];
  load_qf<4>(qf[0], qkv + (size_t)(q0 + r) * NINP + 3840 + qhead * 64 + h * 8);
  load_qf<4>(qf[1], qkv + (size_t)(q0 + 32 + r) * NINP + 3840 + qhead * 64 + h * 8);
  f32x16 O[2][2]; float mrun[2] = {-1e29f, -1e29f}, lrun[2] = {0.f, 0.f};
#pragma unroll
  for (int j = 0; j < 2; ++j)
#pragma unroll
    for (int d = 0; d < 2; ++d)
#pragma unroll
      for (int e = 0; e < 16; ++e) O[j][d][e] = 0.f;
  int t0 = qb * 2 - 2; if (t0 < 0) t0 = 0;
  int t1 = qb * 2 + 4; if (t1 > 64) t1 = 64;
  attn_loop<64, 64, 1, true>(O, mrun, lrun, qf, qkv + 4352 + kvh * 64, nullptr, NINP, qkv + 4480 + kvh * 64, NINP, t0, t1, true, q0, 128, lds);
  const float sink2 = p.in[19][layer * 8 + qhead] * LOG2E;
  const int lane2 = (tidx() & 63), r2 = lane2 & 31, h2 = lane2 >> 5;
#pragma unroll
  for (int j = 0; j < 2; ++j) {
    const float l = swapadd(lrun[j]);
    const float mf = fmaxf(mrun[j], sink2);
    const float a = __builtin_amdgcn_exp2f(mrun[j] - mf);
    const float lf = l * a + __builtin_amdgcn_exp2f(sink2 - mf);
    store_o<2>(O[j], a / lf, outs + (size_t)(q0 + j * 32 + r2) * OUT_LD + 1280 + qhead * 64, h2);
  }
}

__device__ __forceinline__ void attn_B(const Params& p, int layer, int idx, char* lds) {
  char* const ws = lws(p.ws);
  const int tid = tidx(), lane = tid & 63, wid = wave_id(), r = lane & 31, h = lane >> 5;
  const int sub = idx & 31, sh = idx >> 5, seq = sh >> 2, head = sh & 3;
  int g, res, m0;
  if (sub < 8) { g = 0; res = 0; m0 = sub * 512; }
  else if (sub < 16) { g = 1; res = (sub - 8) >> 1; m0 = ((sub - 8) & 1) * 512; }
  else { g = 2; res = sub - 16; m0 = 0; }
  const int dil = g == 0 ? 1 : (g == 1 ? 4 : 16);
  const int Lg = SEQ / dil;
  int nact = (Lg - m0) / 64; if (nact > 8) nact = 8;
  const bool wact = wid < nact;
  const size_t ld = (size_t)dil * NINP;
  const u16* base = (const u16*)(ws + OFF_QKV) + ((size_t)seq * SEQ + res) * NINP + 1536 + g * 768 + head * 64;
  int q0 = m0 + wid * 64; if (!wact) q0 = m0;
  bf16x8 qf[2][4];
  load_qf<4>(qf[0], base + (size_t)(q0 + r) * ld + h * 8);
  load_qf<4>(qf[1], base + (size_t)(q0 + 32 + r) * ld + h * 8);
  f32x16 O[2][2]; float mrun[2] = {-1e29f, -1e29f}, lrun[2] = {0.f, 0.f};
#pragma unroll
  for (int j = 0; j < 2; ++j)
#pragma unroll
    for (int d = 0; d < 2; ++d)
#pragma unroll
      for (int e = 0; e < 16; ++e) O[j][d][e] = 0.f;
  int t0 = m0 / 64 - 1; if (t0 < 0) t0 = 0;
  int t1 = m0 / 64 + 9; if (t1 > Lg / 64) t1 = Lg / 64;
  attn_loop<64, 64, 1, true>(O, mrun, lrun, qf, base + 256, nullptr, ld, base + 512, ld, t0, t1, wact, q0, 64, lds);
  if (wact) {
    const int lane2 = (tidx() & 63), r2 = lane2 & 31, h2 = lane2 >> 5;
    u16* bo = (u16*)(ws + OFF_BO) + (size_t)g * CT * 256;
    float* blse = (float*)(ws + OFF_BLSE) + (size_t)g * CT * 4;
#pragma unroll
    for (int j = 0; j < 2; ++j) {
      const float l = swapadd(lrun[j]);
      const size_t tok = (size_t)seq * SEQ + (size_t)(q0 + j * 32 + r2) * dil + res;
      store_o<2>(O[j], 1.f / l, bo + tok * 256 + head * 64, h2);
      if (h2 == 0) blse[tok * 4 + head] = mrun[j] + __builtin_amdgcn_logf(l);
    }
  }
}

DI void combine_rows(char* ws, int m0) {
  const u16* bo = (const u16*)(ws + OFF_BO);
  const float* blse = (const float*)(ws + OFF_BLSE);
  u16* outs = (u16*)(ws + OFF_OUTS);
  for (int i = tidx(); i < 128 * 32; i += 512) {
    const int tok = m0 + (i >> 5), ch = i & 31, head = ch >> 3;
    float l0 = blse[(size_t)tok * 4 + head], l1 = blse[((size_t)CT + tok) * 4 + head], l2 = blse[((size_t)2 * CT + tok) * 4 + head];
    float mx = fmaxf(l0, fmaxf(l1, l2));
    float w0 = __builtin_amdgcn_exp2f(l0 - mx), w1 = __builtin_amdgcn_exp2f(l1 - mx), w2 = __builtin_amdgcn_exp2f(l2 - mx);
    float inv = 1.f / (w0 + w1 + w2); w0 *= inv; w1 *= inv; w2 *= inv;
    u32x4 a = *(const u32x4*)(bo + (size_t)tok * 256 + ch * 8);
    u32x4 b = *(const u32x4*)(bo + ((size_t)CT + tok) * 256 + ch * 8);
    u32x4 c = *(const u32x4*)(bo + ((size_t)2 * CT + tok) * 256 + ch * 8);
    u32x4 o;
#pragma unroll
    for (int e = 0; e < 4; ++e) {
      float lo = w0 * bflo(a[e]) + w1 * bflo(b[e]) + w2 * bflo(c[e]);
      float hi = w0 * bfhi(a[e]) + w1 * bfhi(b[e]) + w2 * bfhi(c[e]);
      o[e] = cvtpk(lo, hi);
    }
    *(u32x4*)(outs + (size_t)tok * OUT_LD + 512 + ch * 8) = o;
  }
  asm volatile("s_waitcnt vmcnt(0)" ::: "memory");
}

__device__ __forceinline__ void phase_merge(const Params& p, int layer, char* lds) {
  char* const ws = lws(p.ws);
  const u16* Wbr = (const u16*)(ws + OFF_WBR) + (size_t)layer * 1024 * 1792;
  const u16* Wg = (const u16*)(ws + OFF_WGATE) + (size_t)layer * 4096 * 1024;
  const u16* xn = (const u16*)(ws + OFF_XN);
  const u16* outs = (const u16*)(ws + OFF_OUTS);
  u16* merged = (u16*)(ws + OFF_MERGED);
  const int wid = wave_id(), wn = wid & 3, wm = wid >> 2;
  for (int t = blockIdx.x; t < 4 * 128; t += gridDim.x) {
    int nt, mt; tile_map(t, nt, mt);
    const int n0 = nt * 256, m0 = mt * 128;
    combine_rows(ws, m0);
    f32x16 mg[2][2];
#pragma unroll
    for (int i = 0; i < 2; ++i)
#pragma unroll
      for (int j = 0; j < 2; ++j)
#pragma unroll
        for (int e = 0; e < 16; ++e) mg[i][j][e] = 0.f;
    for (int br = 0; br < 4; ++br) {
      const int Kb = br == 1 ? 256 : 512;
      const int cofs = br == 0 ? 0 : (br == 1 ? 512 : (br == 2 ? 768 : 1280));
      f32x16 acc[2][2];
      gemm_core<2, 2, true>(acc, Wbr + (size_t)1024 * cofs + (size_t)n0 * Kb, Kb, outs + (size_t)m0 * OUT_LD + cofs, OUT_LD, Kb, lds);
      unsigned yp[2][2][8];
#pragma unroll
      for (int i = 0; i < 2; ++i)
#pragma unroll
        for (int j = 0; j < 2; ++j)
#pragma unroll
          for (int e = 0; e < 8; ++e) yp[i][j][e] = cvtpk(acc[i][j][2 * e], acc[i][j][2 * e + 1]);
      gemm_core<2, 2, true>(acc, Wg + (size_t)(br * 1024 + n0) * 1024, 1024, xn + (size_t)m0 * 1024, 1024, 1024, lds);
#pragma unroll
      for (int i = 0; i < 2; ++i)
#pragma unroll
        for (int j = 0; j < 2; ++j)
#pragma unroll
          for (int e = 0; e < 8; ++e) {
            float s0 = __builtin_amdgcn_rcpf(1.f + __builtin_amdgcn_exp2f(-acc[i][j][2 * e] * LOG2E));
            float s1 = __builtin_amdgcn_rcpf(1.f + __builtin_amdgcn_exp2f(-acc[i][j][2 * e + 1] * LOG2E));
            mg[i][j][2 * e] += s0 * bflo(yp[i][j][e]);
            mg[i][j][2 * e + 1] += s1 * bfhi(yp[i][j][e]);
          }
    }
    store_wave_bf16<2>(mg, merged + (size_t)(m0 + wm * 64) * 1024 + n0 + wn * 64, 1024, lds + wid * WAVE_LDS);
  }
}

__device__ __forceinline__ void phase_proj_res(const u16* Wt, const u16* act, int K, const float* resid, float* xout, char* lds) {
  pg8::Gemm g{act, Wt, CT, DM, K};
  pg8::StaticOrder S; S.init(CT, DM, gridDim.x, blockIdx.x);
  EpiRes E{resid, xout};
  __syncthreads();
  pg8::gemm_phase<EpiRes, pg8::StaticOrder, false>((PG8_LAS unsigned char*)lds, g, S, E, nullptr);
}

__device__ __forceinline__ void phase_ffn_up(const Params& p, int layer, char* lds) {
  char* const ws = lws(p.ws);
  pg8::Gemm g{(const u16*)(ws + OFF_XN), (const u16*)(ws + OFF_WGU) + (size_t)layer * NGU * 1024, CT, NGU, 1024};
  pg8::StaticOrder S; S.init(CT, NGU, gridDim.x, blockIdx.x);
  EpiSwiglu E{(u16*)(ws + OFF_ACT)};
  __syncthreads();
  pg8::gemm_phase<EpiSwiglu, pg8::StaticOrder, false>((PG8_LAS unsigned char*)lds, g, S, E, nullptr);
}

#define XB_TMO      128
#define XB_XCNT(j)  (256  + 64 * (j))
#define XB_XSUB(j)  (1280 + 64 * (j))
#define XB_XGEN(j)  (2304 + 64 * (j))
#define XB_TOP      3328
#define XB_TOPGEN   3392
#define XCD_BAR_WORDS 3456
#define XB_SPIN_CAP (1u << 20)
#define XB_LAS __attribute__((address_space(3)))
DI unsigned xb_ld(unsigned* p) { return __hip_atomic_load(p, __ATOMIC_RELAXED, __HIP_MEMORY_SCOPE_AGENT); }
DI unsigned xb_add(unsigned* p, unsigned v) { return __hip_atomic_fetch_add(p, v, __ATOMIC_RELAXED, __HIP_MEMORY_SCOPE_AGENT); }
DI unsigned xb_xcc_id() { return (unsigned)__builtin_amdgcn_s_getreg((3 << 11) | 20) & 0xFu; }
#define XB_SPIN(cond, bar) do { unsigned _sp = 0; while (cond) { __builtin_amdgcn_s_sleep(1); \
    if ((++_sp & 255u) == 0u) { if (xb_ld(&(bar)[XB_TMO])) break; if (_sp > XB_SPIN_CAP) { atomicAdd(&(bar)[XB_TMO], 1u); break; } } } } while (0)
struct XcdBarrier { unsigned* bar; unsigned x; volatile XB_LAS unsigned* st; };
DI XcdBarrier xcd_barrier_post(unsigned* bar, volatile XB_LAS unsigned* st) {
  XcdBarrier b; b.bar = bar; b.x = xb_xcc_id(); b.st = st;
  if (tidx() == 0) (void)xb_add(&bar[XB_XCNT(b.x)], 1u);
  return b;
}
DI void xcd_barrier_complete(unsigned* bar, unsigned x, unsigned& nloc, unsigned& nx) {
  const unsigned G = gridDim.x;
  unsigned sum, cnt, mine, sp = 0u;
  for (;;) {
    sum = 0u; cnt = 0u; mine = 0u;
#pragma unroll
    for (unsigned j = 0; j < 16; ++j) { const unsigned c = xb_ld(&bar[XB_XCNT(j)]); sum += c; cnt += (c > 0u) ? 1u : 0u; mine = (j == x) ? c : mine; }
    if (sum == G) break;
    __builtin_amdgcn_s_sleep(1);
    if ((++sp & 255u) == 0u) { if (xb_ld(&bar[XB_TMO])) break; if (sp > XB_SPIN_CAP) { atomicAdd(&bar[XB_TMO], 1u); break; } }
  }
  nloc = mine > 0u ? mine : 1u; nx = cnt > 0u ? cnt : 1u;
}
DI void xcd_barrier(const XcdBarrier& b) {
  asm volatile("s_waitcnt vmcnt(0)" ::: "memory");
  __syncthreads();
  if (tidx() == 0) {
    unsigned* bar = b.bar;
    __builtin_amdgcn_s_waitcnt(0);
    unsigned nloc = b.st[0], nx = b.st[1];
    if (nloc == 0u) { xcd_barrier_complete(bar, b.x, nloc, nx); b.st[0] = nloc; b.st[1] = nx; }
    const unsigned old = xb_add(&bar[XB_XSUB(b.x)], 1u);
    const unsigned gen = old / nloc;
    if (old + 1u == (gen + 1u) * nloc) {
      __builtin_amdgcn_fence(__ATOMIC_RELEASE, "agent");
      asm volatile("s_waitcnt vmcnt(0)" ::: "memory");
      const unsigned og = xb_add(&bar[XB_TOP], 1u);
      const unsigned tg = og / nx;
      if (og + 1u == (tg + 1u) * nx) xb_add(&bar[XB_TOPGEN], 1u);
      else XB_SPIN(xb_ld(&bar[XB_TOPGEN]) == tg, bar);
      __builtin_amdgcn_fence(__ATOMIC_ACQUIRE, "agent");
      xb_add(&bar[XB_XGEN(b.x)], 1u);
      asm volatile("s_waitcnt vmcnt(0)" ::: "memory");
    } else {
      XB_SPIN(xb_ld(&bar[XB_XGEN(b.x)]) == gen, bar);
      __builtin_amdgcn_fence(__ATOMIC_ACQUIRE, "agent");
      asm volatile("s_waitcnt vmcnt(0)" ::: "memory");
    }
  }
  __syncthreads();
}

DI void grid_barrier(unsigned* ctr, unsigned target) {
  asm volatile("s_waitcnt vmcnt(0)" ::: "memory");
  __syncthreads();
  if (threadIdx.x == 0) {
    __builtin_amdgcn_fence(__ATOMIC_RELEASE, "agent");
    asm volatile("s_waitcnt vmcnt(0)" ::: "memory");
    __hip_atomic_fetch_add(ctr, 1u, __ATOMIC_RELAXED, __HIP_MEMORY_SCOPE_AGENT);
    unsigned spins = 0;
    while (__hip_atomic_load(ctr, __ATOMIC_RELAXED, __HIP_MEMORY_SCOPE_AGENT) < target && ++spins < (1u << 26)) __builtin_amdgcn_s_sleep(2);
    __builtin_amdgcn_fence(__ATOMIC_ACQUIRE, "agent");
    asm volatile("s_waitcnt vmcnt(0)" ::: "memory");
  }
  __syncthreads();
}

extern "C" __global__ void __launch_bounds__(512, 2) __attribute__((amdgpu_waves_per_eu(2, 2))) mega(Params p) {
  extern __shared__ __attribute__((aligned(16))) char lds[];
  cg::grid_group grid = cg::this_grid();
  unsigned* const barp = (unsigned*)(p.ws + OFF_BAR);
  unsigned nbar = 0;
#define PWS lws(p.ws)
#define POUT ((float*)lws((char*)p.out))
  volatile XB_LAS unsigned* xst = (volatile XB_LAS unsigned*)(lds + (LDS_BYTES - 16));
  if (tidx() == 0) { xst[0] = 0u; xst[1] = 0u; }
  phase_w(p, lds);
  grid.sync();
  const XcdBarrier xb = xcd_barrier_post(barp, xst);
#pragma nounroll
  for (int ch = 0; ch < NCH; ++ch) {
#pragma nounroll
    for (int layer = 0; layer < DEPTH; ++layer) {
      {
        const float* xin = ch == 0 ? p.in[0] : p.in[1] + (size_t)(ch - 1) * CT * DM;
        const float* xcur = layer == 0 ? xin : POUT + (size_t)ch * CT * DM;
        phase_norm(xcur, p.in[2] + layer * DM, (u16*)(PWS + OFF_XN));
      }
      xcd_barrier(xb);
      phase_p1(p, layer, lds);
      xcd_barrier(xb);
      phase_p1c(p, layer, lds);
      xcd_barrier(xb);
#pragma nounroll
      for (int it = blockIdx.x; it < 1280; it += gridDim.x) {
        if (it < 256) attn_A(p, layer, it, lds);
        else if (it < 512) attn_C(p, layer, it - 256, lds);
        else if (it < 768) attn_D(p, layer, it - 512, lds);
        else attn_B(p, layer, it - 768, lds);
      }
      xcd_barrier(xb);
      phase_merge(p, layer, lds);
      xcd_barrier(xb);
      {
        const float* xin = ch == 0 ? p.in[0] : p.in[1] + (size_t)(ch - 1) * CT * DM;
        float* xo = POUT + (size_t)ch * CT * DM;
        const float* xcur = layer == 0 ? xin : xo;
        phase_proj_res((const u16*)(PWS + OFF_WO) + (size_t)layer * 1024 * 1024, (const u16*)(PWS + OFF_MERGED), 1024, xcur, xo, lds);
      }
      xcd_barrier(xb);
      {
        phase_norm(POUT + (size_t)ch * CT * DM, p.in[25] + layer * DM, (u16*)(PWS + OFF_XN));
      }
      xcd_barrier(xb);
      phase_ffn_up(p, layer, lds);
      xcd_barrier(xb);
      {
        float* xo = POUT + (size_t)ch * CT * DM;
        phase_proj_res((const u16*)(PWS + OFF_WDN) + (size_t)layer * 1024 * DFF, (const u16*)(PWS + OFF_ACT), DFF, xo, xo, lds);
      }
      xcd_barrier(xb);
    }
  }
}

extern "C" void kernel_launch(void* const* d_in, const int* in_sizes, int n_in, void* d_out, int out_size, void* d_ws, size_t ws_size, hipStream_t stream) {
  static int grid_blocks = 0;
  if (!grid_blocks) {
    int dev = 0, cus = 0, per_cu = 0;
    (void)hipGetDevice(&dev);
    (void)hipDeviceGetAttribute(&cus, hipDeviceAttributeMultiprocessorCount, dev);
    (void)hipFuncSetAttribute((const void*)mega, hipFuncAttributeMaxDynamicSharedMemorySize, (int)LDS_BYTES);
    (void)hipOccupancyMaxActiveBlocksPerMultiprocessor(&per_cu, mega, 512, LDS_BYTES);
    if (per_cu < 1) fprintf(stderr, "kernel_launch: occupancy query returned %d\n", per_cu);
    grid_blocks = cus > 0 ? cus : 256;
    if (ws_size < WS_END) fprintf(stderr, "kernel_launch: workspace too small: %zu < %zu\n", ws_size, (size_t)WS_END);
  }
  Params p{};
  for (int i = 0; i < 29; ++i) p.in[i] = (const float*)d_in[i];
  p.out = (float*)d_out;
  p.ws = (char*)d_ws;
  for (int i = 0; i < 32; ++i) p.inv64[i] = (float)pow(10000.0, -(double)i / 32.0);
  for (int i = 0; i < 16; ++i) p.inv32[i] = (float)pow(10000.0, -(double)i / 16.0);
  for (int l = 0; l < 2; ++l) {
    double li = 0.8 - 0.6 * exp(-0.3 * (double)l);
    p.lam_init[l] = (float)li;
    p.oml[l] = (float)(1.0 - li);
  }
  void* args[] = {&p};
  hipError_t e = hipLaunchCooperativeKernel((void*)mega, dim3(grid_blocks), dim3(512), args, LDS_BYTES, stream);
  if (e != hipSuccess) fprintf(stderr, "cooperative launch failed: %s (grid %d)\n", hipGetErrorString(e), grid_blocks);
}
```

```cpp
#include <hip/hip_runtime.h>
#include <hip/hip_cooperative_groups.h>
#include <cstdio>
#include <cmath>
namespace cg = cooperative_groups;

typedef unsigned short u16;
typedef short bf16x8 __attribute__((ext_vector_type(8)));
typedef short s16x4 __attribute__((ext_vector_type(4)));
typedef float f32x16 __attribute__((ext_vector_type(16)));
typedef float f32x4 __attribute__((ext_vector_type(4)));
typedef float f32x2 __attribute__((ext_vector_type(2)));
typedef unsigned u32x4 __attribute__((ext_vector_type(4)));
typedef unsigned u32x2 __attribute__((ext_vector_type(2)));
typedef __bf16 bf16x2_t __attribute__((ext_vector_type(2)));

#define DI __device__ __forceinline__
#define MFMA(a, b, c) __builtin_amdgcn_mfma_f32_32x32x16_bf16(a, b, c, 0, 0, 0)

constexpr int DM = 1024, SEQ = 4096, CT = 16384, NCH = 3, NINP = 5120, DFF = 2816, NGU = 5632, NIN2 = 9216;
constexpr int QKVC_LD = 2048, OUT_LD = 1792, DEPTH = 2;
constexpr float LOG2E = 1.4426950408889634f;
constexpr float QS64 = 0.125f * LOG2E, QS96 = 0.10206207261596575f * LOG2E;
constexpr float EPS = 1e-6f;
constexpr int PITCH = 144;
constexpr int WAVE_LDS = 17408;
constexpr size_t LDS_BYTES = 155648;

constexpr size_t al256(size_t x) { return (x + 255) / 256 * 256; }
constexpr size_t OFF_WIN = 0;
constexpr size_t OFF_WGATE = OFF_WIN + al256((size_t)DEPTH * NIN2 * 1024 * 2);
constexpr size_t OFF_WUQ = OFF_WGATE + 256;
constexpr size_t OFF_WUKV = OFF_WUQ + al256((size_t)DEPTH * 768 * 256 * 2);
constexpr size_t OFF_WBR = OFF_WUKV + al256((size_t)DEPTH * 1024 * 128 * 2);
constexpr size_t OFF_WO = OFF_WBR + al256((size_t)DEPTH * 1024 * 1792 * 2);
constexpr size_t OFF_WGU = OFF_WO + al256((size_t)DEPTH * 1024 * 1024 * 2);
constexpr size_t OFF_WDN = OFF_WGU + al256((size_t)DEPTH * NGU * 1024 * 2);
constexpr size_t OFF_COS64 = OFF_WDN + al256((size_t)DEPTH * 1024 * DFF * 2);
constexpr size_t OFF_SIN64 = OFF_COS64 + (size_t)SEQ * 32 * 4;
constexpr size_t OFF_COS32 = OFF_SIN64 + (size_t)SEQ * 32 * 4;
constexpr size_t OFF_SIN32 = OFF_COS32 + (size_t)SEQ * 16 * 4;
constexpr size_t OFF_LAM = OFF_SIN32 + (size_t)SEQ * 16 * 4;
constexpr size_t OFF_BAR = OFF_LAM + 256;
constexpr size_t OFF_XN = OFF_BAR + 16384;
constexpr size_t OFF_QKV = OFF_XN + (size_t)CT * 1024 * 2;
constexpr size_t OFF_QKVC = OFF_QKV + (size_t)CT * NINP * 2;
constexpr size_t OFF_OUTS = OFF_QKVC + (size_t)CT * QKVC_LD * 2;
constexpr size_t OFF_BO = OFF_OUTS + (size_t)CT * OUT_LD * 2;
constexpr size_t OFF_BLSE = OFF_BO + (size_t)3 * CT * 256 * 2;
constexpr size_t OFF_GATE = OFF_BLSE + (size_t)3 * CT * 4 * 4;
constexpr size_t WS_END = OFF_GATE + (size_t)CT * 4096;
constexpr size_t OFF_MERGED = OFF_QKV;
constexpr size_t OFF_ACT = OFF_QKV + (size_t)CT * 1024 * 2;

struct Params {
  const float* in[29];
  float* out;
  char* ws;
  float inv64[32];
  float inv32[16];
  float lam_init[2];
  float oml[2];
  int pad[2];
};

DI int crow(int reg, int h) { return (reg & 3) + 8 * (reg >> 2) + 4 * h; }
DI unsigned cvtpk(float lo, float hi) {
  f32x2 f = {lo, hi};
  bf16x2_t b = __builtin_convertvector(f, bf16x2_t);
  return __builtin_bit_cast(unsigned, b);
}
DI float bflo(unsigned u) { return __uint_as_float(u << 16); }
DI float bfhi(unsigned u) { return __uint_as_float(u & 0xffff0000u); }
DI float swapadd(float x) {
  auto rr = __builtin_amdgcn_permlane32_swap(__float_as_uint(x), __float_as_uint(x), false, false);
  return __uint_as_float(rr[0]) + __uint_as_float(rr[1]);
}
DI float swapmax(float x) {
  auto rr = __builtin_amdgcn_permlane32_swap(__float_as_uint(x), __float_as_uint(x), false, false);
  return fmaxf(__uint_as_float(rr[0]), __uint_as_float(rr[1]));
}
DI int opaque(int x) { asm volatile("" : "+v"(x)); return x; }
DI int tidx() { return opaque((int)threadIdx.x); }
DI int wave_id() { return __builtin_amdgcn_readfirstlane(tidx() >> 6); }
DI char* lws(char* w) { asm volatile("" : "+s"(w)); return w; }
DI void lds_fence() { asm volatile("s_waitcnt lgkmcnt(0)" ::: "memory"); }
DI void tile_map(int t, int& nt, int& mt) {
  int round = t >> 8, b = t & 255, xcd = b & 7, slot = b >> 3;
  nt = round * 2 + (slot & 1);
  mt = xcd * 16 + (slot >> 1);
}

template <int NB, int AN = NB, bool LOWREG = false>
DI void gemm_core(f32x16 (&acc)[AN][2], const u16* __restrict__ Ag, int lda, const u16* __restrict__ Bg, int ldb, int K, char* lds) {
  constexpr int AR = 128 * NB;
  constexpr int ACH = AR * 8 / 512;
  constexpr int STAGE = (AR + 128) * PITCH;
  const int tid = tidx(), lane = tid & 63, wid = wave_id(), r = lane & 31, h = lane >> 5;
  const int wn = wid & 3, wm = wid >> 2;
  const int crow0 = tid >> 3, ccol = tid & 7;
  const __amdgpu_buffer_rsrc_t arsrc = __builtin_amdgcn_make_buffer_rsrc((void*)Ag, 0, 0x7fffffff, 0x00020000);
  const __amdgpu_buffer_rsrc_t brsrc = __builtin_amdgcn_make_buffer_rsrc((void*)Bg, 0, 0x7fffffff, 0x00020000);
  const int avo = (crow0 * lda + ccol * 8) * 2, bvo = (crow0 * ldb + ccol * 8) * 2;
  const int astep = 64 * lda * 2, bstep = 64 * ldb * 2;
  const int wofs = crow0 * PITCH + ccol * 16;
  const int aoff = (wn * 32 * NB + r) * PITCH + h * 16;
  const int boff = AR * PITCH + (wm * 64 + r) * PITCH + h * 16;
  const int nk = K >> 6;
  u32x4 ra[ACH], rb[2];
#pragma unroll
  for (int i = 0; i < NB; ++i)
#pragma unroll
    for (int j = 0; j < 2; ++j)
#pragma unroll
      for (int e = 0; e < 16; ++e) acc[i][j][e] = 0.f;
  __syncthreads();
#pragma unroll
  for (int i = 0; i < ACH; ++i) ra[i] = __builtin_amdgcn_raw_buffer_load_b128(arsrc, avo + i * astep, 0, 0);
#pragma unroll
  for (int i = 0; i < 2; ++i) rb[i] = __builtin_amdgcn_raw_buffer_load_b128(brsrc, bvo + i * bstep, 0, 0);
#pragma unroll
  for (int i = 0; i < ACH; ++i) *(u32x4*)(lds + wofs + i * 64 * PITCH) = ra[i];
#pragma unroll
  for (int i = 0; i < 2; ++i) *(u32x4*)(lds + AR * PITCH + wofs + i * 64 * PITCH) = rb[i];
  __syncthreads();
#pragma nounroll
  for (int kt = 0; kt < nk; ++kt) {
    const bool more = kt + 1 < nk;
    if (more) {
#pragma unroll
      for (int i = 0; i < ACH; ++i) ra[i] = __builtin_amdgcn_raw_buffer_load_b128(arsrc, avo + i * astep, (kt + 1) * 128, 0);
#pragma unroll
      for (int i = 0; i < 2; ++i) rb[i] = __builtin_amdgcn_raw_buffer_load_b128(brsrc, bvo + i * bstep, (kt + 1) * 128, 0);
    }
    const char* base = lds + (kt & 1) * STAGE;
    if (LOWREG) {
#pragma unroll
      for (int s = 0; s < 4; ++s) {
        bf16x8 af[NB], bfr[2];
#pragma unroll
        for (int i = 0; i < NB; ++i) af[i] = *(const bf16x8*)(base + aoff + i * 32 * PITCH + s * 32);
#pragma unroll
        for (int j = 0; j < 2; ++j) bfr[j] = *(const bf16x8*)(base + boff + j * 32 * PITCH + s * 32);
#pragma unroll
        for (int i = 0; i < NB; ++i)
#pragma unroll
          for (int j = 0; j < 2; ++j) acc[i][j] = MFMA(af[i], bfr[j], acc[i][j]);
      }
    } else {
    bf16x8 afA[NB], bfA[2], afB[NB], bfB[2];
#pragma unroll
    for (int i = 0; i < NB; ++i) afA[i] = *(const bf16x8*)(base + aoff + i * 32 * PITCH);
#pragma unroll
    for (int j = 0; j < 2; ++j) bfA[j] = *(const bf16x8*)(base + boff + j * 32 * PITCH);
    __builtin_amdgcn_sched_barrier(0);
#pragma unroll
    for (int s = 0; s < 4; s += 2) {
#pragma unroll
      for (int i = 0; i < NB; ++i) afB[i] = *(const bf16x8*)(base + aoff + i * 32 * PITCH + (s + 1) * 32);
#pragma unroll
      for (int j = 0; j < 2; ++j) bfB[j] = *(const bf16x8*)(base + boff + j * 32 * PITCH + (s + 1) * 32);
      __builtin_amdgcn_sched_barrier(0);
#pragma unroll
      for (int i = 0; i < NB; ++i)
#pragma unroll
        for (int j = 0; j < 2; ++j) acc[i][j] = MFMA(afA[i], bfA[j], acc[i][j]);
      __builtin_amdgcn_sched_barrier(0);
      if (s + 2 < 4) {
#pragma unroll
        for (int i = 0; i < NB; ++i) afA[i] = *(const bf16x8*)(base + aoff + i * 32 * PITCH + (s + 2) * 32);
#pragma unroll
        for (int j = 0; j < 2; ++j) bfA[j] = *(const bf16x8*)(base + boff + j * 32 * PITCH + (s + 2) * 32);
      }
      __builtin_amdgcn_sched_barrier(0);
#pragma unroll
      for (int i = 0; i < NB; ++i)
#pragma unroll
        for (int j = 0; j < 2; ++j) acc[i][j] = MFMA(afB[i], bfB[j], acc[i][j]);
      __builtin_amdgcn_sched_barrier(0);
    }
    }
    if (more) {
      char* nb = lds + ((kt + 1) & 1) * STAGE;
#pragma unroll
      for (int i = 0; i < ACH; ++i) *(u32x4*)(nb + wofs + i * 64 * PITCH) = ra[i];
#pragma unroll
      for (int i = 0; i < 2; ++i) *(u32x4*)(nb + AR * PITCH + wofs + i * 64 * PITCH) = rb[i];
    }
    __syncthreads();
  }
}

template <int NB, int AN = NB>
DI void store_wave_bf16(const f32x16 (&v)[AN][2], u16* __restrict__ wdst, int ldd, char* wl) {
  constexpr int TP = NB * 64 + 16;
  const int lane = (tidx() & 63), r = lane & 31, h = lane >> 5;
#pragma unroll
  for (int i = 0; i < NB; ++i)
#pragma unroll
    for (int j = 0; j < 2; ++j)
#pragma unroll
      for (int g = 0; g < 4; ++g) {
        u32x2 w = {cvtpk(v[i][j][4 * g], v[i][j][4 * g + 1]), cvtpk(v[i][j][4 * g + 2], v[i][j][4 * g + 3])};
        *(u32x2*)(wl + (j * 32 + r) * TP + (i * 32 + 8 * g + 4 * h) * 2) = w;
      }
  lds_fence();
  constexpr int CPR = NB * 4;
#pragma unroll
  for (int it = 0; it < CPR; ++it) {
    int c = lane + 64 * it, row = c / CPR, ch = c % CPR;
    u32x4 d = *(const u32x4*)(wl + row * TP + ch * 16);
    *(u32x4*)(wdst + (size_t)row * ldd + ch * 8) = d;
  }
  lds_fence();
}

DI void store_wave_f32_res(const f32x16 (&v)[2][2], const float* __restrict__ res, float* __restrict__ wdst, char* wl) {
  constexpr int TP = 272;
  const int lane = (tidx() & 63), r = lane & 31, h = lane >> 5;
#pragma unroll
  for (int i = 0; i < 2; ++i)
#pragma unroll
    for (int j = 0; j < 2; ++j)
#pragma unroll
      for (int g = 0; g < 4; ++g) {
        f32x4 w = {v[i][j][4 * g], v[i][j][4 * g + 1], v[i][j][4 * g + 2], v[i][j][4 * g + 3]};
        *(f32x4*)(wl + (j * 32 + r) * TP + (i * 32 + 8 * g + 4 * h) * 4) = w;
      }
  lds_fence();
#pragma unroll
  for (int it = 0; it < 16; ++it) {
    int c = lane + 64 * it, row = c >> 4, ch = c & 15;
    f32x4 d = *(const f32x4*)(wl + row * TP + ch * 16);
    f32x4 x = *(const f32x4*)(res + (size_t)row * DM + ch * 4);
    d += x;
    *(f32x4*)(wdst + (size_t)row * DM + ch * 4) = d;
  }
  lds_fence();
}

DI void norm_rope64(f32x16 (&v)[2][2], const float* __restrict__ gain, float scale, int pos0, const float* __restrict__ cs, const float* __restrict__ sn) {
  const int lane = (tidx() & 63), r = lane & 31, h = lane >> 5;
#pragma unroll
  for (int j = 0; j < 2; ++j) {
    float ss = 0.f;
#pragma unroll
    for (int e = 0; e < 16; ++e) ss += v[0][j][e] * v[0][j][e] + v[1][j][e] * v[1][j][e];
    ss = swapadd(ss);
    const float rstd = __builtin_amdgcn_rsqf(ss * (1.f / 64.f) + EPS);
    const int pos = pos0 + j * 32 + r;
#pragma unroll
    for (int g = 0; g < 4; ++g) {
      const int d = 8 * g + 4 * h;
      f32x4 c4 = *(const f32x4*)(cs + pos * 32 + d), s4 = *(const f32x4*)(sn + pos * 32 + d);
      f32x4 g1 = *(const f32x4*)(gain + d), g2 = *(const f32x4*)(gain + 32 + d);
#pragma unroll
      for (int e = 0; e < 4; ++e) {
        float x1 = v[0][j][4 * g + e] * rstd * g1[e], x2 = v[1][j][4 * g + e] * rstd * g2[e];
        v[0][j][4 * g + e] = (x1 * c4[e] - x2 * s4[e]) * scale;
        v[1][j][4 * g + e] = (x2 * c4[e] + x1 * s4[e]) * scale;
      }
    }
  }
}

DI void norm96_rope_store(f32x16 (&v)[3][2], const float* __restrict__ gain, float scale, int pos0, const float* __restrict__ cs, const float* __restrict__ sn,
                          u16* __restrict__ wdst, char* wl) {
  const int lane = (tidx() & 63), r = lane & 31, h = lane >> 5;
#pragma unroll
  for (int j = 0; j < 2; ++j) {
    float ss = 0.f;
#pragma unroll
    for (int i = 0; i < 3; ++i)
#pragma unroll
      for (int e = 0; e < 16; ++e) ss += v[i][j][e] * v[i][j][e];
    ss = swapadd(ss);
    const float rstd = __builtin_amdgcn_rsqf(ss * (1.f / 96.f) + EPS);
    const int pos = pos0 + j * 32 + r;
#pragma unroll
    for (int i = 0; i < 3; ++i)
#pragma unroll
      for (int g = 0; g < 4; ++g) {
        f32x4 g4 = *(const f32x4*)(gain + i * 32 + 8 * g + 4 * h);
#pragma unroll
        for (int e = 0; e < 4; ++e) v[i][j][4 * g + e] *= rstd * g4[e];
      }
#pragma unroll
    for (int g = 0; g < 2; ++g) {
      f32x4 c4 = *(const f32x4*)(cs + pos * 16 + 8 * g + 4 * h), s4 = *(const f32x4*)(sn + pos * 16 + 8 * g + 4 * h);
#pragma unroll
      for (int e = 0; e < 4; ++e) {
        float a = v[2][j][4 * g + e], b = v[2][j][4 * g + e + 8];
        v[2][j][4 * g + e] = a * c4[e] - b * s4[e];
        v[2][j][4 * g + e + 8] = b * c4[e] + a * s4[e];
      }
    }
#pragma unroll
    for (int i = 0; i < 3; ++i)
#pragma unroll
      for (int e = 0; e < 16; ++e) v[i][j][e] *= scale;
  }
  store_wave_bf16<3>(v, wdst, QKVC_LD, wl);
}

DI float row_ssq(const u16* __restrict__ p, int nchunk) {
  float ss = 0.f;
#pragma unroll 2
  for (int c = 0; c < nchunk; ++c) {
    u32x4 d = *(const u32x4*)(p + c * 8);
    unsigned w[4] = {d[0], d[1], d[2], d[3]};
#pragma unroll
    for (int e = 0; e < 4; ++e) { float a = bflo(w[e]), b = bfhi(w[e]); ss += a * a + b * b; }
  }
  return ss;
}

namespace pg8 {
#define PG8_LAS __attribute__((address_space(3)))
typedef unsigned short bf16_t;
typedef short bf16x8 __attribute__((ext_vector_type(8)));
typedef float f32x4 __attribute__((ext_vector_type(4)));
typedef unsigned u32x4 __attribute__((ext_vector_type(4)));
constexpr int BM = 256, BK = 64, HALF = 128, HTB = HALF * BK * 2  , STAGE_BYTES = 8 * HTB, NXCD = 8, WGM = 8;

__host__ __device__ __forceinline__ int lds_byte(int r, int c) { const int st = (r >> 4) * 2 + (c >> 5), rr = r & 15, cc = c & 31, ob = rr * 64 + cc * 2; return st * 1024 + (ob ^ (((ob >> 9) & 1) << 5)); }
__host__ __device__ __forceinline__ void stage_rc(int b, int& R, int& C) { const int st = b / 1024, sb = b % 1024, swz = sb ^ (((sb >> 9) & 1) << 5); R = (st >> 1) * 16 + swz / 64; C = (st & 1) * 32 + (swz % 64) / 2; }
__host__ __device__ __forceinline__ int perm32(int rho) { const int n = rho >> 4, i = rho & 15; return 8 * (i >> 2) + 4 * n + (i & 3); }

struct Unit { int pm, pn; };
struct Gemm { const bf16_t* A; const bf16_t* Bt; int M, N, K; };
struct StaticOrder {
    int nM, nN, nwg, G, c;
    __host__ __device__ void init(int M, int N, int G_, int c_) { nM = M / BM; nN = N / BM; nwg = nM * nN; G = G_; c = c_; }
    __host__ __device__ bool next(int i, Unit& u) const {
        const long L = (long)i * G + c; if (L >= nwg) return false;
        int wgid = (int)L; { const int q = nwg / NXCD, r = nwg % NXCD, xcd = wgid % NXCD, off = wgid / NXCD; wgid = (xcd < r ? xcd * (q + 1) : r * (q + 1) + (xcd - r) * q) + off; }
        const int nig = WGM * nN, gid = wgid / nig, fm = gid * WGM, gsz = (nM - fm) < WGM ? (nM - fm) : WGM;
        u.pm = fm + ((wgid % nig) % gsz); u.pn = (wgid % nig) / gsz; return true;
    }
    __device__ __forceinline__ void a_ready(const Unit&) const {}
    __device__ __forceinline__ void done(const Unit&) const {}
};
template <class Epi, class Sched, bool STAMP = false>
__device__ __forceinline__ void gemm_phase(PG8_LAS unsigned char* lds, const Gemm g, const Sched& S, const Epi& E, unsigned long long* stamps) {
    const int tid = tidx(), wid = __builtin_amdgcn_readfirstlane(tid >> 6), lane = tid & 63, wr = wid >> 2, wc = wid & 3, fr = lane & 15, fq = lane >> 4;
    const int K = g.K, nt = K / BK;
    int ts_lo = 0, ts_hi = 0, nts = 0; const unsigned long long rt_entry = STAMP ? (unsigned long long)wall_clock64() : 0ull;
#define PG8_STAMP() do { if (STAMP && wid == 0 && nts < 64) { const unsigned long long _c = (unsigned long long)clock64(); \
        ts_lo = (lane == nts) ? (int)(unsigned)_c : ts_lo; ts_hi = (lane == nts) ? (int)(unsigned)(_c >> 32) : ts_hi; ++nts; } } while (0)
    PG8_STAMP();
    unsigned voffA[2], voffB[2];
#pragma unroll
    for (int i = 0; i < 2; ++i) { int R, C; stage_rc(tid * 16 + i * 8192, R, C); const int Rb = Epi::PERM ? ((R & ~31) + perm32(R & 31)) : R;
        voffA[i] = (unsigned)(R * K + C) * 2u; voffB[i] = (unsigned)(Rb * K + C) * 2u; }
    const size_t kstep = (size_t)(BK * 2);
    const size_t hstep = (size_t)HALF * K * 2;
    const size_t tstep = 2 * hstep;
    const unsigned ldsw = (unsigned)wid * 1024u;
    const int aoff = lds_byte(wr * 64 + fr, fq * 8), boff = lds_byte(wc * 32 + fr, fq * 8);
#define PG8_SA(b, h) (((b) * 2 + (h)) * HTB)
#define PG8_SB(b, h) ((4 + (b) * 2 + (h)) * HTB)
#define PG8_STAGE(bufoff, gbase, voff) do { _Pragma("unroll") for (int _i = 0; _i < 2; ++_i) \
        __builtin_amdgcn_global_load_lds((const unsigned*)((const char*)(gbase) + (voff)[_i]), (PG8_LAS unsigned*)(lds + (bufoff) + ldsw + _i * 8192), 16, 0, 0); } while (0)
#define PG8_LDA(dst, b, h) do { _Pragma("unroll") for (int m = 0; m < 4; ++m) _Pragma("unroll") for (int k = 0; k < 2; ++k) dst[m][k] = *(const PG8_LAS bf16x8*)(lds + PG8_SA(b, h) + aoff + m * 2048 + k * 1024); } while (0)
#define PG8_LDB(dst, b, h) do { _Pragma("unroll") for (int n = 0; n < 2; ++n) _Pragma("unroll") for (int k = 0; k < 2; ++k) dst[n][k] = *(const PG8_LAS bf16x8*)(lds + PG8_SB(b, h) + boff + n * 2048 + k * 1024); } while (0)
#define PG8_MMA(ai, bj, At, Bt) do { __builtin_amdgcn_s_setprio(1); _Pragma("unroll") for (int m = 0; m < 4; ++m) _Pragma("unroll") for (int n = 0; n < 2; ++n) _Pragma("unroll") for (int k = 0; k < 2; ++k) \
        acc[ai][bj][m][n] = __builtin_amdgcn_mfma_f32_16x16x32_bf16(Bt[n][k], At[m][k], acc[ai][bj][m][n], 0, 0, 0); __builtin_amdgcn_s_setprio(0); } while (0)
#define PG8_WAIT_V(n) asm volatile("s_waitcnt vmcnt(" #n ")" ::: "memory")
#define PG8_WAIT_L(n) asm volatile("s_waitcnt lgkmcnt(" #n ")" ::: "memory")
#define PG8_BAR __builtin_amdgcn_s_barrier()
#define PG8_SCHED __builtin_amdgcn_sched_barrier(0)
    Unit cur, nxt; int ui = 0;
    if (!S.next(0, cur)) return;
    f32x4 acc[2][2][4][2];
#pragma unroll
    for (int a = 0; a < 2; ++a)
#pragma unroll
        for (int b = 0; b < 2; ++b)
#pragma unroll
            for (int m = 0; m < 4; ++m)
#pragma unroll
                for (int n = 0; n < 2; ++n) acc[a][b][m][n] = (f32x4){0.f, 0.f, 0.f, 0.f};
    bf16x8 At[4][2], B0[2][2], B1[2][2];
    const char* cA = (const char*)g.A + (size_t)cur.pm * tstep; const char* cB = (const char*)g.Bt + (size_t)cur.pn * tstep;
    S.a_ready(cur);
    PG8_STAGE(PG8_SB(0, 0), cB, voffB); PG8_STAGE(PG8_SA(0, 0), cA, voffA); PG8_STAGE(PG8_SB(0, 1), cB + hstep, voffB); PG8_STAGE(PG8_SA(0, 1), cA + hstep, voffA);
    if (wr == 1) PG8_BAR;
    PG8_WAIT_V(4); PG8_BAR;
    PG8_STAGE(PG8_SB(1, 0), cB + kstep, voffB); PG8_STAGE(PG8_SA(1, 0), cA + kstep, voffA); PG8_STAGE(PG8_SB(1, 1), cB + hstep + kstep, voffB);
    PG8_WAIT_V(6); PG8_BAR;
    PG8_STAMP();
    for (;;) {
        const bool has_next = S.next(ui + 1, nxt);
        const char* nA = has_next ? (const char*)g.A + (size_t)nxt.pm * tstep : cA; const char* nB = has_next ? (const char*)g.Bt + (size_t)nxt.pn * tstep : cB;
        for (int t = 0; t < nt; t += 2) {
            const bool last = (t == nt - 2);
            const char* a1 = cA + (size_t)(t + 1) * kstep;
            const char* a2 = last ? nA : cA + (size_t)(t + 2) * kstep; const char* b2 = last ? nB : cB + (size_t)(t + 2) * kstep;
            const char* a3 = a2 + kstep; const char* b3 = b2 + kstep;
            if (last && has_next) S.a_ready(nxt);
            PG8_LDB(B0, 0, 0); PG8_SCHED; PG8_LDA(At, 0, 0); PG8_STAGE(PG8_SA(1, 1), a1 + hstep, voffA);
            PG8_WAIT_L(8); PG8_BAR; PG8_WAIT_L(0); PG8_MMA(0, 0, At, B0); PG8_BAR; PG8_SCHED;
            PG8_LDB(B1, 0, 1); PG8_STAGE(PG8_SB(0, 0), b2, voffB);
            PG8_BAR; PG8_WAIT_L(0); PG8_MMA(0, 1, At, B1); PG8_BAR;
            PG8_LDA(At, 0, 1); PG8_STAGE(PG8_SA(0, 0), a2, voffA);
            PG8_BAR; PG8_WAIT_L(0); PG8_MMA(1, 0, At, B0); PG8_BAR; PG8_SCHED;
            PG8_STAGE(PG8_SB(0, 1), b2 + hstep, voffB);
            PG8_WAIT_V(6); PG8_BAR; PG8_MMA(1, 1, At, B1); PG8_BAR;
            PG8_LDB(B0, 1, 0); PG8_SCHED; PG8_LDA(At, 1, 0); PG8_STAGE(PG8_SA(0, 1), a2 + hstep, voffA);
            PG8_WAIT_L(8); PG8_BAR; PG8_WAIT_L(0); PG8_MMA(0, 0, At, B0); PG8_BAR; PG8_SCHED;
            PG8_LDB(B1, 1, 1); PG8_STAGE(PG8_SB(1, 0), b3, voffB);
            PG8_BAR; PG8_WAIT_L(0); PG8_MMA(0, 1, At, B1); PG8_BAR;
            PG8_LDA(At, 1, 1); PG8_STAGE(PG8_SA(1, 0), a3, voffA);
            PG8_BAR; PG8_WAIT_L(0); PG8_MMA(1, 0, At, B0); PG8_BAR; PG8_SCHED;
            PG8_STAGE(PG8_SB(1, 1), b3 + hstep, voffB);
            PG8_WAIT_V(6); PG8_BAR; PG8_MMA(1, 1, At, B1); PG8_BAR;
        }
        PG8_STAMP();
        if constexpr (!Epi::AFTER_DRAIN) { E(acc, cur, wr, wc, fr, fq); S.done(cur); }
        PG8_STAMP();
        if (!has_next) break;
#pragma unroll
        for (int a = 0; a < 2; ++a)
#pragma unroll
            for (int b = 0; b < 2; ++b)
#pragma unroll
                for (int m = 0; m < 4; ++m)
#pragma unroll
                    for (int n = 0; n < 2; ++n) acc[a][b][m][n] = (f32x4){0.f, 0.f, 0.f, 0.f};
        cur = nxt; cA = nA; cB = nB; ++ui;
    }
    PG8_WAIT_V(0);
    if (wr == 0) PG8_BAR;
    PG8_BAR;
    if constexpr (Epi::AFTER_DRAIN) { E.fused(acc, cur, wr, wc, fr, fq, lds, wid, lane); S.done(cur); }
    PG8_STAMP();
    if (STAMP && wid == 0) { stamps[lane] = lane < nts ? (((unsigned long long)(unsigned)ts_hi << 32) | (unsigned)ts_lo) : 0ull;
        if (lane == 62) stamps[62] = rt_entry; if (lane == 63) stamps[63] = (unsigned long long)wall_clock64(); }
#undef PG8_STAMP
#undef PG8_SA
#undef PG8_SB
#undef PG8_STAGE
#undef PG8_LDA
#undef PG8_LDB
#undef PG8_MMA
#undef PG8_WAIT_V
#undef PG8_WAIT_L
#undef PG8_BAR
#undef PG8_SCHED
}
}

DI float quadsum(float x) {
  auto rr = __builtin_amdgcn_permlane16_swap(__float_as_uint(x), __float_as_uint(x), false, false);
  x = __uint_as_float(rr[0]) + __uint_as_float(rr[1]);
  return swapadd(x);
}
struct EpiP1 {
  static constexpr bool PERM = true, AFTER_DRAIN = false;
  u16* qkv; const float* cs; const float* sn; const float* const* in; int layer; unsigned char* gate;
  DI void operator()(const pg8::f32x4 (&acc)[2][2][4][2], const pg8::Unit& u, int wr, int wc, int fr_, int fq_) const {
    const int lane = tidx() & 63, fr = lane & 15, fq = lane >> 4;
    if (u.pn >= 20) {
#pragma unroll
      for (int ai = 0; ai < 2; ++ai)
#pragma unroll
        for (int m = 0; m < 4; ++m) {
          const int row = u.pm * 256 + ai * 128 + wr * 64 + m * 16 + fr;
          unsigned char* gp = gate + (size_t)row * 4096 + (u.pn - 20) * 256 + wc * 32 + 8 * fq;
#pragma unroll
          for (int bj = 0; bj < 2; ++bj) {
            unsigned w2[2];
#pragma unroll
            for (int n = 0; n < 2; ++n) {
              unsigned wv = 0u;
#pragma unroll
              for (int e = 0; e < 4; ++e) {
                const float sg = __builtin_amdgcn_rcpf(1.f + __builtin_amdgcn_exp2f(-acc[ai][bj][m][n][e] * LOG2E));
                wv |= ((unsigned)(sg * 255.f + 0.5f)) << (8 * e);
              }
              w2[n] = wv;
            }
            u32x2 wq = {w2[0], w2[1]};
            *(u32x2*)(gp + bj * 128) = wq;
          }
        }
      return;
    }
    const int n64 = u.pn * 4 + wc;
    const float* gain = nullptr; float scale = 1.f;
    if (n64 < 8) { gain = in[5] + layer * 64; scale = QS64; }
    else if (n64 < 16) { gain = in[6] + layer * 64; }
    else if (n64 < 24) {}
    else if (n64 < 60) {
      int tt = n64 - 24, g = tt / 12, jj = (tt % 12) >> 2;
      if (jj == 0) { gain = in[9] + (layer * 3 + g) * 64; scale = QS64; }
      else if (jj == 1) { gain = in[10] + (layer * 3 + g) * 64; }
    }
    else if (n64 < 68) { gain = in[17] + layer * 64; scale = QS64; }
    else if (n64 < 70) { gain = in[18] + layer * 64; }
#pragma unroll
    for (int ai = 0; ai < 2; ++ai)
#pragma unroll
      for (int m = 0; m < 4; ++m) {
        const int row = u.pm * 256 + ai * 128 + wr * 64 + m * 16 + fr;
        f32x4 v[2][2];
#pragma unroll
        for (int bj = 0; bj < 2; ++bj)
#pragma unroll
          for (int n = 0; n < 2; ++n) v[bj][n] = acc[ai][bj][m][n];
        if (gain) {
          float ss = 0.f;
#pragma unroll
          for (int bj = 0; bj < 2; ++bj)
#pragma unroll
            for (int n = 0; n < 2; ++n)
#pragma unroll
              for (int e = 0; e < 4; ++e) ss += v[bj][n][e] * v[bj][n][e];
          ss = quadsum(ss);
          const float rstd = __builtin_amdgcn_rsqf(ss * (1.f / 64.f) + EPS);
          const int pos = row & (SEQ - 1);
#pragma unroll
          for (int n = 0; n < 2; ++n) {
            const int d = 8 * fq + 4 * n;
            f32x4 c4 = *(const f32x4*)(cs + pos * 32 + d), s4 = *(const f32x4*)(sn + pos * 32 + d);
            f32x4 g1 = *(const f32x4*)(gain + d), g2 = *(const f32x4*)(gain + 32 + d);
#pragma unroll
            for (int e = 0; e < 4; ++e) {
              float x1 = v[0][n][e] * rstd * g1[e], x2 = v[1][n][e] * rstd * g2[e];
              v[0][n][e] = (x1 * c4[e] - x2 * s4[e]) * scale;
              v[1][n][e] = (x2 * c4[e] + x1 * s4[e]) * scale;
            }
          }
        }
        u16* rowp = qkv + (size_t)row * NINP + n64 * 64 + 8 * fq;
#pragma unroll
        for (int bj = 0; bj < 2; ++bj) {
          u32x4 w = {cvtpk(v[bj][0][0], v[bj][0][1]), cvtpk(v[bj][0][2], v[bj][0][3]), cvtpk(v[bj][1][0], v[bj][1][1]), cvtpk(v[bj][1][2], v[bj][1][3])};
          *(u32x4*)(rowp + bj * 32) = w;
        }
      }
  }
};
struct EpiRes {
  static constexpr bool PERM = false, AFTER_DRAIN = false;
  const float* resid; float* out;
  DI void operator()(const pg8::f32x4 (&acc)[2][2][4][2], const pg8::Unit& u, int wr, int wc, int fr_, int fq_) const {
    const int lane = tidx() & 63, fr = lane & 15, fq = lane >> 4;
#pragma unroll
    for (int ai = 0; ai < 2; ++ai)
#pragma unroll
      for (int m = 0; m < 4; ++m) {
        const size_t o = (size_t)(u.pm * 256 + ai * 128 + wr * 64 + m * 16 + fr) * DM + u.pn * 256 + wc * 32 + 4 * fq;
#pragma unroll
        for (int bj = 0; bj < 2; ++bj)
#pragma unroll
          for (int n = 0; n < 2; ++n) {
            f32x4 x = *(const f32x4*)(resid + o + bj * 128 + n * 16);
            *(f32x4*)(out + o + bj * 128 + n * 16) = x + acc[ai][bj][m][n];
          }
      }
  }
};
struct EpiSwiglu {
  static constexpr bool PERM = true, AFTER_DRAIN = false;
  u16* act;
  DI void operator()(const pg8::f32x4 (&acc)[2][2][4][2], const pg8::Unit& u, int wr, int wc, int fr_, int fq_) const {
    const int lane = tidx() & 63, fr = lane & 15, fq = lane >> 4;
#pragma unroll
    for (int ai = 0; ai < 2; ++ai)
#pragma unroll
      for (int m = 0; m < 4; ++m) {
        const int row = u.pm * 256 + ai * 128 + wr * 64 + m * 16 + fr;
        float a[8];
#pragma unroll
        for (int n = 0; n < 2; ++n)
#pragma unroll
          for (int e = 0; e < 4; ++e) {
            float gte = acc[ai][0][m][n][e];
            a[4 * n + e] = gte * __builtin_amdgcn_rcpf(1.f + __builtin_amdgcn_exp2f(-gte * LOG2E)) * acc[ai][1][m][n][e];
          }
        u32x4 w = {cvtpk(a[0], a[1]), cvtpk(a[2], a[3]), cvtpk(a[4], a[5]), cvtpk(a[6], a[7])};
        *(u32x4*)(act + (size_t)row * DFF + u.pn * 128 + wc * 32 + 8 * fq) = w;
      }
  }
};

DI void repack_tile(const float* __restrict__ src, const float* __restrict__ src2, int nsrc, u16* __restrict__ dst, int K, int n0, int k0, int mode,
                    const float* __restrict__ gain, char* lds) {
  float* tile = (float*)lds;
  const int tid = tidx();
  {
    const int nn = tid & 63, kk0 = tid >> 6;
    const int np = n0 + nn;
    const float* s = src; int col = np; bool valid = true;
    if (mode == 1) {
      const int rho = np & 255, lg = ((np >> 8) * 4 + ((rho >> 5) & 3)) * 64 + 32 * (rho >> 7) + (rho & 31);
      if (lg < 3840) col = lg; else if (lg < 4608) col = 4256 + (lg - 3840); else if (lg < 5024) col = 3840 + (lg - 4608); else valid = false;
    } else if (mode == 2) {
      const int rho = np & 255;
      col = (np >> 8) * 128 + (rho & 127);
      if (rho >= 128) s = src2;
    }
#pragma unroll
    for (int i = 0; i < 8; ++i) {
      int kk = kk0 + 8 * i;
      float v = valid ? s[(size_t)(k0 + kk) * nsrc + col] : 0.f;
      if (gain) v *= gain[k0 + kk];
      tile[kk * 65 + nn] = v;
    }
  }
  __syncthreads();
  {
    const int n = tid >> 3, kc = (tid & 7) * 8;
    float f[8];
#pragma unroll
    for (int i = 0; i < 8; ++i) f[i] = tile[(kc + i) * 65 + n];
    u32x4 w = {cvtpk(f[0], f[1]), cvtpk(f[2], f[3]), cvtpk(f[4], f[5]), cvtpk(f[6], f[7])};
    *(u32x4*)(dst + (size_t)(n0 + n) * K + k0 + kc) = w;
  }
  __syncthreads();
}

DI void sincos_acc(float ang, float& c, float& s) {
  double a = (double)ang;
  double t = a * 0.15915494309189535;
  double fr = t - rint(t);
  double x = fr * 6.283185307179586;
  double x2 = x * x;
  double ts = x, tc = 1.0, ssum = x, csum = 1.0;
  for (int n = 1; n <= 14; ++n) {
    tc *= -x2 / (double)((2 * n - 1) * (2 * n));
    ts *= -x2 / (double)((2 * n) * (2 * n + 1));
    csum += tc; ssum += ts;
  }
  c = (float)csum; s = (float)ssum;
}

__device__ __forceinline__ void phase_w(const Params& p, char* lds) {
  char* const ws = lws(p.ws);
  constexpr int PER_LAYER = 5200;
  for (int t = blockIdx.x; t < PER_LAYER * DEPTH; t += gridDim.x) {
    const int l = t / PER_LAYER; int u = t % PER_LAYER;
    if (u < 1280) {
      repack_tile(p.in[3] + (size_t)l * 1024 * 5024, nullptr, 5024, (u16*)(ws + OFF_WIN) + (size_t)l * NIN2 * 1024, 1024, (u >> 4) * 64, (u & 15) * 64, 1, nullptr, lds);
      continue;
    }
    u -= 1280;
    if (u < 1024) {
      repack_tile(p.in[4] + (size_t)l * 1024 * 4096, nullptr, 4096, (u16*)(ws + OFF_WIN) + ((size_t)l * NIN2 + NINP) * 1024, 1024, (u >> 4) * 64, (u & 15) * 64, 0, nullptr, lds);
      continue;
    }
    u -= 1024;
    if (u < 48) {
      repack_tile(p.in[13] + (size_t)l * 256 * 768, nullptr, 768, (u16*)(ws + OFF_WUQ) + (size_t)l * 768 * 256, 256, (u >> 2) * 64, (u & 3) * 64, 0, p.in[11] + l * 256, lds);
      continue;
    }
    u -= 48;
    if (u < 32) {
      repack_tile(p.in[14] + (size_t)l * 128 * 1024, nullptr, 1024, (u16*)(ws + OFF_WUKV) + (size_t)l * 1024 * 128, 128, (u >> 1) * 64, (u & 1) * 64, 0, p.in[12] + l * 128, lds);
      continue;
    }
    u -= 32;
    if (u < 448) {
      u16* wbr = (u16*)(ws + OFF_WBR) + (size_t)l * 1024 * 1792;
      if (u < 128) repack_tile(p.in[20] + (size_t)l * 512 * 1024, nullptr, 1024, wbr, 512, (u >> 3) * 64, (u & 7) * 64, 0, nullptr, lds);
      else if (u < 192) { u -= 128; repack_tile(p.in[21] + (size_t)l * 256 * 1024, nullptr, 1024, wbr + 1024 * 512, 256, (u >> 2) * 64, (u & 3) * 64, 0, nullptr, lds); }
      else if (u < 320) { u -= 192; repack_tile(p.in[22] + (size_t)l * 512 * 1024, nullptr, 1024, wbr + 1024 * 768, 512, (u >> 3) * 64, (u & 7) * 64, 0, nullptr, lds); }
      else { u -= 320; repack_tile(p.in[23] + (size_t)l * 512 * 1024, nullptr, 1024, wbr + 1024 * 1280, 512, (u >> 3) * 64, (u & 7) * 64, 0, nullptr, lds); }
      continue;
    }
    u -= 448;
    if (u < 256) {
      repack_tile(p.in[24] + (size_t)l * 1024 * 1024, nullptr, 1024, (u16*)(ws + OFF_WO) + (size_t)l * 1024 * 1024, 1024, (u >> 4) * 64, (u & 15) * 64, 0, nullptr, lds);
      continue;
    }
    u -= 256;
    if (u < 1408) {
      repack_tile(p.in[26] + (size_t)l * 1024 * DFF, p.in[27] + (size_t)l * 1024 * DFF, DFF, (u16*)(ws + OFF_WGU) + (size_t)l * NGU * 1024, 1024, (u >> 4) * 64, (u & 15) * 64, 2, nullptr, lds);
      continue;
    }
    u -= 1408;
    repack_tile(p.in[28] + (size_t)l * DFF * 1024, nullptr, 1024, (u16*)(ws + OFF_WDN) + (size_t)l * 1024 * DFF, DFF, (u / 44) * 64, (u % 44) * 64, 0, nullptr, lds);
  }
  const int gt = blockIdx.x * 512 + tidx(), ngt = gridDim.x * 512;
  float* c64 = (float*)(ws + OFF_COS64); float* s64 = (float*)(ws + OFF_SIN64);
  float* c32 = (float*)(ws + OFF_COS32); float* s32 = (float*)(ws + OFF_SIN32);
  for (int i = gt; i < SEQ * 32; i += ngt) {
    int pos = i >> 5, f = i & 31; float c, s;
    sincos_acc((float)pos * p.inv64[f], c, s);
    c64[i] = c; s64[i] = s;
  }
  for (int i = gt; i < SEQ * 16; i += ngt) {
    int pos = i >> 4, f = i & 15; float c, s;
    sincos_acc((float)pos * p.inv32[f], c, s);
    c32[i] = c; s32[i] = s;
  }
  if (blockIdx.x == 0)
    for (int i = tidx(); i < 3456; i += 512) __hip_atomic_store((unsigned*)(ws + OFF_BAR) + i, 0u, __ATOMIC_RELAXED, __HIP_MEMORY_SCOPE_AGENT);
  if (gt < DEPTH) {
    const float* lp = p.in[7] + gt * 256;
    float a = 0.f, b = 0.f;
    for (int i = 0; i < 64; ++i) { a += lp[i] * lp[64 + i]; b += lp[128 + i] * lp[192 + i]; }
    ((float*)(ws + OFF_LAM))[gt] = expf(a) - expf(b) + p.lam_init[gt];
  }
}

__device__ __forceinline__ void phase_norm(const float* __restrict__ x, const float* __restrict__ g, u16* __restrict__ xn) {
  const int lane = tidx() & 63, wid = wave_id();
  for (int row = blockIdx.x * 8 + wid; row < CT; row += gridDim.x * 8) {
    const f32x4* xr = (const f32x4*)(x + (size_t)row * DM);
    f32x4 v[4]; float ss = 0.f;
#pragma unroll
    for (int i = 0; i < 4; ++i) { v[i] = xr[lane + 64 * i]; ss += v[i][0] * v[i][0] + v[i][1] * v[i][1] + v[i][2] * v[i][2] + v[i][3] * v[i][3]; }
    ss = swapadd(ss);
#pragma unroll
    for (int o = 16; o >= 1; o >>= 1) ss += __int_as_float(__builtin_amdgcn_ds_bpermute((lane ^ o) << 2, __float_as_int(ss)));
    const float rstd = __builtin_amdgcn_rsqf(ss * (1.f / 1024.f) + EPS);
#pragma unroll
    for (int i = 0; i < 4; ++i) {
      f32x4 g4 = ((const f32x4*)g)[lane + 64 * i];
      u32x2 w = {cvtpk(v[i][0] * rstd * g4[0], v[i][1] * rstd * g4[1]), cvtpk(v[i][2] * rstd * g4[2], v[i][3] * rstd * g4[3])};
      *(u32x2*)(xn + (size_t)row * DM + (lane + 64 * i) * 4) = w;
    }
  }
}

__device__ __forceinline__ void phase_p1(const Params& p, int layer, char* lds) {
  char* const ws = lws(p.ws);
  pg8::Gemm g{(const u16*)(ws + OFF_XN), (const u16*)(ws + OFF_WIN) + (size_t)layer * NIN2 * 1024, CT, NIN2, 1024};
  pg8::StaticOrder S; S.init(CT, NIN2, gridDim.x, blockIdx.x);
  EpiP1 E{(u16*)(ws + OFF_QKV), (const float*)(ws + OFF_COS64), (const float*)(ws + OFF_SIN64), p.in, layer, (unsigned char*)(ws + OFF_GATE)};
  __syncthreads();
  pg8::gemm_phase<EpiP1, pg8::StaticOrder, false>((PG8_LAS unsigned char*)lds, g, S, E, nullptr);
}

__device__ __forceinline__ void phase_p1c(const Params& p, int layer, char* lds) {
  char* const ws = lws(p.ws);
  const u16* Wuq = (const u16*)(ws + OFF_WUQ) + (size_t)layer * 768 * 256;
  const u16* Wukv = (const u16*)(ws + OFF_WUKV) + (size_t)layer * 1024 * 128;
  const u16* qkv = (const u16*)(ws + OFF_QKV);
  u16* qc = (u16*)(ws + OFF_QKVC);
  const float* c32 = (const float*)(ws + OFF_COS32); const float* s32 = (const float*)(ws + OFF_SIN32);
  const int tid = tidx(), wid = wave_id(), wn = wid & 3, wm = wid >> 2;
  char* wl = lds + wid * WAVE_LDS;
  for (int t = blockIdx.x; t < 2 * 128; t += gridDim.x) {
    int nt, mt; tile_map(t, nt, mt);
    const int n0 = nt * 384, m0 = mt * 128;
    f32x16 acc[3][2];
    gemm_core<3>(acc, Wuq + (size_t)n0 * 256, 256, qkv + (size_t)m0 * NINP + 4608, NINP, 256, lds);
    const int lane2 = (tidx() & 63), r = lane2 & 31, h = lane2 >> 5;
#pragma unroll
    for (int j = 0; j < 2; ++j) {
      const int m = m0 + wm * 64 + j * 32 + r;
      float ss = swapadd(row_ssq(qkv + (size_t)m * NINP + 4608 + h * 128, 16));
      const float rq = __builtin_amdgcn_rsqf(ss * (1.f / 256.f) + EPS);
#pragma unroll
      for (int i = 0; i < 3; ++i)
#pragma unroll
        for (int e = 0; e < 16; ++e) acc[i][j][e] *= rq;
    }
    norm96_rope_store(acc, p.in[15] + layer * 96, QS96, (m0 + wm * 64) & (SEQ - 1), c32, s32, qc + (size_t)(m0 + wm * 64) * QKVC_LD + n0 + wn * 96, wl);
  }
  for (int t = blockIdx.x; t < 4 * 128; t += gridDim.x) {
    int nt, mt; tile_map(t, nt, mt);
    const int n0 = nt * 256, m0 = mt * 128;
    f32x16 acc[3][2];
    gemm_core<2, 3>(acc, Wukv + (size_t)n0 * 128, 128, qkv + (size_t)m0 * NINP + 4864, NINP, 128, lds);
    const int n64 = (n0 >> 6) + wn, head = n64 >> 1, isv = n64 & 1;
    const int lane2 = (tidx() & 63), r = lane2 & 31, h = lane2 >> 5;
#pragma unroll
    for (int j = 0; j < 2; ++j) {
      const int m = m0 + wm * 64 + j * 32 + r;
      float ss = swapadd(row_ssq(qkv + (size_t)m * NINP + 4864 + h * 64, 8));
      const float rk = __builtin_amdgcn_rsqf(ss * (1.f / 128.f) + EPS);
#pragma unroll
      for (int i = 0; i < 2; ++i)
#pragma unroll
        for (int e = 0; e < 16; ++e) acc[i][j][e] *= rk;
    }
    if (isv) {
      store_wave_bf16<2, 3>(acc, qc + (size_t)(m0 + wm * 64) * QKVC_LD + 1536 + head * 64, QKVC_LD, wl);
    } else {
      f32x16 (&y)[3][2] = acc;
#pragma unroll
      for (int j = 0; j < 2; ++j) {
        const int m = m0 + wm * 64 + j * 32 + r;
#pragma unroll
        for (int g = 0; g < 4; ++g) {
          u32x2 d = *(const u32x2*)(qkv + (size_t)m * NINP + 4992 + 8 * g + 4 * h);
          y[2][j][4 * g] = bflo(d[0]); y[2][j][4 * g + 1] = bfhi(d[0]); y[2][j][4 * g + 2] = bflo(d[1]); y[2][j][4 * g + 3] = bfhi(d[1]);
        }
      }
      norm96_rope_store(y, p.in[16] + layer * 96, 1.f, (m0 + wm * 64) & (SEQ - 1), c32, s32, qc + (size_t)(m0 + wm * 64) * QKVC_LD + 768 + head * 96, wl);
    }
  }
}

constexpr int QLDS_OFF = 77824, QLDS_WAVE = 64 * 144;
template <int DQK, int DV, int NKT, bool BANDED, bool QLDS = false>
DI void attn_loop(f32x16 (&O)[2][DV / 32], float (&mrun)[2], float (&lrun)[2], const bf16x8 (&qf)[2][DQK / 16],
                  const u16* __restrict__ k0p, const u16* __restrict__ k1p, size_t kld, const u16* __restrict__ vp, size_t vld,
                  int t0, int t1, bool wact, int qbase, int W, char* lds) {
  constexpr int KP = DQK * 2 + 16, VP = DV * 2 + 64;
  constexpr int KC = DQK / 8, VC = DV / 8;
  constexpr int KTOT = NKT * 64 * KC, VTOT = 64 * VC, TOT = KTOT + VTOT, NIT = (TOT + 511) / 512;
  constexpr int SB = NKT * 64 * KP + 64 * VP;
  constexpr float THR = 8.f;
  const int tid = tidx(), lane = tid & 63, r = lane & 31, h = lane >> 5;
  const int dk1 = NKT == 2 ? (int)(k1p - k0p) : 0, dvo = (int)(vp - k0p);
  const int ldi = (int)kld;
  int soff[NIT]; int doff[NIT]; bool sval[NIT];
#pragma unroll
  for (int it = 0; it < NIT; ++it) {
    const int c = tid + it * 512;
    const bool allK = (it + 1) * 512 <= KTOT, allV = it * 512 >= KTOT;
    const bool isK = allK ? true : (allV ? false : (c < KTOT));
    const int kt = c / (64 * KC), rem = c % (64 * KC), krow = rem / KC, kcol = rem % KC;
    const int c2 = c - KTOT, vrow = c2 / VC, vcol = c2 % VC;
    const int so_k = (kt ? dk1 : 0) + krow * ldi + kcol * 8, do_k = kt * 64 * KP + krow * KP + kcol * 16;
    const int so_v = dvo + vrow * ldi + vcol * 8, do_v = NKT * 64 * KP + vrow * VP + vcol * 16;
    soff[it] = isK ? so_k : so_v;
    doff[it] = isK ? do_k : do_v;
    sval[it] = ((it + 1) * 512 <= TOT) ? true : (c < TOT);
  }
  u32x4 rg[NIT];
  const __amdgpu_buffer_rsrc_t krsrc = __builtin_amdgcn_make_buffer_rsrc((void*)k0p, 0, 0x7fffffff, 0x00020000);
  const int kaddr = r * KP + h * 16;
  const char* const qlds = lds + QLDS_OFF + wave_id() * QLDS_WAVE + r * 144 + h * 16;
  const int vaddr = NKT * 64 * KP + (4 * h + ((lane & 15) >> 2)) * VP + (((lane >> 4) & 1) * 16 + (lane & 3) * 4) * 2;
  if (t1 <= t0) return;
  __syncthreads();
#pragma unroll
  for (int it = 0; it < NIT; ++it) if (sval[it]) rg[it] = __builtin_amdgcn_raw_buffer_load_b128(krsrc, soff[it] * 2, t0 * 128 * ldi, 0);
#pragma unroll
  for (int it = 0; it < NIT; ++it) if (sval[it]) *(u32x4*)(lds + doff[it]) = rg[it];
  __syncthreads();
#pragma nounroll
  for (int t = t0; t < t1; ++t) {
    const int buf = (t - t0) & 1;
    const bool more = t + 1 < t1;
    if (more && NKT == 1) {
#pragma unroll
      for (int it = 0; it < NIT; ++it) if (sval[it]) rg[it] = __builtin_amdgcn_raw_buffer_load_b128(krsrc, soff[it] * 2, (t + 1) * 128 * ldi, 0);
    }
    bool doit = wact;
    if (BANDED) doit = wact && (t * 64 + 63 >= qbase - W) && (t * 64 <= qbase + 63 + W);
    if (doit) {
      const char* base = lds + buf * SB;
      bf16x8 pf[2][4];
      if (NKT == 1) {
        f32x16 S[2][2];
#pragma unroll
        for (int j = 0; j < 2; ++j)
#pragma unroll
          for (int kb = 0; kb < 2; ++kb)
#pragma unroll
            for (int e = 0; e < 16; ++e) S[j][kb][e] = 0.f;
#pragma unroll
        for (int s = 0; s < DQK / 16; ++s)
#pragma unroll
          for (int kb = 0; kb < 2; ++kb) {
            bf16x8 kf = *(const bf16x8*)(base + kaddr + kb * 32 * KP + s * 32);
#pragma unroll
            for (int j = 0; j < 2; ++j) S[j][kb] = MFMA(kf, qf[j][s], S[j][kb]);
          }
#pragma unroll
        for (int j = 0; j < 2; ++j) {
          if (BANDED) {
            const int qi = qbase + j * 32 + r;
#pragma unroll
            for (int kb = 0; kb < 2; ++kb)
#pragma unroll
              for (int e = 0; e < 16; ++e) {
                int ki = t * 64 + kb * 32 + crow(e, h);
                int dd = qi - ki; dd = dd < 0 ? -dd : dd;
                if (dd > W) S[j][kb][e] = -1e30f;
              }
          }
          float pmax = S[j][0][0];
#pragma unroll
          for (int e = 1; e < 16; ++e) pmax = fmaxf(pmax, S[j][0][e]);
#pragma unroll
          for (int e = 0; e < 16; ++e) pmax = fmaxf(pmax, S[j][1][e]);
          pmax = swapmax(pmax);
          if (!__all(pmax - mrun[j] <= THR)) {
            float mn = fmaxf(mrun[j], pmax);
            float alpha = __builtin_amdgcn_exp2f(mrun[j] - mn);
            mrun[j] = mn; lrun[j] *= alpha;
#pragma unroll
            for (int d = 0; d < DV / 32; ++d)
#pragma unroll
              for (int e = 0; e < 16; ++e) O[j][d][e] *= alpha;
          }
          float ps = 0.f; const float mm = mrun[j];
#pragma unroll
          for (int kb = 0; kb < 2; ++kb)
#pragma unroll
            for (int e = 0; e < 16; ++e) { float pv = __builtin_amdgcn_exp2f(S[j][kb][e] - mm); S[j][kb][e] = pv; ps += pv; }
          lrun[j] += ps;
#pragma unroll
          for (int ks = 0; ks < 4; ++ks) {
            const int kb = ks >> 1, b8 = (ks & 1) * 8;
            u32x4 w = {cvtpk(S[j][kb][b8], S[j][kb][b8 + 1]), cvtpk(S[j][kb][b8 + 2], S[j][kb][b8 + 3]),
                       cvtpk(S[j][kb][b8 + 4], S[j][kb][b8 + 5]), cvtpk(S[j][kb][b8 + 6], S[j][kb][b8 + 7])};
            pf[j][ks] = __builtin_bit_cast(bf16x8, w);
          }
        }
      } else {
#pragma unroll
        for (int j = 0; j < 2; ++j) {
          f32x16 S[2];
#pragma unroll
          for (int kb = 0; kb < 2; ++kb)
#pragma unroll
            for (int e = 0; e < 16; ++e) S[kb][e] = 0.f;
          {
            constexpr int NS = DQK / 16;
            const char* kbase = base + j * 64 * KP + kaddr;
            const char* qbase_l = qlds + j * 32 * 144;
#define A1_KF(s_, kb_) (*(const bf16x8*)(kbase + (kb_) * 32 * KP + (s_) * 32))
#define A1_QF(s_) (QLDS ? *(const bf16x8*)(qbase_l + (s_) * 32) : qf[j][(s_)])
            bf16x8 ka = A1_KF(0, 0), kb2 = A1_KF(0, 1), qa = A1_QF(0);
            __builtin_amdgcn_sched_barrier(0);
#pragma unroll
            for (int s2 = 0; s2 < NS; ++s2) {
              bf16x8 kn0, kn1, qn;
              if (s2 + 1 < NS) { kn0 = A1_KF(s2 + 1, 0); kn1 = A1_KF(s2 + 1, 1); qn = A1_QF(s2 + 1); }
              __builtin_amdgcn_sched_barrier(0);
              S[0] = MFMA(ka, qa, S[0]);
              S[1] = MFMA(kb2, qa, S[1]);
              __builtin_amdgcn_sched_barrier(0);
              if (s2 + 1 < NS) { ka = kn0; kb2 = kn1; qa = qn; }
            }
#undef A1_KF
#undef A1_QF
          }
          float pmax = S[0][0];
#pragma unroll
          for (int e = 1; e < 16; ++e) pmax = fmaxf(pmax, S[0][e]);
#pragma unroll
          for (int e = 0; e < 16; ++e) pmax = fmaxf(pmax, S[1][e]);
          pmax = swapmax(pmax);
          if (!__all(pmax - mrun[j] <= THR)) {
            float mn = fmaxf(mrun[j], pmax);
            float alpha = __builtin_amdgcn_exp2f(mrun[j] - mn);
            mrun[j] = mn; lrun[j] *= alpha;
#pragma unroll
            for (int d = 0; d < DV / 32; ++d)
#pragma unroll
              for (int e = 0; e < 16; ++e) O[j][d][e] *= alpha;
          }
          float ps = 0.f; const float mm = mrun[j];
#pragma unroll
          for (int kb = 0; kb < 2; ++kb)
#pragma unroll
            for (int e = 0; e < 16; ++e) { float pv = __builtin_amdgcn_exp2f(S[kb][e] - mm); S[kb][e] = pv; ps += pv; }
          lrun[j] += ps;
#pragma unroll
          for (int ks = 0; ks < 4; ++ks) {
            const int kb = ks >> 1, b8 = (ks & 1) * 8;
            u32x4 w = {cvtpk(S[kb][b8], S[kb][b8 + 1]), cvtpk(S[kb][b8 + 2], S[kb][b8 + 3]),
                       cvtpk(S[kb][b8 + 4], S[kb][b8 + 5]), cvtpk(S[kb][b8 + 6], S[kb][b8 + 7])};
            pf[j][ks] = __builtin_bit_cast(bf16x8, w);
          }
          {
            constexpr int ND = DV / 32, NV = 4 * ND;
            const char* vbase = base + vaddr;
            auto vread = [&](int i) -> bf16x8 {
              const char* va = vbase + (i / ND) * 16 * VP + (i % ND) * 64;
              s16x4 lo = __builtin_amdgcn_ds_read_tr16_b64_v4i16((__attribute__((address_space(3))) s16x4*)(va));
              s16x4 hi = __builtin_amdgcn_ds_read_tr16_b64_v4i16((__attribute__((address_space(3))) s16x4*)(va + 8 * VP));
              bf16x8 vf = {lo[0], lo[1], lo[2], lo[3], hi[0], hi[1], hi[2], hi[3]};
              return vf;
            };
            bf16x8 v0 = vread(0), v1 = vread(1);
            __builtin_amdgcn_sched_barrier(0);
#pragma unroll
            for (int i = 0; i < NV; i += 2) {
              O[j][i % ND] = MFMA(v0, pf[j][i / ND], O[j][i % ND]);
              if (i + 2 < NV) v0 = vread(i + 2);
              __builtin_amdgcn_sched_barrier(0);
              O[j][(i + 1) % ND] = MFMA(v1, pf[j][(i + 1) / ND], O[j][(i + 1) % ND]);
              if (i + 3 < NV) v1 = vread(i + 3);
              __builtin_amdgcn_sched_barrier(0);
            }
            if (j == 0 && more) {
#pragma unroll
              for (int it = 0; it < NIT; ++it) if (sval[it]) rg[it] = __builtin_amdgcn_raw_buffer_load_b128(krsrc, soff[it] * 2, (t + 1) * 128 * ldi, 0);
              __builtin_amdgcn_sched_barrier(0);
            }
          }
        }
      }
      if (NKT == 1) {
#pragma unroll
        for (int ks = 0; ks < 4; ++ks)
#pragma unroll
          for (int d = 0; d < DV / 32; ++d) {
            const char* va = base + vaddr + ks * 16 * VP + d * 64;
            s16x4 lo = __builtin_amdgcn_ds_read_tr16_b64_v4i16((__attribute__((address_space(3))) s16x4*)(va));
            s16x4 hi = __builtin_amdgcn_ds_read_tr16_b64_v4i16((__attribute__((address_space(3))) s16x4*)(va + 8 * VP));
            bf16x8 vf = {lo[0], lo[1], lo[2], lo[3], hi[0], hi[1], hi[2], hi[3]};
#pragma unroll
            for (int j = 0; j < 2; ++j) O[j][d] = MFMA(vf, pf[j][ks], O[j][d]);
          }
      }
    }
    if (more) {
      char* nb = lds + (buf ^ 1) * SB;
#pragma unroll
      for (int it = 0; it < NIT; ++it) if (sval[it]) *(u32x4*)(nb + doff[it]) = rg[it];
    }
    __syncthreads();
  }
}

template <int NS>
DI void load_qf(bf16x8 (&qf)[NS], const u16* __restrict__ qrow) {
#pragma unroll
  for (int s = 0; s < NS; ++s) qf[s] = *(const bf16x8*)(qrow + s * 16);
}

template <int ND>
DI void store_o(const f32x16 (&o)[ND], float scale, u16* __restrict__ dst, int h) {
#pragma unroll
  for (int d = 0; d < ND; ++d)
#pragma unroll
    for (int g = 0; g < 4; ++g) {
      u32x2 w = {cvtpk(o[d][4 * g] * scale, o[d][4 * g + 1] * scale), cvtpk(o[d][4 * g + 2] * scale, o[d][4 * g + 3] * scale)};
      *(u32x2*)(dst + d * 32 + 8 * g + 4 * h) = w;
    }
}

DI void item_map(int idx, int nqb, int& sh, int& qb) {
  int xcd = idx & 7, slot = idx >> 3;
  sh = xcd * (32 / nqb) + slot / nqb;
  qb = slot % nqb;
}

__device__ __forceinline__ void attn_A(const Params& p, int layer, int idx, char* lds) {
  char* const ws = lws(p.ws);
  const int tid = tidx(), lane = tid & 63, wid = wave_id(), r = lane & 31, h = lane >> 5;
  int sh, qb; item_map(idx, 16, sh, qb);
  const int seq = sh >> 2, head = sh & 3;
  const u16* qkv = (const u16*)(ws + OFF_QKV) + (size_t)seq * SEQ * NINP;
  u16* outs = (u16*)(ws + OFF_OUTS) + (size_t)seq * SEQ * OUT_LD;
  const int q0 = qb * 256 + wid * 32;
  bf16x8 qf[2][4];
  __syncthreads();
#pragma unroll
  for (int j = 0; j < 2; ++j) {
    load_qf<4>(qf[j], qkv + (size_t)(q0 + r) * NINP + (head * 2 + j) * 64 + h * 8);
#pragma unroll
    for (int s = 0; s < 4; ++s) *(bf16x8*)(lds + QLDS_OFF + wid * QLDS_WAVE + (j * 32 + r) * 144 + h * 16 + s * 32) = qf[j][s];
  }
  lds_fence();
  f32x16 O[2][4]; float mrun[2] = {-1e29f, -1e29f}, lrun[2] = {0.f, 0.f};
#pragma unroll
  for (int j = 0; j < 2; ++j)
#pragma unroll
    for (int d = 0; d < 4; ++d)
#pragma unroll
      for (int e = 0; e < 16; ++e) O[j][d][e] = 0.f;
  attn_loop<64, 128, 2, false, true>(O, mrun, lrun, qf, qkv + 512 + (head * 2) * 64, qkv + 512 + (head * 2 + 1) * 64, NINP, qkv + 1024 + head * 128, NINP,
                               0, 64, true, 0, 0, lds);
  const int lane2 = (tidx() & 63), r2 = lane2 & 31, h2 = lane2 >> 5;
  const float lam = ((const float*)(ws + OFF_LAM))[layer];
  const float i0 = 1.f / swapadd(lrun[0]), i1 = lam / swapadd(lrun[1]);
  float ss = 0.f;
#pragma unroll
  for (int d = 0; d < 4; ++d)
#pragma unroll
    for (int e = 0; e < 16; ++e) { float o = O[0][d][e] * i0 - O[1][d][e] * i1; O[0][d][e] = o; ss += o * o; }
  ss = swapadd(ss);
  const float rstd = __builtin_amdgcn_rsqf(ss * (1.f / 128.f) + EPS) * p.oml[layer];
  const float* sg = p.in[8] + layer * 128;
  u16* dst = outs + (size_t)(q0 + r2) * OUT_LD + head * 128;
#pragma unroll
  for (int d = 0; d < 4; ++d)
#pragma unroll
    for (int g = 0; g < 4; ++g) {
      f32x4 g4 = *(const f32x4*)(sg + d * 32 + 8 * g + 4 * h2);
      u32x2 w = {cvtpk(O[0][d][4 * g] * rstd * g4[0], O[0][d][4 * g + 1] * rstd * g4[1]), cvtpk(O[0][d][4 * g + 2] * rstd * g4[2], O[0][d][4 * g + 3] * rstd * g4[3])};
      *(u32x2*)(dst + d * 32 + 8 * g + 4 * h2) = w;
    }
}

__device__ __forceinline__ void attn_C(const Params& p, int layer, int idx, char* lds) {
  char* const ws = lws(p.ws);
  const int tid = tidx(), lane = tid & 63, wid = wave_id(), r = lane & 31, h = lane >> 5;
  int sh, qb; item_map(idx, 8, sh, qb);
  const int seq = sh >> 3, head = sh & 7;
  const u16* qc = (const u16*)(ws + OFF_QKVC) + (size_t)seq * SEQ * QKVC_LD;
  u16* outs = (u16*)(ws + OFF_OUTS) + (size_t)seq * SEQ * OUT_LD;
  const int q0 = qb * 512 + wid * 64;
  bf16x8 qf[2][6];
  load_qf<6>(qf[0], qc + (size_t)(q0 + r) * QKVC_LD + head * 96 + h * 8);
  load_qf<6>(qf[1], qc + (size_t)(q0 + 32 + r) * QKVC_LD + head * 96 + h * 8);
  f32x16 O[2][2]; float mrun[2] = {-1e29f, -1e29f}, lrun[2] = {0.f, 0.f};
#pragma unroll
  for (int j = 0; j < 2; ++j)
#pragma unroll
    for (int d = 0; d < 2; ++d)
#pragma unroll
      for (int e = 0; e < 16; ++e) O[j][d][e] = 0.f;
  attn_loop<96, 64, 1, false>(O, mrun, lrun, qf, qc + 768 + head * 96, nullptr, QKVC_LD, qc + 1536 + head * 64, QKVC_LD, 0, 64, true, 0, 0, lds);
  const int lane2 = (tidx() & 63), r2 = lane2 & 31, h2 = lane2 >> 5;
#pragma unroll
  for (int j = 0; j < 2; ++j) {
    const float inv = 1.f / swapadd(lrun[j]);
    store_o<2>(O[j], inv, outs + (size_t)(q0 + j * 32 + r2) * OUT_LD + 768 + head * 64, h2);
  }
}

__device__ __forceinline__ void attn_D(const Params& p, int layer, int idx, char* lds) {
  char* const ws = lws(p.ws);
  const int tid = tidx(), lane = tid & 63, wid = wave_id(), r = lane & 31, h = lane >> 5;
  const int xcd = idx & 7, qb = idx >> 3;
  const int seq = xcd >> 1, kvh = xcd & 1;
  const u16* qkv = (const u16*)(ws + OFF_QKV) + (size_t)seq * SEQ * NINP;
  u16* outs = (u16*)(ws + OFF_OUTS) + (size_t)seq * SEQ * OUT_LD;
  const int qhead = kvh * 4 + (wid >> 1);
  const int q0 = qb * 128 + (wid & 1) * 64;
  bf16x8 qf[2][4];
  load_qf<4>(qf[0], qkv + (size_t)(q0 + r) * NINP + 3840 + qhead * 64 + h * 8);
  load_qf<4>(qf[1], qkv + (size_t)(q0 + 32 + r) * NINP + 3840 + qhead * 64 + h * 8);
  f32x16 O[2][2]; float mrun[2] = {-1e29f, -1e29f}, lrun[2] = {0.f, 0.f};
#pragma unroll
  for (int j = 0; j < 2; ++j)
#pragma unroll
    for (int d = 0; d < 2; ++d)
#pragma unroll
      for (int e = 0; e < 16; ++e) O[j][d][e] = 0.f;
  int t0 = qb * 2 - 2; if (t0 < 0) t0 = 0;
  int t1 = qb * 2 + 4; if (t1 > 64) t1 = 64;
  attn_loop<64, 64, 1, true>(O, mrun, lrun, qf, qkv + 4352 + kvh * 64, nullptr, NINP, qkv + 4480 + kvh * 64, NINP, t0, t1, true, q0, 128, lds);
  const float sink2 = p.in[19][layer * 8 + qhead] * LOG2E;
  const int lane2 = (tidx() & 63), r2 = lane2 & 31, h2 = lane2 >> 5;
#pragma unroll
  for (int j = 0; j < 2; ++j) {
    const float l = swapadd(lrun[j]);
    const float mf = fmaxf(mrun[j], sink2);
    const float a = __builtin_amdgcn_exp2f(mrun[j] - mf);
    const float lf = l * a + __builtin_amdgcn_exp2f(sink2 - mf);
    store_o<2>(O[j], a / lf, outs + (size_t)(q0 + j * 32 + r2) * OUT_LD + 1280 + qhead * 64, h2);
  }
}

__device__ __forceinline__ void attn_B(const Params& p, int layer, int idx, char* lds) {
  char* const ws = lws(p.ws);
  const int tid = tidx(), lane = tid & 63, wid = wave_id(), r = lane & 31, h = lane >> 5;
  const int sub = idx & 31, sh = idx >> 5, seq = sh >> 2, head = sh & 3;
  int g, res, m0;
  if (sub < 8) { g = 0; res = 0; m0 = sub * 512; }
  else if (sub < 16) { g = 1; res = (sub - 8) >> 1; m0 = ((sub - 8) & 1) * 512; }
  else { g = 2; res = sub - 16; m0 = 0; }
  const int dil = g == 0 ? 1 : (g == 1 ? 4 : 16);
  const int Lg = SEQ / dil;
  int nact = (Lg - m0) / 64; if (nact > 8) nact = 8;
  const bool wact = wid < nact;
  const size_t ld = (size_t)dil * NINP;
  const u16* base = (const u16*)(ws + OFF_QKV) + ((size_t)seq * SEQ + res) * NINP + 1536 + g * 768 + head * 64;
  int q0 = m0 + wid * 64; if (!wact) q0 = m0;
  bf16x8 qf[2][4];
  load_qf<4>(qf[0], base + (size_t)(q0 + r) * ld + h * 8);
  load_qf<4>(qf[1], base + (size_t)(q0 + 32 + r) * ld + h * 8);
  f32x16 O[2][2]; float mrun[2] = {-1e29f, -1e29f}, lrun[2] = {0.f, 0.f};
#pragma unroll
  for (int j = 0; j < 2; ++j)
#pragma unroll
    for (int d = 0; d < 2; ++d)
#pragma unroll
      for (int e = 0; e < 16; ++e) O[j][d][e] = 0.f;
  int t0 = m0 / 64 - 1; if (t0 < 0) t0 = 0;
  int t1 = m0 / 64 + 9; if (t1 > Lg / 64) t1 = Lg / 64;
  attn_loop<64, 64, 1, true>(O, mrun, lrun, qf, base + 256, nullptr, ld, base + 512, ld, t0, t1, wact, q0, 64, lds);
  if (wact) {
    const int lane2 = (tidx() & 63), r2 = lane2 & 31, h2 = lane2 >> 5;
    u16* bo = (u16*)(ws + OFF_BO) + (size_t)g * CT * 256;
    float* blse = (float*)(ws + OFF_BLSE) + (size_t)g * CT * 4;
#pragma unroll
    for (int j = 0; j < 2; ++j) {
      const float l = swapadd(lrun[j]);
      const size_t tok = (size_t)seq * SEQ + (size_t)(q0 + j * 32 + r2) * dil + res;
      store_o<2>(O[j], 1.f / l, bo + tok * 256 + head * 64, h2);
      if (h2 == 0) blse[tok * 4 + head] = mrun[j] + __builtin_amdgcn_logf(l);
    }
  }
}

DI void combine_rows(char* ws, int m0) {
  const u16* bo = (const u16*)(ws + OFF_BO);
  const float* blse = (const float*)(ws + OFF_BLSE);
  u16* outs = (u16*)(ws + OFF_OUTS);
  for (int i = tidx(); i < 128 * 32; i += 512) {
    const int tok = m0 + (i >> 5), ch = i & 31, head = ch >> 3;
    float l0 = blse[(size_t)tok * 4 + head], l1 = blse[((size_t)CT + tok) * 4 + head], l2 = blse[((size_t)2 * CT + tok) * 4 + head];
    float mx = fmaxf(l0, fmaxf(l1, l2));
    float w0 = __builtin_amdgcn_exp2f(l0 - mx), w1 = __builtin_amdgcn_exp2f(l1 - mx), w2 = __builtin_amdgcn_exp2f(l2 - mx);
    float inv = 1.f / (w0 + w1 + w2); w0 *= inv; w1 *= inv; w2 *= inv;
    u32x4 a = *(const u32x4*)(bo + (size_t)tok * 256 + ch * 8);
    u32x4 b = *(const u32x4*)(bo + ((size_t)CT + tok) * 256 + ch * 8);
    u32x4 c = *(const u32x4*)(bo + ((size_t)2 * CT + tok) * 256 + ch * 8);
    u32x4 o;
#pragma unroll
    for (int e = 0; e < 4; ++e) {
      float lo = w0 * bflo(a[e]) + w1 * bflo(b[e]) + w2 * bflo(c[e]);
      float hi = w0 * bfhi(a[e]) + w1 * bfhi(b[e]) + w2 * bfhi(c[e]);
      o[e] = cvtpk(lo, hi);
    }
    *(u32x4*)(outs + (size_t)tok * OUT_LD + 512 + ch * 8) = o;
  }
  asm volatile("s_waitcnt vmcnt(0)" ::: "memory");
}

__device__ __forceinline__ void phase_merge(const Params& p, int layer, char* lds) {
  char* const ws = lws(p.ws);
  const u16* Wbr = (const u16*)(ws + OFF_WBR) + (size_t)layer * 1024 * 1792;
  const u16* Wg = (const u16*)(ws + OFF_WGATE) + (size_t)layer * 4096 * 1024;
  const u16* xn = (const u16*)(ws + OFF_XN);
  const u16* outs = (const u16*)(ws + OFF_OUTS);
  u16* merged = (u16*)(ws + OFF_MERGED);
  const int wid = wave_id(), wn = wid & 3, wm = wid >> 2;
  for (int t = blockIdx.x; t < 4 * 128; t += gridDim.x) {
    int nt, mt; tile_map(t, nt, mt);
    const int n0 = nt * 256, m0 = mt * 128;
    combine_rows(ws, m0);
    f32x16 mg[2][2];
#pragma unroll
    for (int i = 0; i < 2; ++i)
#pragma unroll
      for (int j = 0; j < 2; ++j)
#pragma unroll
        for (int e = 0; e < 16; ++e) mg[i][j][e] = 0.f;
#pragma nounroll
    for (int br = 0; br < 4; ++br) {
      const int Kb = br == 1 ? 256 : 512;
      const int cofs = br == 0 ? 0 : (br == 1 ? 512 : (br == 2 ? 768 : 1280));
      f32x16 acc[2][2];
      gemm_core<2, 2, false>(acc, Wbr + (size_t)1024 * cofs + (size_t)n0 * Kb, Kb, outs + (size_t)m0 * OUT_LD + cofs, OUT_LD, Kb, lds);
      const int lane_ = tidx() & 63, r_ = lane_ & 31, h_ = lane_ >> 5;
      const unsigned char* gb = (const unsigned char*)lws(ws + OFF_GATE) + br * 1024 + n0 + wn * 64 + 4 * h_;
#pragma unroll
      for (int j = 0; j < 2; ++j) {
        const unsigned char* gr = gb + (size_t)(m0 + wm * 64 + j * 32 + r_) * 4096;
#pragma unroll
        for (int i = 0; i < 2; ++i)
#pragma unroll
          for (int g = 0; g < 4; ++g) {
            const unsigned gw = *(const unsigned*)(gr + i * 32 + 8 * g);
#pragma unroll
            for (int e = 0; e < 4; ++e) mg[i][j][4 * g + e] += (float)((gw >> (8 * e)) & 255u) * (1.f / 255.f) * acc[i][j][4 * g + e];
          }
      }
    }
    store_wave_bf16<2>(mg, merged + (size_t)(m0 + wm * 64) * 1024 + n0 + wn * 64, 1024, lds + wid * WAVE_LDS);
  }
}

__device__ __forceinline__ void phase_proj_res(const u16* Wt, const u16* act, int K, const float* resid, float* xout, char* lds) {
  pg8::Gemm g{act, Wt, CT, DM, K};
  pg8::StaticOrder S; S.init(CT, DM, gridDim.x, blockIdx.x);
  EpiRes E{resid, xout};
  __syncthreads();
  pg8::gemm_phase<EpiRes, pg8::StaticOrder, false>((PG8_LAS unsigned char*)lds, g, S, E, nullptr);
}

__device__ __forceinline__ void phase_ffn_up(const Params& p, int layer, char* lds) {
  char* const ws = lws(p.ws);
  pg8::Gemm g{(const u16*)(ws + OFF_XN), (const u16*)(ws + OFF_WGU) + (size_t)layer * NGU * 1024, CT, NGU, 1024};
  pg8::StaticOrder S; S.init(CT, NGU, gridDim.x, blockIdx.x);
  EpiSwiglu E{(u16*)(ws + OFF_ACT)};
  __syncthreads();
  pg8::gemm_phase<EpiSwiglu, pg8::StaticOrder, false>((PG8_LAS unsigned char*)lds, g, S, E, nullptr);
}

#define XB_TMO      128
#define XB_XCNT(j)  (256  + 64 * (j))
#define XB_XSUB(j)  (1280 + 64 * (j))
#define XB_XGEN(j)  (2304 + 64 * (j))
#define XB_TOP      3328
#define XB_TOPGEN   3392
#define XCD_BAR_WORDS 3456
#define XB_SPIN_CAP (1u << 20)
#define XB_LAS __attribute__((address_space(3)))
DI unsigned xb_ld(unsigned* p) { return __hip_atomic_load(p, __ATOMIC_RELAXED, __HIP_MEMORY_SCOPE_AGENT); }
DI unsigned xb_add(unsigned* p, unsigned v) { return __hip_atomic_fetch_add(p, v, __ATOMIC_RELAXED, __HIP_MEMORY_SCOPE_AGENT); }
DI unsigned xb_xcc_id() { return (unsigned)__builtin_amdgcn_s_getreg((3 << 11) | 20) & 0xFu; }
#define XB_SPIN(cond, bar) do { unsigned _sp = 0; while (cond) { __builtin_amdgcn_s_sleep(1); \
    if ((++_sp & 255u) == 0u) { if (xb_ld(&(bar)[XB_TMO])) break; if (_sp > XB_SPIN_CAP) { atomicAdd(&(bar)[XB_TMO], 1u); break; } } } } while (0)
struct XcdBarrier { unsigned* bar; unsigned x; volatile XB_LAS unsigned* st; };
DI XcdBarrier xcd_barrier_post(unsigned* bar, volatile XB_LAS unsigned* st) {
  XcdBarrier b; b.bar = bar; b.x = xb_xcc_id(); b.st = st;
  if (tidx() == 0) (void)xb_add(&bar[XB_XCNT(b.x)], 1u);
  return b;
}
DI void xcd_barrier_complete(unsigned* bar, unsigned x, unsigned& nloc, unsigned& nx) {
  const unsigned G = gridDim.x;
  unsigned sum, cnt, mine, sp = 0u;
  for (;;) {
    sum = 0u; cnt = 0u; mine = 0u;
#pragma unroll
    for (unsigned j = 0; j < 16; ++j) { const unsigned c = xb_ld(&bar[XB_XCNT(j)]); sum += c; cnt += (c > 0u) ? 1u : 0u; mine = (j == x) ? c : mine; }
    if (sum == G) break;
    __builtin_amdgcn_s_sleep(1);
    if ((++sp & 255u) == 0u) { if (xb_ld(&bar[XB_TMO])) break; if (sp > XB_SPIN_CAP) { atomicAdd(&bar[XB_TMO], 1u); break; } }
  }
  nloc = mine > 0u ? mine : 1u; nx = cnt > 0u ? cnt : 1u;
}
DI void xcd_barrier(const XcdBarrier& b) {
  asm volatile("s_waitcnt vmcnt(0)" ::: "memory");
  __syncthreads();
  if (tidx() == 0) {
    unsigned* bar = b.bar;
    __builtin_amdgcn_s_waitcnt(0);
    unsigned nloc = b.st[0], nx = b.st[1];
    if (nloc == 0u) { xcd_barrier_complete(bar, b.x, nloc, nx); b.st[0] = nloc; b.st[1] = nx; }
    const unsigned old = xb_add(&bar[XB_XSUB(b.x)], 1u);
    const unsigned gen = old / nloc;
    if (old + 1u == (gen + 1u) * nloc) {
      __builtin_amdgcn_fence(__ATOMIC_RELEASE, "agent");
      asm volatile("s_waitcnt vmcnt(0)" ::: "memory");
      const unsigned og = xb_add(&bar[XB_TOP], 1u);
      const unsigned tg = og / nx;
      if (og + 1u == (tg + 1u) * nx) xb_add(&bar[XB_TOPGEN], 1u);
      else XB_SPIN(xb_ld(&bar[XB_TOPGEN]) == tg, bar);
      __builtin_amdgcn_fence(__ATOMIC_ACQUIRE, "agent");
      xb_add(&bar[XB_XGEN(b.x)], 1u);
      asm volatile("s_waitcnt vmcnt(0)" ::: "memory");
    } else {
      XB_SPIN(xb_ld(&bar[XB_XGEN(b.x)]) == gen, bar);
      __builtin_amdgcn_fence(__ATOMIC_ACQUIRE, "agent");
      asm volatile("s_waitcnt vmcnt(0)" ::: "memory");
    }
  }
  __syncthreads();
}

DI void grid_barrier(unsigned* ctr, unsigned target) {
  asm volatile("s_waitcnt vmcnt(0)" ::: "memory");
  __syncthreads();
  if (threadIdx.x == 0) {
    __builtin_amdgcn_fence(__ATOMIC_RELEASE, "agent");
    asm volatile("s_waitcnt vmcnt(0)" ::: "memory");
    __hip_atomic_fetch_add(ctr, 1u, __ATOMIC_RELAXED, __HIP_MEMORY_SCOPE_AGENT);
    unsigned spins = 0;
    while (__hip_atomic_load(ctr, __ATOMIC_RELAXED, __HIP_MEMORY_SCOPE_AGENT) < target && ++spins < (1u << 26)) __builtin_amdgcn_s_sleep(2);
    __builtin_amdgcn_fence(__ATOMIC_ACQUIRE, "agent");
    asm volatile("s_waitcnt vmcnt(0)" ::: "memory");
  }
  __syncthreads();
}

extern "C" __global__ void __launch_bounds__(512, 2) mega(Params p) {
  extern __shared__ __attribute__((aligned(16))) char lds[];
  cg::grid_group grid = cg::this_grid();
  unsigned* const barp = (unsigned*)(p.ws + OFF_BAR);
  unsigned nbar = 0;
#define PWS lws(p.ws)
#define POUT ((float*)lws((char*)p.out))
  volatile XB_LAS unsigned* xst = (volatile XB_LAS unsigned*)(lds + (LDS_BYTES - 16));
  if (tidx() == 0) { xst[0] = 0u; xst[1] = 0u; }
  phase_w(p, lds);
  grid.sync();
  const XcdBarrier xb = xcd_barrier_post(barp, xst);
#pragma nounroll
  for (int ch = 0; ch < NCH; ++ch) {
#pragma nounroll
    for (int layer = 0; layer < DEPTH; ++layer) {
      {
        const float* xin = ch == 0 ? p.in[0] : p.in[1] + (size_t)(ch - 1) * CT * DM;
        const float* xcur = layer == 0 ? xin : POUT + (size_t)ch * CT * DM;
        phase_norm(xcur, p.in[2] + layer * DM, (u16*)(PWS + OFF_XN));
      }
      xcd_barrier(xb);
      phase_p1(p, layer, lds);
      xcd_barrier(xb);
      phase_p1c(p, layer, lds);
      xcd_barrier(xb);
#pragma nounroll
      for (int it = blockIdx.x; it < 1280; it += gridDim.x) {
        if (it < 256) attn_A(p, layer, it, lds);
        else if (it < 512) attn_C(p, layer, it - 256, lds);
        else if (it < 768) attn_D(p, layer, it - 512, lds);
        else attn_B(p, layer, it - 768, lds);
      }
      xcd_barrier(xb);
      phase_merge(p, layer, lds);
      xcd_barrier(xb);
      {
        const float* xin = ch == 0 ? p.in[0] : p.in[1] + (size_t)(ch - 1) * CT * DM;
        float* xo = POUT + (size_t)ch * CT * DM;
        const float* xcur = layer == 0 ? xin : xo;
        phase_proj_res((const u16*)(PWS + OFF_WO) + (size_t)layer * 1024 * 1024, (const u16*)(PWS + OFF_MERGED), 1024, xcur, xo, lds);
      }
      xcd_barrier(xb);
      {
        phase_norm(POUT + (size_t)ch * CT * DM, p.in[25] + layer * DM, (u16*)(PWS + OFF_XN));
      }
      xcd_barrier(xb);
      phase_ffn_up(p, layer, lds);
      xcd_barrier(xb);
      {
        float* xo = POUT + (size_t)ch * CT * DM;
        phase_proj_res((const u16*)(PWS + OFF_WDN) + (size_t)layer * 1024 * DFF, (const u16*)(PWS + OFF_ACT), DFF, xo, xo, lds);
      }
      xcd_barrier(xb);
    }
  }
}

extern "C" void kernel_launch(void* const* d_in, const int* in_sizes, int n_in, void* d_out, int out_size, void* d_ws, size_t ws_size, hipStream_t stream) {
  static int grid_blocks = 0;
  if (!grid_blocks) {
    int dev = 0, cus = 0, per_cu = 0;
    (void)hipGetDevice(&dev);
    (void)hipDeviceGetAttribute(&cus, hipDeviceAttributeMultiprocessorCount, dev);
    (void)hipFuncSetAttribute((const void*)mega, hipFuncAttributeMaxDynamicSharedMemorySize, (int)LDS_BYTES);
    (void)hipOccupancyMaxActiveBlocksPerMultiprocessor(&per_cu, mega, 512, LDS_BYTES);
    if (per_cu < 1) fprintf(stderr, "kernel_launch: occupancy query returned %d\n", per_cu);
    grid_blocks = cus > 0 ? cus : 256;
    if (ws_size < WS_END) fprintf(stderr, "kernel_launch: workspace too small: %zu < %zu\n", ws_size, (size_t)WS_END);
  }
  Params p{};
  for (int i = 0; i < 29; ++i) p.in[i] = (const float*)d_in[i];
  p.out = (float*)d_out;
  p.ws = (char*)d_ws;
  for (int i = 0; i < 32; ++i) p.inv64[i] = (float)pow(10000.0, -(double)i / 32.0);
  for (int i = 0; i < 16; ++i) p.inv32[i] = (float)pow(10000.0, -(double)i / 16.0);
  for (int l = 0; l < 2; ++l) {
    double li = 0.8 - 0.6 * exp(-0.3 * (double)l);
    p.lam_init[l] = (float)li;
    p.oml[l] = (float)(1.0 - li);
  }
  void* args[] = {&p};
  hipError_t e = hipLaunchCooperativeKernel((void*)mega, dim3(grid_blocks), dim3(512), args, LDS_BYTES, stream);
  if (e != hipSuccess) fprintf(stderr, "cooperative launch failed: %s (grid %d)\n", hipGetErrorString(e), grid_blocks);
}
```

```cpp
#include <hip/hip_runtime.h>
#include <hip/hip_cooperative_groups.h>
#include <cstdio>
#include <cmath>
namespace cg = cooperative_groups;

typedef unsigned short u16;
typedef short bf16x8 __attribute__((ext_vector_type(8)));
typedef short s16x4 __attribute__((ext_vector_type(4)));
typedef float f32x16 __attribute__((ext_vector_type(16)));
typedef float f32x4 __attribute__((ext_vector_type(4)));
typedef float f32x2 __attribute__((ext_vector_type(2)));
typedef unsigned u32x4 __attribute__((ext_vector_type(4)));
typedef unsigned u32x2 __attribute__((ext_vector_type(2)));
typedef __bf16 bf16x2_t __attribute__((ext_vector_type(2)));

#define DI __device__ __forceinline__
#define MFMA(a, b, c) __builtin_amdgcn_mfma_f32_32x32x16_bf16(a, b, c, 0, 0, 0)

constexpr int DM = 1024, SEQ = 4096, CT = 16384, NCH = 3, NINP = 5120, DFF = 2816, NGU = 5632, NIN2 = 9216;
constexpr int QKVC_LD = 2048, OUT_LD = 1792, DEPTH = 2;
constexpr float LOG2E = 1.4426950408889634f;
constexpr float QS64 = 0.125f * LOG2E, QS96 = 0.10206207261596575f * LOG2E;
constexpr float EPS = 1e-6f;
constexpr int PITCH = 144;
constexpr int WAVE_LDS = 17408;
constexpr size_t LDS_BYTES = 155648;

constexpr size_t al256(size_t x) { return (x + 255) / 256 * 256; }
constexpr size_t OFF_WIN = 0;
constexpr size_t OFF_WGATE = OFF_WIN + al256((size_t)DEPTH * NIN2 * 1024 * 2);
constexpr size_t OFF_WUQ = OFF_WGATE + 256;
constexpr size_t OFF_WUKV = OFF_WUQ + al256((size_t)DEPTH * 768 * 256 * 2);
constexpr size_t OFF_WBR = OFF_WUKV + al256((size_t)DEPTH * 1024 * 128 * 2);
constexpr size_t OFF_WO = OFF_WBR + al256((size_t)DEPTH * 1024 * 1792 * 2);
constexpr size_t OFF_WGU = OFF_WO + al256((size_t)DEPTH * 1024 * 1024 * 2);
constexpr size_t OFF_WDN = OFF_WGU + al256((size_t)DEPTH * NGU * 1024 * 2);
constexpr size_t OFF_COS64 = OFF_WDN + al256((size_t)DEPTH * 1024 * DFF * 2);
constexpr size_t OFF_SIN64 = OFF_COS64 + (size_t)SEQ * 32 * 4;
constexpr size_t OFF_COS32 = OFF_SIN64 + (size_t)SEQ * 32 * 4;
constexpr size_t OFF_SIN32 = OFF_COS32 + (size_t)SEQ * 16 * 4;
constexpr size_t OFF_LAM = OFF_SIN32 + (size_t)SEQ * 16 * 4;
constexpr size_t OFF_BAR = OFF_LAM + 256;
constexpr size_t OFF_XN = OFF_BAR + 16384;
constexpr size_t OFF_QKV = OFF_XN + (size_t)CT * 1024 * 2;
constexpr size_t OFF_QKVC = OFF_QKV + (size_t)CT * NINP * 2;
constexpr size_t OFF_OUTS = OFF_QKVC + (size_t)CT * QKVC_LD * 2;
constexpr size_t OFF_BO = OFF_OUTS + (size_t)CT * OUT_LD * 2;
constexpr size_t OFF_BLSE = OFF_BO + (size_t)3 * CT * 256 * 2;
constexpr size_t OFF_GATE = OFF_BLSE + (size_t)3 * CT * 4 * 4;
constexpr size_t WS_END = OFF_GATE + (size_t)CT * 4096;
constexpr size_t OFF_MERGED = OFF_QKV;
constexpr size_t OFF_ACT = OFF_QKV + (size_t)CT * 1024 * 2;

struct Params {
  const float* in[29];
  float* out;
  char* ws;
  float inv64[32];
  float inv32[16];
  float lam_init[2];
  float oml[2];
  int pad[2];
};

DI int crow(int reg, int h) { return (reg & 3) + 8 * (reg >> 2) + 4 * h; }
DI unsigned cvtpk(float lo, float hi) {
  f32x2 f = {lo, hi};
  bf16x2_t b = __builtin_convertvector(f, bf16x2_t);
  return __builtin_bit_cast(unsigned, b);
}
DI float bflo(unsigned u) { return __uint_as_float(u << 16); }
DI float bfhi(unsigned u) { return __uint_as_float(u & 0xffff0000u); }
DI float swapadd(float x) {
  auto rr = __builtin_amdgcn_permlane32_swap(__float_as_uint(x), __float_as_uint(x), false, false);
  return __uint_as_float(rr[0]) + __uint_as_float(rr[1]);
}
DI float swapmax(float x) {
  auto rr = __builtin_amdgcn_permlane32_swap(__float_as_uint(x), __float_as_uint(x), false, false);
  return fmaxf(__uint_as_float(rr[0]), __uint_as_float(rr[1]));
}
DI int opaque(int x) { asm volatile("" : "+v"(x)); return x; }
DI int tidx() { return opaque((int)threadIdx.x); }
DI int wave_id() { return __builtin_amdgcn_readfirstlane(tidx() >> 6); }
DI char* lws(char* w) { asm volatile("" : "+s"(w)); return w; }
DI void lds_fence() { asm volatile("s_waitcnt lgkmcnt(0)" ::: "memory"); }
DI void tile_map(int t, int& nt, int& mt) {
  int round = t >> 8, b = t & 255, xcd = b & 7, slot = b >> 3;
  nt = round * 2 + (slot & 1);
  mt = xcd * 16 + (slot >> 1);
}

template <int NB, int AN = NB, bool LOWREG = false>
DI void gemm_core(f32x16 (&acc)[AN][2], const u16* __restrict__ Ag, int lda, const u16* __restrict__ Bg, int ldb, int K, char* lds) {
  constexpr int AR = 128 * NB;
  constexpr int ACH = AR * 8 / 512;
  constexpr int STAGE = (AR + 128) * PITCH;
  const int tid = tidx(), lane = tid & 63, wid = wave_id(), r = lane & 31, h = lane >> 5;
  const int wn = wid & 3, wm = wid >> 2;
  const int crow0 = tid >> 3, ccol = tid & 7;
  const __amdgpu_buffer_rsrc_t arsrc = __builtin_amdgcn_make_buffer_rsrc((void*)Ag, 0, 0x7fffffff, 0x00020000);
  const __amdgpu_buffer_rsrc_t brsrc = __builtin_amdgcn_make_buffer_rsrc((void*)Bg, 0, 0x7fffffff, 0x00020000);
  const int avo = (crow0 * lda + ccol * 8) * 2, bvo = (crow0 * ldb + ccol * 8) * 2;
  const int astep = 64 * lda * 2, bstep = 64 * ldb * 2;
  const int wofs = crow0 * PITCH + ccol * 16;
  const int aoff = (wn * 32 * NB + r) * PITCH + h * 16;
  const int boff = AR * PITCH + (wm * 64 + r) * PITCH + h * 16;
  const int nk = K >> 6;
  u32x4 ra[ACH], rb[2];
#pragma unroll
  for (int i = 0; i < NB; ++i)
#pragma unroll
    for (int j = 0; j < 2; ++j)
#pragma unroll
      for (int e = 0; e < 16; ++e) acc[i][j][e] = 0.f;
  __syncthreads();
#pragma unroll
  for (int i = 0; i < ACH; ++i) ra[i] = __builtin_amdgcn_raw_buffer_load_b128(arsrc, avo + i * astep, 0, 0);
#pragma unroll
  for (int i = 0; i < 2; ++i) rb[i] = __builtin_amdgcn_raw_buffer_load_b128(brsrc, bvo + i * bstep, 0, 0);
#pragma unroll
  for (int i = 0; i < ACH; ++i) *(u32x4*)(lds + wofs + i * 64 * PITCH) = ra[i];
#pragma unroll
  for (int i = 0; i < 2; ++i) *(u32x4*)(lds + AR * PITCH + wofs + i * 64 * PITCH) = rb[i];
  __syncthreads();
#pragma nounroll
  for (int kt = 0; kt < nk; ++kt) {
    const bool more = kt + 1 < nk;
    if (more) {
#pragma unroll
      for (int i = 0; i < ACH; ++i) ra[i] = __builtin_amdgcn_raw_buffer_load_b128(arsrc, avo + i * astep, (kt + 1) * 128, 0);
#pragma unroll
      for (int i = 0; i < 2; ++i) rb[i] = __builtin_amdgcn_raw_buffer_load_b128(brsrc, bvo + i * bstep, (kt + 1) * 128, 0);
    }
    const char* base = lds + (kt & 1) * STAGE;
    if (LOWREG) {
#pragma unroll
      for (int s = 0; s < 4; ++s) {
        bf16x8 af[NB], bfr[2];
#pragma unroll
        for (int i = 0; i < NB; ++i) af[i] = *(const bf16x8*)(base + aoff + i * 32 * PITCH + s * 32);
#pragma unroll
        for (int j = 0; j < 2; ++j) bfr[j] = *(const bf16x8*)(base + boff + j * 32 * PITCH + s * 32);
#pragma unroll
        for (int i = 0; i < NB; ++i)
#pragma unroll
          for (int j = 0; j < 2; ++j) acc[i][j] = MFMA(af[i], bfr[j], acc[i][j]);
      }
    } else {
    bf16x8 afA[NB], bfA[2], afB[NB], bfB[2];
#pragma unroll
    for (int i = 0; i < NB; ++i) afA[i] = *(const bf16x8*)(base + aoff + i * 32 * PITCH);
#pragma unroll
    for (int j = 0; j < 2; ++j) bfA[j] = *(const bf16x8*)(base + boff + j * 32 * PITCH);
    __builtin_amdgcn_sched_barrier(0);
#pragma unroll
    for (int s = 0; s < 4; s += 2) {
#pragma unroll
      for (int i = 0; i < NB; ++i) afB[i] = *(const bf16x8*)(base + aoff + i * 32 * PITCH + (s + 1) * 32);
#pragma unroll
      for (int j = 0; j < 2; ++j) bfB[j] = *(const bf16x8*)(base + boff + j * 32 * PITCH + (s + 1) * 32);
      __builtin_amdgcn_sched_barrier(0);
#pragma unroll
      for (int i = 0; i < NB; ++i)
#pragma unroll
        for (int j = 0; j < 2; ++j) acc[i][j] = MFMA(afA[i], bfA[j], acc[i][j]);
      __builtin_amdgcn_sched_barrier(0);
      if (s + 2 < 4) {
#pragma unroll
        for (int i = 0; i < NB; ++i) afA[i] = *(const bf16x8*)(base + aoff + i * 32 * PITCH + (s + 2) * 32);
#pragma unroll
        for (int j = 0; j < 2; ++j) bfA[j] = *(const bf16x8*)(base + boff + j * 32 * PITCH + (s + 2) * 32);
      }
      __builtin_amdgcn_sched_barrier(0);
#pragma unroll
      for (int i = 0; i < NB; ++i)
#pragma unroll
        for (int j = 0; j < 2; ++j) acc[i][j] = MFMA(afB[i], bfB[j], acc[i][j]);
      __builtin_amdgcn_sched_barrier(0);
    }
    }
    if (more) {
      char* nb = lds + ((kt + 1) & 1) * STAGE;
#pragma unroll
      for (int i = 0; i < ACH; ++i) *(u32x4*)(nb + wofs + i * 64 * PITCH) = ra[i];
#pragma unroll
      for (int i = 0; i < 2; ++i) *(u32x4*)(nb + AR * PITCH + wofs + i * 64 * PITCH) = rb[i];
    }
    __syncthreads();
  }
}

template <int NB, int AN = NB>
DI void store_wave_bf16(const f32x16 (&v)[AN][2], u16* __restrict__ wdst, int ldd, char* wl) {
  constexpr int TP = NB * 64 + 16;
  const int lane = (tidx() & 63), r = lane & 31, h = lane >> 5;
#pragma unroll
  for (int i = 0; i < NB; ++i)
#pragma unroll
    for (int j = 0; j < 2; ++j)
#pragma unroll
      for (int g = 0; g < 4; ++g) {
        u32x2 w = {cvtpk(v[i][j][4 * g], v[i][j][4 * g + 1]), cvtpk(v[i][j][4 * g + 2], v[i][j][4 * g + 3])};
        *(u32x2*)(wl + (j * 32 + r) * TP + (i * 32 + 8 * g + 4 * h) * 2) = w;
      }
  lds_fence();
  constexpr int CPR = NB * 4;
#pragma unroll
  for (int it = 0; it < CPR; ++it) {
    int c = lane + 64 * it, row = c / CPR, ch = c % CPR;
    u32x4 d = *(const u32x4*)(wl + row * TP + ch * 16);
    *(u32x4*)(wdst + (size_t)row * ldd + ch * 8) = d;
  }
  lds_fence();
}

DI void store_wave_f32_res(const f32x16 (&v)[2][2], const float* __restrict__ res, float* __restrict__ wdst, char* wl) {
  constexpr int TP = 272;
  const int lane = (tidx() & 63), r = lane & 31, h = lane >> 5;
#pragma unroll
  for (int i = 0; i < 2; ++i)
#pragma unroll
    for (int j = 0; j < 2; ++j)
#pragma unroll
      for (int g = 0; g < 4; ++g) {
        f32x4 w = {v[i][j][4 * g], v[i][j][4 * g + 1], v[i][j][4 * g + 2], v[i][j][4 * g + 3]};
        *(f32x4*)(wl + (j * 32 + r) * TP + (i * 32 + 8 * g + 4 * h) * 4) = w;
      }
  lds_fence();
#pragma unroll
  for (int it = 0; it < 16; ++it) {
    int c = lane + 64 * it, row = c >> 4, ch = c & 15;
    f32x4 d = *(const f32x4*)(wl + row * TP + ch * 16);
    f32x4 x = *(const f32x4*)(res + (size_t)row * DM + ch * 4);
    d += x;
    *(f32x4*)(wdst + (size_t)row * DM + ch * 4) = d;
  }
  lds_fence();
}

DI void norm_rope64(f32x16 (&v)[2][2], const float* __restrict__ gain, float scale, int pos0, const float* __restrict__ cs, const float* __restrict__ sn) {
  const int lane = (tidx() & 63), r = lane & 31, h = lane >> 5;
#pragma unroll
  for (int j = 0; j < 2; ++j) {
    float ss = 0.f;
#pragma unroll
    for (int e = 0; e < 16; ++e) ss += v[0][j][e] * v[0][j][e] + v[1][j][e] * v[1][j][e];
    ss = swapadd(ss);
    const float rstd = __builtin_amdgcn_rsqf(ss * (1.f / 64.f) + EPS);
    const int pos = pos0 + j * 32 + r;
#pragma unroll
    for (int g = 0; g < 4; ++g) {
      const int d = 8 * g + 4 * h;
      f32x4 c4 = *(const f32x4*)(cs + pos * 32 + d), s4 = *(const f32x4*)(sn + pos * 32 + d);
      f32x4 g1 = *(const f32x4*)(gain + d), g2 = *(const f32x4*)(gain + 32 + d);
#pragma unroll
      for (int e = 0; e < 4; ++e) {
        float x1 = v[0][j][4 * g + e] * rstd * g1[e], x2 = v[1][j][4 * g + e] * rstd * g2[e];
        v[0][j][4 * g + e] = (x1 * c4[e] - x2 * s4[e]) * scale;
        v[1][j][4 * g + e] = (x2 * c4[e] + x1 * s4[e]) * scale;
      }
    }
  }
}

DI void norm96_rope_store(f32x16 (&v)[3][2], const float* __restrict__ gain, float scale, int pos0, const float* __restrict__ cs, const float* __restrict__ sn,
                          u16* __restrict__ wdst, char* wl) {
  const int lane = (tidx() & 63), r = lane & 31, h = lane >> 5;
#pragma unroll
  for (int j = 0; j < 2; ++j) {
    float ss = 0.f;
#pragma unroll
    for (int i = 0; i < 3; ++i)
#pragma unroll
      for (int e = 0; e < 16; ++e) ss += v[i][j][e] * v[i][j][e];
    ss = swapadd(ss);
    const float rstd = __builtin_amdgcn_rsqf(ss * (1.f / 96.f) + EPS);
    const int pos = pos0 + j * 32 + r;
#pragma unroll
    for (int i = 0; i < 3; ++i)
#pragma unroll
      for (int g = 0; g < 4; ++g) {
        f32x4 g4 = *(const f32x4*)(gain + i * 32 + 8 * g + 4 * h);
#pragma unroll
        for (int e = 0; e < 4; ++e) v[i][j][4 * g + e] *= rstd * g4[e];
      }
#pragma unroll
    for (int g = 0; g < 2; ++g) {
      f32x4 c4 = *(const f32x4*)(cs + pos * 16 + 8 * g + 4 * h), s4 = *(const f32x4*)(sn + pos * 16 + 8 * g + 4 * h);
#pragma unroll
      for (int e = 0; e < 4; ++e) {
        float a = v[2][j][4 * g + e], b = v[2][j][4 * g + e + 8];
        v[2][j][4 * g + e] = a * c4[e] - b * s4[e];
        v[2][j][4 * g + e + 8] = b * c4[e] + a * s4[e];
      }
    }
#pragma unroll
    for (int i = 0; i < 3; ++i)
#pragma unroll
      for (int e = 0; e < 16; ++e) v[i][j][e] *= scale;
  }
  store_wave_bf16<3>(v, wdst, QKVC_LD, wl);
}

DI float row_ssq(const u16* __restrict__ p, int nchunk) {
  float ss = 0.f;
#pragma unroll 2
  for (int c = 0; c < nchunk; ++c) {
    u32x4 d = *(const u32x4*)(p + c * 8);
    unsigned w[4] = {d[0], d[1], d[2], d[3]};
#pragma unroll
    for (int e = 0; e < 4; ++e) { float a = bflo(w[e]), b = bfhi(w[e]); ss += a * a + b * b; }
  }
  return ss;
}

namespace pg8 {
#define PG8_LAS __attribute__((address_space(3)))
typedef unsigned short bf16_t;
typedef short bf16x8 __attribute__((ext_vector_type(8)));
typedef float f32x4 __attribute__((ext_vector_type(4)));
typedef unsigned u32x4 __attribute__((ext_vector_type(4)));
constexpr int BM = 256, BK = 64, HALF = 128, HTB = HALF * BK * 2  , STAGE_BYTES = 8 * HTB, NXCD = 8, WGM = 8;

__host__ __device__ __forceinline__ int lds_byte(int r, int c) { const int st = (r >> 4) * 2 + (c >> 5), rr = r & 15, cc = c & 31, ob = rr * 64 + cc * 2; return st * 1024 + (ob ^ (((ob >> 9) & 1) << 5)); }
__host__ __device__ __forceinline__ void stage_rc(int b, int& R, int& C) { const int st = b / 1024, sb = b % 1024, swz = sb ^ (((sb >> 9) & 1) << 5); R = (st >> 1) * 16 + swz / 64; C = (st & 1) * 32 + (swz % 64) / 2; }
__host__ __device__ __forceinline__ int perm32(int rho) { const int n = rho >> 4, i = rho & 15; return 8 * (i >> 2) + 4 * n + (i & 3); }

struct Unit { int pm, pn; };
struct Gemm { const bf16_t* A; const bf16_t* Bt; int M, N, K; };
struct StaticOrder {
    int nM, nN, nwg, G, c;
    __host__ __device__ void init(int M, int N, int G_, int c_) { nM = M / BM; nN = N / BM; nwg = nM * nN; G = G_; c = c_; }
    __host__ __device__ bool next(int i, Unit& u) const {
        const long L = (long)i * G + c; if (L >= nwg) return false;
        int wgid = (int)L; { const int q = nwg / NXCD, r = nwg % NXCD, xcd = wgid % NXCD, off = wgid / NXCD; wgid = (xcd < r ? xcd * (q + 1) : r * (q + 1) + (xcd - r) * q) + off; }
        const int nig = WGM * nN, gid = wgid / nig, fm = gid * WGM, gsz = (nM - fm) < WGM ? (nM - fm) : WGM;
        u.pm = fm + ((wgid % nig) % gsz); u.pn = (wgid % nig) / gsz; return true;
    }
    __device__ __forceinline__ void a_ready(const Unit&) const {}
    __device__ __forceinline__ void done(const Unit&) const {}
};
template <class Epi, class Sched, bool STAMP = false>
__device__ __forceinline__ void gemm_phase(PG8_LAS unsigned char* lds, const Gemm g, const Sched& S, const Epi& E, unsigned long long* stamps) {
    const int tid = tidx(), wid = __builtin_amdgcn_readfirstlane(tid >> 6), lane = tid & 63, wr = wid >> 2, wc = wid & 3, fr = lane & 15, fq = lane >> 4;
    const int K = g.K, nt = K / BK;
    int ts_lo = 0, ts_hi = 0, nts = 0; const unsigned long long rt_entry = STAMP ? (unsigned long long)wall_clock64() : 0ull;
#define PG8_STAMP() do { if (STAMP && wid == 0 && nts < 64) { const unsigned long long _c = (unsigned long long)clock64(); \
        ts_lo = (lane == nts) ? (int)(unsigned)_c : ts_lo; ts_hi = (lane == nts) ? (int)(unsigned)(_c >> 32) : ts_hi; ++nts; } } while (0)
    PG8_STAMP();
    unsigned voffA[2], voffB[2];
#pragma unroll
    for (int i = 0; i < 2; ++i) { int R, C; stage_rc(tid * 16 + i * 8192, R, C); const int Rb = Epi::PERM ? ((R & ~31) + perm32(R & 31)) : R;
        voffA[i] = (unsigned)(R * K + C) * 2u; voffB[i] = (unsigned)(Rb * K + C) * 2u; }
    const size_t kstep = (size_t)(BK * 2);
    const size_t hstep = (size_t)HALF * K * 2;
    const size_t tstep = 2 * hstep;
    const unsigned ldsw = (unsigned)wid * 1024u;
    const int aoff = lds_byte(wr * 64 + fr, fq * 8), boff = lds_byte(wc * 32 + fr, fq * 8);
#define PG8_SA(b, h) (((b) * 2 + (h)) * HTB)
#define PG8_SB(b, h) ((4 + (b) * 2 + (h)) * HTB)
#define PG8_STAGE(bufoff, gbase, voff) do { _Pragma("unroll") for (int _i = 0; _i < 2; ++_i) \
        __builtin_amdgcn_global_load_lds((const unsigned*)((const char*)(gbase) + (voff)[_i]), (PG8_LAS unsigned*)(lds + (bufoff) + ldsw + _i * 8192), 16, 0, 0); } while (0)
#define PG8_LDA(dst, b, h) do { _Pragma("unroll") for (int m = 0; m < 4; ++m) _Pragma("unroll") for (int k = 0; k < 2; ++k) dst[m][k] = *(const PG8_LAS bf16x8*)(lds + PG8_SA(b, h) + aoff + m * 2048 + k * 1024); } while (0)
#define PG8_LDB(dst, b, h) do { _Pragma("unroll") for (int n = 0; n < 2; ++n) _Pragma("unroll") for (int k = 0; k < 2; ++k) dst[n][k] = *(const PG8_LAS bf16x8*)(lds + PG8_SB(b, h) + boff + n * 2048 + k * 1024); } while (0)
#define PG8_MMA(ai, bj, At, Bt) do { __builtin_amdgcn_s_setprio(1); _Pragma("unroll") for (int m = 0; m < 4; ++m) _Pragma("unroll") for (int n = 0; n < 2; ++n) _Pragma("unroll") for (int k = 0; k < 2; ++k) \
        acc[ai][bj][m][n] = __builtin_amdgcn_mfma_f32_16x16x32_bf16(Bt[n][k], At[m][k], acc[ai][bj][m][n], 0, 0, 0); __builtin_amdgcn_s_setprio(0); } while (0)
#define PG8_WAIT_V(n) asm volatile("s_waitcnt vmcnt(" #n ")" ::: "memory")
#define PG8_WAIT_L(n) asm volatile("s_waitcnt lgkmcnt(" #n ")" ::: "memory")
#define PG8_BAR __builtin_amdgcn_s_barrier()
#define PG8_SCHED __builtin_amdgcn_sched_barrier(0)
    Unit cur, nxt; int ui = 0;
    if (!S.next(0, cur)) return;
    f32x4 acc[2][2][4][2];
#pragma unroll
    for (int a = 0; a < 2; ++a)
#pragma unroll
        for (int b = 0; b < 2; ++b)
#pragma unroll
            for (int m = 0; m < 4; ++m)
#pragma unroll
                for (int n = 0; n < 2; ++n) acc[a][b][m][n] = (f32x4){0.f, 0.f, 0.f, 0.f};
    bf16x8 At[4][2], B0[2][2], B1[2][2];
    const char* cA = (const char*)g.A + (size_t)cur.pm * tstep; const char* cB = (const char*)g.Bt + (size_t)cur.pn * tstep;
    S.a_ready(cur);
    PG8_STAGE(PG8_SB(0, 0), cB, voffB); PG8_STAGE(PG8_SA(0, 0), cA, voffA); PG8_STAGE(PG8_SB(0, 1), cB + hstep, voffB); PG8_STAGE(PG8_SA(0, 1), cA + hstep, voffA);
    if (wr == 1) PG8_BAR;
    PG8_WAIT_V(4); PG8_BAR;
    PG8_STAGE(PG8_SB(1, 0), cB + kstep, voffB); PG8_STAGE(PG8_SA(1, 0), cA + kstep, voffA); PG8_STAGE(PG8_SB(1, 1), cB + hstep + kstep, voffB);
    PG8_WAIT_V(6); PG8_BAR;
    PG8_STAMP();
    for (;;) {
        const bool has_next = S.next(ui + 1, nxt);
        const char* nA = has_next ? (const char*)g.A + (size_t)nxt.pm * tstep : cA; const char* nB = has_next ? (const char*)g.Bt + (size_t)nxt.pn * tstep : cB;
        for (int t = 0; t < nt; t += 2) {
            const bool last = (t == nt - 2);
            const char* a1 = cA + (size_t)(t + 1) * kstep;
            const char* a2 = last ? nA : cA + (size_t)(t + 2) * kstep; const char* b2 = last ? nB : cB + (size_t)(t + 2) * kstep;
            const char* a3 = a2 + kstep; const char* b3 = b2 + kstep;
            if (last && has_next) S.a_ready(nxt);
            PG8_LDB(B0, 0, 0); PG8_SCHED; PG8_LDA(At, 0, 0); PG8_STAGE(PG8_SA(1, 1), a1 + hstep, voffA);
            PG8_WAIT_L(8); PG8_BAR; PG8_WAIT_L(0); PG8_MMA(0, 0, At, B0); PG8_BAR; PG8_SCHED;
            PG8_LDB(B1, 0, 1); PG8_STAGE(PG8_SB(0, 0), b2, voffB);
            PG8_BAR; PG8_WAIT_L(0); PG8_MMA(0, 1, At, B1); PG8_BAR;
            PG8_LDA(At, 0, 1); PG8_STAGE(PG8_SA(0, 0), a2, voffA);
            PG8_BAR; PG8_WAIT_L(0); PG8_MMA(1, 0, At, B0); PG8_BAR; PG8_SCHED;
            PG8_STAGE(PG8_SB(0, 1), b2 + hstep, voffB);
            PG8_WAIT_V(6); PG8_BAR; PG8_MMA(1, 1, At, B1); PG8_BAR;
            PG8_LDB(B0, 1, 0); PG8_SCHED; PG8_LDA(At, 1, 0); PG8_STAGE(PG8_SA(0, 1), a2 + hstep, voffA);
            PG8_WAIT_L(8); PG8_BAR; PG8_WAIT_L(0); PG8_MMA(0, 0, At, B0); PG8_BAR; PG8_SCHED;
            PG8_LDB(B1, 1, 1); PG8_STAGE(PG8_SB(1, 0), b3, voffB);
            PG8_BAR; PG8_WAIT_L(0); PG8_MMA(0, 1, At, B1); PG8_BAR;
            PG8_LDA(At, 1, 1); PG8_STAGE(PG8_SA(1, 0), a3, voffA);
            PG8_BAR; PG8_WAIT_L(0); PG8_MMA(1, 0, At, B0); PG8_BAR; PG8_SCHED;
            PG8_STAGE(PG8_SB(1, 1), b3 + hstep, voffB);
            PG8_WAIT_V(6); PG8_BAR; PG8_MMA(1, 1, At, B1); PG8_BAR;
        }
        PG8_STAMP();
        if constexpr (!Epi::AFTER_DRAIN) { E(acc, cur, wr, wc, fr, fq); S.done(cur); }
        PG8_STAMP();
        if (!has_next) break;
#pragma unroll
        for (int a = 0; a < 2; ++a)
#pragma unroll
            for (int b = 0; b < 2; ++b)
#pragma unroll
                for (int m = 0; m < 4; ++m)
#pragma unroll
                    for (int n = 0; n < 2; ++n) acc[a][b][m][n] = (f32x4){0.f, 0.f, 0.f, 0.f};
        cur = nxt; cA = nA; cB = nB; ++ui;
    }
    PG8_WAIT_V(0);
    if (wr == 0) PG8_BAR;
    PG8_BAR;
    if constexpr (Epi::AFTER_DRAIN) { E.fused(acc, cur, wr, wc, fr, fq, lds, wid, lane); S.done(cur); }
    PG8_STAMP();
    if (STAMP && wid == 0) { stamps[lane] = lane < nts ? (((unsigned long long)(unsigned)ts_hi << 32) | (unsigned)ts_lo) : 0ull;
        if (lane == 62) stamps[62] = rt_entry; if (lane == 63) stamps[63] = (unsigned long long)wall_clock64(); }
#undef PG8_STAMP
#undef PG8_SA
#undef PG8_SB
#undef PG8_STAGE
#undef PG8_LDA
#undef PG8_LDB
#undef PG8_MMA
#undef PG8_WAIT_V
#undef PG8_WAIT_L
#undef PG8_BAR
#undef PG8_SCHED
}
}

DI float quadsum(float x) {
  auto rr = __builtin_amdgcn_permlane16_swap(__float_as_uint(x), __float_as_uint(x), false, false);
  x = __uint_as_float(rr[0]) + __uint_as_float(rr[1]);
  return swapadd(x);
}
struct EpiP1 {
  static constexpr bool PERM = true, AFTER_DRAIN = false;
  u16* qkv; const float* cs; const float* sn; const float* const* in; int layer; unsigned char* gate;
  DI void operator()(const pg8::f32x4 (&acc)[2][2][4][2], const pg8::Unit& u, int wr, int wc, int fr_, int fq_) const {
    const int lane = tidx() & 63, fr = lane & 15, fq = lane >> 4;
    if (u.pn >= 20) {
#pragma unroll
      for (int ai = 0; ai < 2; ++ai)
#pragma unroll
        for (int m = 0; m < 4; ++m) {
          const int row = u.pm * 256 + ai * 128 + wr * 64 + m * 16 + fr;
          unsigned char* gp = gate + (size_t)row * 4096 + (u.pn - 20) * 256 + wc * 32 + 8 * fq;
#pragma unroll
          for (int bj = 0; bj < 2; ++bj) {
            unsigned w2[2];
#pragma unroll
            for (int n = 0; n < 2; ++n) {
              unsigned wv = 0u;
#pragma unroll
              for (int e = 0; e < 4; ++e) {
                const float sg = __builtin_amdgcn_rcpf(1.f + __builtin_amdgcn_exp2f(-acc[ai][bj][m][n][e] * LOG2E));
                wv |= ((unsigned)(sg * 255.f + 0.5f)) << (8 * e);
              }
              w2[n] = wv;
            }
            u32x2 wq = {w2[0], w2[1]};
            *(u32x2*)(gp + bj * 128) = wq;
          }
        }
      return;
    }
    const int n64 = u.pn * 4 + wc;
    const float* gain = nullptr; float scale = 1.f;
    if (n64 < 8) { gain = in[5] + layer * 64; scale = QS64; }
    else if (n64 < 16) { gain = in[6] + layer * 64; }
    else if (n64 < 24) {}
    else if (n64 < 60) {
      int tt = n64 - 24, g = tt / 12, jj = (tt % 12) >> 2;
      if (jj == 0) { gain = in[9] + (layer * 3 + g) * 64; scale = QS64; }
      else if (jj == 1) { gain = in[10] + (layer * 3 + g) * 64; }
    }
    else if (n64 < 68) { gain = in[17] + layer * 64; scale = QS64; }
    else if (n64 < 70) { gain = in[18] + layer * 64; }
#pragma unroll
    for (int ai = 0; ai < 2; ++ai)
#pragma unroll
      for (int m = 0; m < 4; ++m) {
        const int row = u.pm * 256 + ai * 128 + wr * 64 + m * 16 + fr;
        f32x4 v[2][2];
#pragma unroll
        for (int bj = 0; bj < 2; ++bj)
#pragma unroll
          for (int n = 0; n < 2; ++n) v[bj][n] = acc[ai][bj][m][n];
        if (gain) {
          float ss = 0.f;
#pragma unroll
          for (int bj = 0; bj < 2; ++bj)
#pragma unroll
            for (int n = 0; n < 2; ++n)
#pragma unroll
              for (int e = 0; e < 4; ++e) ss += v[bj][n][e] * v[bj][n][e];
          ss = quadsum(ss);
          const float rstd = __builtin_amdgcn_rsqf(ss * (1.f / 64.f) + EPS);
          const int pos = row & (SEQ - 1);
#pragma unroll
          for (int n = 0; n < 2; ++n) {
            const int d = 8 * fq + 4 * n;
            f32x4 c4 = *(const f32x4*)(cs + pos * 32 + d), s4 = *(const f32x4*)(sn + pos * 32 + d);
            f32x4 g1 = *(const f32x4*)(gain + d), g2 = *(const f32x4*)(gain + 32 + d);
#pragma unroll
            for (int e = 0; e < 4; ++e) {
              float x1 = v[0][n][e] * rstd * g1[e], x2 = v[1][n][e] * rstd * g2[e];
              v[0][n][e] = (x1 * c4[e] - x2 * s4[e]) * scale;
              v[1][n][e] = (x2 * c4[e] + x1 * s4[e]) * scale;
            }
          }
        }
        u16* rowp = qkv + (size_t)row * NINP + n64 * 64 + 8 * fq;
#pragma unroll
        for (int bj = 0; bj < 2; ++bj) {
          u32x4 w = {cvtpk(v[bj][0][0], v[bj][0][1]), cvtpk(v[bj][0][2], v[bj][0][3]), cvtpk(v[bj][1][0], v[bj][1][1]), cvtpk(v[bj][1][2], v[bj][1][3])};
          *(u32x4*)(rowp + bj * 32) = w;
        }
      }
  }
};
struct EpiRes {
  static constexpr bool PERM = false, AFTER_DRAIN = false;
  const float* resid; float* out;
  DI void operator()(const pg8::f32x4 (&acc)[2][2][4][2], const pg8::Unit& u, int wr, int wc, int fr_, int fq_) const {
    const int lane = tidx() & 63, fr = lane & 15, fq = lane >> 4;
#pragma unroll
    for (int ai = 0; ai < 2; ++ai)
#pragma unroll
      for (int m = 0; m < 4; ++m) {
        const size_t o = (size_t)(u.pm * 256 + ai * 128 + wr * 64 + m * 16 + fr) * DM + u.pn * 256 + wc * 32 + 4 * fq;
#pragma unroll
        for (int bj = 0; bj < 2; ++bj)
#pragma unroll
          for (int n = 0; n < 2; ++n) {
            f32x4 x = *(const f32x4*)(resid + o + bj * 128 + n * 16);
            *(f32x4*)(out + o + bj * 128 + n * 16) = x + acc[ai][bj][m][n];
          }
      }
  }
};
struct EpiSwiglu {
  static constexpr bool PERM = true, AFTER_DRAIN = false;
  u16* act;
  DI void operator()(const pg8::f32x4 (&acc)[2][2][4][2], const pg8::Unit& u, int wr, int wc, int fr_, int fq_) const {
    const int lane = tidx() & 63, fr = lane & 15, fq = lane >> 4;
#pragma unroll
    for (int ai = 0; ai < 2; ++ai)
#pragma unroll
      for (int m = 0; m < 4; ++m) {
        const int row = u.pm * 256 + ai * 128 + wr * 64 + m * 16 + fr;
        float a[8];
#pragma unroll
        for (int n = 0; n < 2; ++n)
#pragma unroll
          for (int e = 0; e < 4; ++e) {
            float gte = acc[ai][0][m][n][e];
            a[4 * n + e] = gte * __builtin_amdgcn_rcpf(1.f + __builtin_amdgcn_exp2f(-gte * LOG2E)) * acc[ai][1][m][n][e];
          }
        u32x4 w = {cvtpk(a[0], a[1]), cvtpk(a[2], a[3]), cvtpk(a[4], a[5]), cvtpk(a[6], a[7])};
        *(u32x4*)(act + (size_t)row * DFF + u.pn * 128 + wc * 32 + 8 * fq) = w;
      }
  }
};

DI void repack_tile(const float* __restrict__ src, const float* __restrict__ src2, int nsrc, u16* __restrict__ dst, int K, int n0, int k0, int mode,
                    const float* __restrict__ gain, char* lds) {
  float* tile = (float*)lds;
  const int tid = tidx();
  {
    const int nn = tid & 63, kk0 = tid >> 6;
    const int np = n0 + nn;
    const float* s = src; int col = np; bool valid = true;
    if (mode == 1) {
      const int rho = np & 255, lg = ((np >> 8) * 4 + ((rho >> 5) & 3)) * 64 + 32 * (rho >> 7) + (rho & 31);
      if (lg < 3840) col = lg; else if (lg < 4608) col = 4256 + (lg - 3840); else if (lg < 5024) col = 3840 + (lg - 4608); else valid = false;
    } else if (mode == 2) {
      const int rho = np & 255;
      col = (np >> 8) * 128 + (rho & 127);
      if (rho >= 128) s = src2;
    }
#pragma unroll
    for (int i = 0; i < 8; ++i) {
      int kk = kk0 + 8 * i;
      float v = valid ? s[(size_t)(k0 + kk) * nsrc + col] : 0.f;
      if (gain) v *= gain[k0 + kk];
      tile[kk * 65 + nn] = v;
    }
  }
  __syncthreads();
  {
    const int n = tid >> 3, kc = (tid & 7) * 8;
    float f[8];
#pragma unroll
    for (int i = 0; i < 8; ++i) f[i] = tile[(kc + i) * 65 + n];
    u32x4 w = {cvtpk(f[0], f[1]), cvtpk(f[2], f[3]), cvtpk(f[4], f[5]), cvtpk(f[6], f[7])};
    *(u32x4*)(dst + (size_t)(n0 + n) * K + k0 + kc) = w;
  }
  __syncthreads();
}

DI void sincos_acc(float ang, float& c, float& s) {
  double a = (double)ang;
  double t = a * 0.15915494309189535;
  double fr = t - rint(t);
  double x = fr * 6.283185307179586;
  double x2 = x * x;
  double ts = x, tc = 1.0, ssum = x, csum = 1.0;
  for (int n = 1; n <= 14; ++n) {
    tc *= -x2 / (double)((2 * n - 1) * (2 * n));
    ts *= -x2 / (double)((2 * n) * (2 * n + 1));
    csum += tc; ssum += ts;
  }
  c = (float)csum; s = (float)ssum;
}

__device__ __forceinline__ void phase_w(const Params& p, char* lds) {
  char* const ws = lws(p.ws);
  constexpr int PER_LAYER = 5200;
  for (int t = blockIdx.x; t < PER_LAYER * DEPTH; t += gridDim.x) {
    const int l = t / PER_LAYER; int u = t % PER_LAYER;
    if (u < 1280) {
      repack_tile(p.in[3] + (size_t)l * 1024 * 5024, nullptr, 5024, (u16*)(ws + OFF_WIN) + (size_t)l * NIN2 * 1024, 1024, (u >> 4) * 64, (u & 15) * 64, 1, nullptr, lds);
      continue;
    }
    u -= 1280;
    if (u < 1024) {
      repack_tile(p.in[4] + (size_t)l * 1024 * 4096, nullptr, 4096, (u16*)(ws + OFF_WIN) + ((size_t)l * NIN2 + NINP) * 1024, 1024, (u >> 4) * 64, (u & 15) * 64, 0, nullptr, lds);
      continue;
    }
    u -= 1024;
    if (u < 48) {
      repack_tile(p.in[13] + (size_t)l * 256 * 768, nullptr, 768, (u16*)(ws + OFF_WUQ) + (size_t)l * 768 * 256, 256, (u >> 2) * 64, (u & 3) * 64, 0, p.in[11] + l * 256, lds);
      continue;
    }
    u -= 48;
    if (u < 32) {
      repack_tile(p.in[14] + (size_t)l * 128 * 1024, nullptr, 1024, (u16*)(ws + OFF_WUKV) + (size_t)l * 1024 * 128, 128, (u >> 1) * 64, (u & 1) * 64, 0, p.in[12] + l * 128, lds);
      continue;
    }
    u -= 32;
    if (u < 448) {
      u16* wbr = (u16*)(ws + OFF_WBR) + (size_t)l * 1024 * 1792;
      if (u < 128) repack_tile(p.in[20] + (size_t)l * 512 * 1024, nullptr, 1024, wbr, 512, (u >> 3) * 64, (u & 7) * 64, 0, nullptr, lds);
      else if (u < 192) { u -= 128; repack_tile(p.in[21] + (size_t)l * 256 * 1024, nullptr, 1024, wbr + 1024 * 512, 256, (u >> 2) * 64, (u & 3) * 64, 0, nullptr, lds); }
      else if (u < 320) { u -= 192; repack_tile(p.in[22] + (size_t)l * 512 * 1024, nullptr, 1024, wbr + 1024 * 768, 512, (u >> 3) * 64, (u & 7) * 64, 0, nullptr, lds); }
      else { u -= 320; repack_tile(p.in[23] + (size_t)l * 512 * 1024, nullptr, 1024, wbr + 1024 * 1280, 512, (u >> 3) * 64, (u & 7) * 64, 0, nullptr, lds); }
      continue;
    }
    u -= 448;
    if (u < 256) {
      repack_tile(p.in[24] + (size_t)l * 1024 * 1024, nullptr, 1024, (u16*)(ws + OFF_WO) + (size_t)l * 1024 * 1024, 1024, (u >> 4) * 64, (u & 15) * 64, 0, nullptr, lds);
      continue;
    }
    u -= 256;
    if (u < 1408) {
      repack_tile(p.in[26] + (size_t)l * 1024 * DFF, p.in[27] + (size_t)l * 1024 * DFF, DFF, (u16*)(ws + OFF_WGU) + (size_t)l * NGU * 1024, 1024, (u >> 4) * 64, (u & 15) * 64, 2, nullptr, lds);
      continue;
    }
    u -= 1408;
    repack_tile(p.in[28] + (size_t)l * DFF * 1024, nullptr, 1024, (u16*)(ws + OFF_WDN) + (size_t)l * 1024 * DFF, DFF, (u / 44) * 64, (u % 44) * 64, 0, nullptr, lds);
  }
  const int gt = blockIdx.x * 512 + tidx(), ngt = gridDim.x * 512;
  float* c64 = (float*)(ws + OFF_COS64); float* s64 = (float*)(ws + OFF_SIN64);
  float* c32 = (float*)(ws + OFF_COS32); float* s32 = (float*)(ws + OFF_SIN32);
  for (int i = gt; i < SEQ * 32; i += ngt) {
    int pos = i >> 5, f = i & 31; float c, s;
    sincos_acc((float)pos * p.inv64[f], c, s);
    c64[i] = c; s64[i] = s;
  }
  for (int i = gt; i < SEQ * 16; i += ngt) {
    int pos = i >> 4, f = i & 15; float c, s;
    sincos_acc((float)pos * p.inv32[f], c, s);
    c32[i] = c; s32[i] = s;
  }
  if (blockIdx.x == 0)
    for (int i = tidx(); i < 3456; i += 512) __hip_atomic_store((unsigned*)(ws + OFF_BAR) + i, 0u, __ATOMIC_RELAXED, __HIP_MEMORY_SCOPE_AGENT);
  if (gt < DEPTH) {
    const float* lp = p.in[7] + gt * 256;
    float a = 0.f, b = 0.f;
    for (int i = 0; i < 64; ++i) { a += lp[i] * lp[64 + i]; b += lp[128 + i] * lp[192 + i]; }
    ((float*)(ws + OFF_LAM))[gt] = expf(a) - expf(b) + p.lam_init[gt];
  }
}

__device__ __forceinline__ void phase_norm(const float* __restrict__ x, const float* __restrict__ g, u16* __restrict__ xn) {
  const int lane = tidx() & 63, wid = wave_id();
  for (int row = blockIdx.x * 8 + wid; row < CT; row += gridDim.x * 8) {
    const f32x4* xr = (const f32x4*)(x + (size_t)row * DM);
    f32x4 v[4]; float ss = 0.f;
#pragma unroll
    for (int i = 0; i < 4; ++i) { v[i] = xr[lane + 64 * i]; ss += v[i][0] * v[i][0] + v[i][1] * v[i][1] + v[i][2] * v[i][2] + v[i][3] * v[i][3]; }
    ss = swapadd(ss);
#pragma unroll
    for (int o = 16; o >= 1; o >>= 1) ss += __int_as_float(__builtin_amdgcn_ds_bpermute((lane ^ o) << 2, __float_as_int(ss)));
    const float rstd = __builtin_amdgcn_rsqf(ss * (1.f / 1024.f) + EPS);
#pragma unroll
    for (int i = 0; i < 4; ++i) {
      f32x4 g4 = ((const f32x4*)g)[lane + 64 * i];
      u32x2 w = {cvtpk(v[i][0] * rstd * g4[0], v[i][1] * rstd * g4[1]), cvtpk(v[i][2] * rstd * g4[2], v[i][3] * rstd * g4[3])};
      *(u32x2*)(xn + (size_t)row * DM + (lane + 64 * i) * 4) = w;
    }
  }
}

__device__ __forceinline__ void phase_p1(const Params& p, int layer, char* lds) {
  char* const ws = lws(p.ws);
  pg8::Gemm g{(const u16*)(ws + OFF_XN), (const u16*)(ws + OFF_WIN) + (size_t)layer * NIN2 * 1024, CT, NIN2, 1024};
  pg8::StaticOrder S; S.init(CT, NIN2, gridDim.x, blockIdx.x);
  EpiP1 E{(u16*)(ws + OFF_QKV), (const float*)(ws + OFF_COS64), (const float*)(ws + OFF_SIN64), p.in, layer, (unsigned char*)(ws + OFF_GATE)};
  __syncthreads();
  pg8::gemm_phase<EpiP1, pg8::StaticOrder, false>((PG8_LAS unsigned char*)lds, g, S, E, nullptr);
}

__device__ __forceinline__ void phase_p1c(const Params& p, int layer, char* lds) {
  char* const ws = lws(p.ws);
  const u16* Wuq = (const u16*)(ws + OFF_WUQ) + (size_t)layer * 768 * 256;
  const u16* Wukv = (const u16*)(ws + OFF_WUKV) + (size_t)layer * 1024 * 128;
  const u16* qkv = (const u16*)(ws + OFF_QKV);
  u16* qc = (u16*)(ws + OFF_QKVC);
  const float* c32 = (const float*)(ws + OFF_COS32); const float* s32 = (const float*)(ws + OFF_SIN32);
  const int tid = tidx(), wid = wave_id(), wn = wid & 3, wm = wid >> 2;
  char* wl = lds + wid * WAVE_LDS;
  for (int t = blockIdx.x; t < 2 * 128; t += gridDim.x) {
    int nt, mt; tile_map(t, nt, mt);
    const int n0 = nt * 384, m0 = mt * 128;
    f32x16 acc[3][2];
    gemm_core<3>(acc, Wuq + (size_t)n0 * 256, 256, qkv + (size_t)m0 * NINP + 4608, NINP, 256, lds);
    const int lane2 = (tidx() & 63), r = lane2 & 31, h = lane2 >> 5;
#pragma unroll
    for (int j = 0; j < 2; ++j) {
      const int m = m0 + wm * 64 + j * 32 + r;
      float ss = swapadd(row_ssq(qkv + (size_t)m * NINP + 4608 + h * 128, 16));
      const float rq = __builtin_amdgcn_rsqf(ss * (1.f / 256.f) + EPS);
#pragma unroll
      for (int i = 0; i < 3; ++i)
#pragma unroll
        for (int e = 0; e < 16; ++e) acc[i][j][e] *= rq;
    }
    norm96_rope_store(acc, p.in[15] + layer * 96, QS96, (m0 + wm * 64) & (SEQ - 1), c32, s32, qc + (size_t)(m0 + wm * 64) * QKVC_LD + n0 + wn * 96, wl);
  }
  for (int t = blockIdx.x; t < 4 * 128; t += gridDim.x) {
    int nt, mt; tile_map(t, nt, mt);
    const int n0 = nt * 256, m0 = mt * 128;
    f32x16 acc[3][2];
    gemm_core<2, 3>(acc, Wukv + (size_t)n0 * 128, 128, qkv + (size_t)m0 * NINP + 4864, NINP, 128, lds);
    const int n64 = (n0 >> 6) + wn, head = n64 >> 1, isv = n64 & 1;
    const int lane2 = (tidx() & 63), r = lane2 & 31, h = lane2 >> 5;
#pragma unroll
    for (int j = 0; j < 2; ++j) {
      const int m = m0 + wm * 64 + j * 32 + r;
      float ss = swapadd(row_ssq(qkv + (size_t)m * NINP + 4864 + h * 64, 8));
      const float rk = __builtin_amdgcn_rsqf(ss * (1.f / 128.f) + EPS);
#pragma unroll
      for (int i = 0; i < 2; ++i)
#pragma unroll
        for (int e = 0; e < 16; ++e) acc[i][j][e] *= rk;
    }
    if (isv) {
      store_wave_bf16<2, 3>(acc, qc + (size_t)(m0 + wm * 64) * QKVC_LD + 1536 + head * 64, QKVC_LD, wl);
    } else {
      f32x16 (&y)[3][2] = acc;
#pragma unroll
      for (int j = 0; j < 2; ++j) {
        const int m = m0 + wm * 64 + j * 32 + r;
#pragma unroll
        for (int g = 0; g < 4; ++g) {
          u32x2 d = *(const u32x2*)(qkv + (size_t)m * NINP + 4992 + 8 * g + 4 * h);
          y[2][j][4 * g] = bflo(d[0]); y[2][j][4 * g + 1] = bfhi(d[0]); y[2][j][4 * g + 2] = bflo(d[1]); y[2][j][4 * g + 3] = bfhi(d[1]);
        }
      }
      norm96_rope_store(y, p.in[16] + layer * 96, 1.f, (m0 + wm * 64) & (SEQ - 1), c32, s32, qc + (size_t)(m0 + wm * 64) * QKVC_LD + 768 + head * 96, wl);
    }
  }
}

constexpr int QLDS_OFF = 77824, QLDS_WAVE = 64 * 144;
template <int DQK, int DV, int NKT, bool BANDED, bool QLDS = false>
DI void attn_loop(f32x16 (&O)[2][DV / 32], float (&mrun)[2], float (&lrun)[2], const bf16x8 (&qf)[2][DQK / 16],
                  const u16* __restrict__ k0p, const u16* __restrict__ k1p, size_t kld, const u16* __restrict__ vp, size_t vld,
                  int t0, int t1, bool wact, int qbase, int W, char* lds) {
  constexpr int KP = DQK * 2 + 16, VP = DV * 2 + 64;
  constexpr int KC = DQK / 8, VC = DV / 8;
  constexpr int KTOT = NKT * 64 * KC, VTOT = 64 * VC, TOT = KTOT + VTOT, NIT = (TOT + 511) / 512;
  constexpr int SB = NKT * 64 * KP + 64 * VP;
  constexpr float THR = 8.f;
  const int tid = tidx(), lane = tid & 63, r = lane & 31, h = lane >> 5;
  const int dk1 = NKT == 2 ? (int)(k1p - k0p) : 0, dvo = (int)(vp - k0p);
  const int ldi = (int)kld;
  int soff[NIT]; int doff[NIT]; bool sval[NIT];
#pragma unroll
  for (int it = 0; it < NIT; ++it) {
    const int c = tid + it * 512;
    const bool allK = (it + 1) * 512 <= KTOT, allV = it * 512 >= KTOT;
    const bool isK = allK ? true : (allV ? false : (c < KTOT));
    const int kt = c / (64 * KC), rem = c % (64 * KC), krow = rem / KC, kcol = rem % KC;
    const int c2 = c - KTOT, vrow = c2 / VC, vcol = c2 % VC;
    const int so_k = (kt ? dk1 : 0) + krow * ldi + kcol * 8, do_k = kt * 64 * KP + krow * KP + kcol * 16;
    const int so_v = dvo + vrow * ldi + vcol * 8, do_v = NKT * 64 * KP + vrow * VP + vcol * 16;
    soff[it] = isK ? so_k : so_v;
    doff[it] = isK ? do_k : do_v;
    sval[it] = ((it + 1) * 512 <= TOT) ? true : (c < TOT);
  }
  u32x4 rg[NIT];
#define SOFF_(it) ((NKT == 2 ? soff[(it) & ~1] : soff[it]) * 2)
#define SADD_(it) ((NKT == 2 && ((it) & 1)) ? ((it) == 1 ? dk1 * 2 : 32 * ldi * 2) : 0)
#define DOFF_(it) ((NKT == 2 && ((it) & 1)) ? doff[(it) & ~1] + ((it) == 1 ? 64 * KP : 32 * VP) : doff[it])
  const __amdgpu_buffer_rsrc_t krsrc = __builtin_amdgcn_make_buffer_rsrc((void*)k0p, 0, 0x7fffffff, 0x00020000);
  const int kaddr = r * KP + h * 16;
  const char* const qlds = lds + QLDS_OFF + wave_id() * QLDS_WAVE + r * 144 + h * 16;
  const int vaddr = NKT * 64 * KP + (4 * h + ((lane & 15) >> 2)) * VP + (((lane >> 4) & 1) * 16 + (lane & 3) * 4) * 2;
  if (t1 <= t0) return;
  __syncthreads();
#pragma unroll
  for (int it = 0; it < NIT; ++it) if (sval[it]) rg[it] = __builtin_amdgcn_raw_buffer_load_b128(krsrc, SOFF_(it), t0 * 128 * ldi + SADD_(it), 0);
#pragma unroll
  for (int it = 0; it < NIT; ++it) if (sval[it]) *(u32x4*)(lds + DOFF_(it)) = rg[it];
  __syncthreads();
#pragma nounroll
  for (int t = t0; t < t1; ++t) {
    const int buf = (t - t0) & 1;
    const bool more = t + 1 < t1;
    if (more && NKT == 1) {
#pragma unroll
      for (int it = 0; it < NIT; ++it) if (sval[it]) rg[it] = __builtin_amdgcn_raw_buffer_load_b128(krsrc, SOFF_(it), (t + 1) * 128 * ldi + SADD_(it), 0);
    }
    bool doit = wact;
    if (BANDED) doit = wact && (t * 64 + 63 >= qbase - W) && (t * 64 <= qbase + 63 + W);
    if (doit) {
      const char* base = lds + buf * SB;
      bf16x8 pf[2][4];
      if (NKT == 1) {
        f32x16 S[2][2];
#pragma unroll
        for (int j = 0; j < 2; ++j)
#pragma unroll
          for (int kb = 0; kb < 2; ++kb)
#pragma unroll
            for (int e = 0; e < 16; ++e) S[j][kb][e] = 0.f;
#pragma unroll
        for (int s = 0; s < DQK / 16; ++s)
#pragma unroll
          for (int kb = 0; kb < 2; ++kb) {
            bf16x8 kf = *(const bf16x8*)(base + kaddr + kb * 32 * KP + s * 32);
#pragma unroll
            for (int j = 0; j < 2; ++j) S[j][kb] = MFMA(kf, qf[j][s], S[j][kb]);
          }
#pragma unroll
        for (int j = 0; j < 2; ++j) {
          if (BANDED) {
            const int qi = qbase + j * 32 + r;
#pragma unroll
            for (int kb = 0; kb < 2; ++kb)
#pragma unroll
              for (int e = 0; e < 16; ++e) {
                int ki = t * 64 + kb * 32 + crow(e, h);
                int dd = qi - ki; dd = dd < 0 ? -dd : dd;
                if (dd > W) S[j][kb][e] = -1e30f;
              }
          }
          float pmax = S[j][0][0];
#pragma unroll
          for (int e = 1; e < 16; ++e) pmax = fmaxf(pmax, S[j][0][e]);
#pragma unroll
          for (int e = 0; e < 16; ++e) pmax = fmaxf(pmax, S[j][1][e]);
          pmax = swapmax(pmax);
          if (!__all(pmax - mrun[j] <= THR)) {
            float mn = fmaxf(mrun[j], pmax);
            float alpha = __builtin_amdgcn_exp2f(mrun[j] - mn);
            mrun[j] = mn; lrun[j] *= alpha;
#pragma unroll
            for (int d = 0; d < DV / 32; ++d)
#pragma unroll
              for (int e = 0; e < 16; ++e) O[j][d][e] *= alpha;
          }
          float ps = 0.f; const float mm = mrun[j];
#pragma unroll
          for (int kb = 0; kb < 2; ++kb)
#pragma unroll
            for (int e = 0; e < 16; ++e) { float pv = __builtin_amdgcn_exp2f(S[j][kb][e] - mm); S[j][kb][e] = pv; ps += pv; }
          lrun[j] += ps;
#pragma unroll
          for (int ks = 0; ks < 4; ++ks) {
            const int kb = ks >> 1, b8 = (ks & 1) * 8;
            u32x4 w = {cvtpk(S[j][kb][b8], S[j][kb][b8 + 1]), cvtpk(S[j][kb][b8 + 2], S[j][kb][b8 + 3]),
                       cvtpk(S[j][kb][b8 + 4], S[j][kb][b8 + 5]), cvtpk(S[j][kb][b8 + 6], S[j][kb][b8 + 7])};
            pf[j][ks] = __builtin_bit_cast(bf16x8, w);
          }
        }
      } else {
#pragma unroll
        for (int j = 0; j < 2; ++j) {
          f32x16 S[2];
#pragma unroll
          for (int kb = 0; kb < 2; ++kb)
#pragma unroll
            for (int e = 0; e < 16; ++e) S[kb][e] = 0.f;
          {
            constexpr int NS = DQK / 16;
            const char* kbase = base + j * 64 * KP + kaddr;
            const char* qbase_l = qlds + j * 32 * 144;
#define A1_KF(s_, kb_) (*(const bf16x8*)(kbase + (kb_) * 32 * KP + (s_) * 32))
#define A1_QF(s_) (QLDS ? *(const bf16x8*)(qbase_l + (s_) * 32) : qf[j][(s_)])
            bf16x8 ka = A1_KF(0, 0), kb2 = A1_KF(0, 1), qa = A1_QF(0);
            __builtin_amdgcn_sched_barrier(0);
#pragma unroll
            for (int s2 = 0; s2 < NS; ++s2) {
              bf16x8 kn0, kn1, qn;
              if (s2 + 1 < NS) { kn0 = A1_KF(s2 + 1, 0); kn1 = A1_KF(s2 + 1, 1); qn = A1_QF(s2 + 1); }
              __builtin_amdgcn_sched_barrier(0);
              S[0] = MFMA(ka, qa, S[0]);
              S[1] = MFMA(kb2, qa, S[1]);
              __builtin_amdgcn_sched_barrier(0);
              if (s2 + 1 < NS) { ka = kn0; kb2 = kn1; qa = qn; }
            }
#undef A1_KF
#undef A1_QF
          }
          float pmax = S[0][0];
#pragma unroll
          for (int e = 1; e < 16; ++e) pmax = fmaxf(pmax, S[0][e]);
#pragma unroll
          for (int e = 0; e < 16; ++e) pmax = fmaxf(pmax, S[1][e]);
          pmax = swapmax(pmax);
          if (!__all(pmax - mrun[j] <= THR)) {
            float mn = fmaxf(mrun[j], pmax);
            float alpha = __builtin_amdgcn_exp2f(mrun[j] - mn);
            mrun[j] = mn; lrun[j] *= alpha;
#pragma unroll
            for (int d = 0; d < DV / 32; ++d)
#pragma unroll
              for (int e = 0; e < 16; ++e) O[j][d][e] *= alpha;
          }
          float ps = 0.f; const float mm = mrun[j];
#pragma unroll
          for (int kb = 0; kb < 2; ++kb)
#pragma unroll
            for (int e = 0; e < 16; ++e) { float pv = __builtin_amdgcn_exp2f(S[kb][e] - mm); S[kb][e] = pv; ps += pv; }
          lrun[j] += ps;
#pragma unroll
          for (int ks = 0; ks < 4; ++ks) {
            const int kb = ks >> 1, b8 = (ks & 1) * 8;
            u32x4 w = {cvtpk(S[kb][b8], S[kb][b8 + 1]), cvtpk(S[kb][b8 + 2], S[kb][b8 + 3]),
                       cvtpk(S[kb][b8 + 4], S[kb][b8 + 5]), cvtpk(S[kb][b8 + 6], S[kb][b8 + 7])};
            pf[j][ks] = __builtin_bit_cast(bf16x8, w);
          }
          {
            constexpr int ND = DV / 32, NV = 4 * ND;
            const char* vbase = base + vaddr;
            auto vread = [&](int i) -> bf16x8 {
              const char* va = vbase + (i / ND) * 16 * VP + (i % ND) * 64;
              s16x4 lo = __builtin_amdgcn_ds_read_tr16_b64_v4i16((__attribute__((address_space(3))) s16x4*)(va));
              s16x4 hi = __builtin_amdgcn_ds_read_tr16_b64_v4i16((__attribute__((address_space(3))) s16x4*)(va + 8 * VP));
              bf16x8 vf = {lo[0], lo[1], lo[2], lo[3], hi[0], hi[1], hi[2], hi[3]};
              return vf;
            };
            bf16x8 v0 = vread(0), v1 = vread(1);
            __builtin_amdgcn_sched_barrier(0);
#pragma unroll
            for (int i = 0; i < NV; i += 2) {
              O[j][i % ND] = MFMA(v0, pf[j][i / ND], O[j][i % ND]);
              if (i + 2 < NV) v0 = vread(i + 2);
              __builtin_amdgcn_sched_barrier(0);
              O[j][(i + 1) % ND] = MFMA(v1, pf[j][(i + 1) / ND], O[j][(i + 1) % ND]);
              if (i + 3 < NV) v1 = vread(i + 3);
              __builtin_amdgcn_sched_barrier(0);
            }
            if (j == 0 && more) {
#pragma unroll
              for (int it = 0; it < NIT; ++it) if (sval[it]) rg[it] = __builtin_amdgcn_raw_buffer_load_b128(krsrc, SOFF_(it), (t + 1) * 128 * ldi + SADD_(it), 0);
              __builtin_amdgcn_sched_barrier(0);
            }
          }
        }
      }
      if (NKT == 1) {
#pragma unroll
        for (int ks = 0; ks < 4; ++ks)
#pragma unroll
          for (int d = 0; d < DV / 32; ++d) {
            const char* va = base + vaddr + ks * 16 * VP + d * 64;
            s16x4 lo = __builtin_amdgcn_ds_read_tr16_b64_v4i16((__attribute__((address_space(3))) s16x4*)(va));
            s16x4 hi = __builtin_amdgcn_ds_read_tr16_b64_v4i16((__attribute__((address_space(3))) s16x4*)(va + 8 * VP));
            bf16x8 vf = {lo[0], lo[1], lo[2], lo[3], hi[0], hi[1], hi[2], hi[3]};
#pragma unroll
            for (int j = 0; j < 2; ++j) O[j][d] = MFMA(vf, pf[j][ks], O[j][d]);
          }
      }
    }
    if (more) {
      char* nb = lds + (buf ^ 1) * SB;
#pragma unroll
      for (int it = 0; it < NIT; ++it) if (sval[it]) *(u32x4*)(nb + DOFF_(it)) = rg[it];
    }
    __syncthreads();
  }
}

template <int NS>
DI void load_qf(bf16x8 (&qf)[NS], const u16* __restrict__ qrow) {
#pragma unroll
  for (int s = 0; s < NS; ++s) qf[s] = *(const bf16x8*)(qrow + s * 16);
}

template <int ND>
DI void store_o(const f32x16 (&o)[ND], float scale, u16* __restrict__ dst, int h) {
#pragma unroll
  for (int d = 0; d < ND; ++d)
#pragma unroll
    for (int g = 0; g < 4; ++g) {
      u32x2 w = {cvtpk(o[d][4 * g] * scale, o[d][4 * g + 1] * scale), cvtpk(o[d][4 * g + 2] * scale, o[d][4 * g + 3] * scale)};
      *(u32x2*)(dst + d * 32 + 8 * g + 4 * h) = w;
    }
}

DI void item_map(int idx, int nqb, int& sh, int& qb) {
  int xcd = idx & 7, slot = idx >> 3;
  sh = xcd * (32 / nqb) + slot / nqb;
  qb = slot % nqb;
}

__device__ __forceinline__ void attn_A(const Params& p, int layer, int idx, char* lds) {
  char* const ws = lws(p.ws);
  const int tid = tidx(), lane = tid & 63, wid = wave_id(), r = lane & 31, h = lane >> 5;
  int sh, qb; item_map(idx, 16, sh, qb);
  const int seq = sh >> 2, head = sh & 3;
  const u16* qkv = (const u16*)(ws + OFF_QKV) + (size_t)seq * SEQ * NINP;
  u16* outs = (u16*)(ws + OFF_OUTS) + (size_t)seq * SEQ * OUT_LD;
  const int q0 = qb * 256 + wid * 32;
  bf16x8 qf[2][4];
  __syncthreads();
#pragma unroll
  for (int j = 0; j < 2; ++j) {
    load_qf<4>(qf[j], qkv + (size_t)(q0 + r) * NINP + (head * 2 + j) * 64 + h * 8);
#pragma unroll
    for (int s = 0; s < 4; ++s) *(bf16x8*)(lds + QLDS_OFF + wid * QLDS_WAVE + (j * 32 + r) * 144 + h * 16 + s * 32) = qf[j][s];
  }
  lds_fence();
  f32x16 O[2][4]; float mrun[2] = {-1e29f, -1e29f}, lrun[2] = {0.f, 0.f};
#pragma unroll
  for (int j = 0; j < 2; ++j)
#pragma unroll
    for (int d = 0; d < 4; ++d)
#pragma unroll
      for (int e = 0; e < 16; ++e) O[j][d][e] = 0.f;
  attn_loop<64, 128, 2, false, true>(O, mrun, lrun, qf, qkv + 512 + (head * 2) * 64, qkv + 512 + (head * 2 + 1) * 64, NINP, qkv + 1024 + head * 128, NINP,
                               0, 64, true, 0, 0, lds);
  const int lane2 = (tidx() & 63), r2 = lane2 & 31, h2 = lane2 >> 5;
  const float lam = ((const float*)(ws + OFF_LAM))[layer];
  const float i0 = 1.f / swapadd(lrun[0]), i1 = lam / swapadd(lrun[1]);
  float ss = 0.f;
#pragma unroll
  for (int d = 0; d < 4; ++d)
#pragma unroll
    for (int e = 0; e < 16; ++e) { float o = O[0][d][e] * i0 - O[1][d][e] * i1; O[0][d][e] = o; ss += o * o; }
  ss = swapadd(ss);
  const float rstd = __builtin_amdgcn_rsqf(ss * (1.f / 128.f) + EPS) * p.oml[layer];
  const float* sg = p.in[8] + layer * 128;
  u16* dst = outs + (size_t)(q0 + r2) * OUT_LD + head * 128;
#pragma unroll
  for (int d = 0; d < 4; ++d)
#pragma unroll
    for (int g = 0; g < 4; ++g) {
      f32x4 g4 = *(const f32x4*)(sg + d * 32 + 8 * g + 4 * h2);
      u32x2 w = {cvtpk(O[0][d][4 * g] * rstd * g4[0], O[0][d][4 * g + 1] * rstd * g4[1]), cvtpk(O[0][d][4 * g + 2] * rstd * g4[2], O[0][d][4 * g + 3] * rstd * g4[3])};
      *(u32x2*)(dst + d * 32 + 8 * g + 4 * h2) = w;
    }
}

__device__ __forceinline__ void attn_C(const Params& p, int layer, int idx, char* lds) {
  char* const ws = lws(p.ws);
  const int tid = tidx(), lane = tid & 63, wid = wave_id(), r = lane & 31, h = lane >> 5;
  int sh, qb; item_map(idx, 8, sh, qb);
  const int seq = sh >> 3, head = sh & 7;
  const u16* qc = (const u16*)(ws + OFF_QKVC) + (size_t)seq * SEQ * QKVC_LD;
  u16* outs = (u16*)(ws + OFF_OUTS) + (size_t)seq * SEQ * OUT_LD;
  const int q0 = qb * 512 + wid * 64;
  bf16x8 qf[2][6];
  load_qf<6>(qf[0], qc + (size_t)(q0 + r) * QKVC_LD + head * 96 + h * 8);
  load_qf<6>(qf[1], qc + (size_t)(q0 + 32 + r) * QKVC_LD + head * 96 + h * 8);
  f32x16 O[2][2]; float mrun[2] = {-1e29f, -1e29f}, lrun[2] = {0.f, 0.f};
#pragma unroll
  for (int j = 0; j < 2; ++j)
#pragma unroll
    for (int d = 0; d < 2; ++d)
#pragma unroll
      for (int e = 0; e < 16; ++e) O[j][d][e] = 0.f;
  attn_loop<96, 64, 1, false>(O, mrun, lrun, qf, qc + 768 + head * 96, nullptr, QKVC_LD, qc + 1536 + head * 64, QKVC_LD, 0, 64, true, 0, 0, lds);
  const int lane2 = (tidx() & 63), r2 = lane2 & 31, h2 = lane2 >> 5;
#pragma unroll
  for (int j = 0; j < 2; ++j) {
    const float inv = 1.f / swapadd(lrun[j]);
    store_o<2>(O[j], inv, outs + (size_t)(q0 + j * 32 + r2) * OUT_LD + 768 + head * 64, h2);
  }
}

__device__ __forceinline__ void attn_D(const Params& p, int layer, int idx, char* lds) {
  char* const ws = lws(p.ws);
  const int tid = tidx(), lane = tid & 63, wid = wave_id(), r = lane & 31, h = lane >> 5;
  const int xcd = idx & 7, qb = idx >> 3;
  const int seq = xcd >> 1, kvh = xcd & 1;
  const u16* qkv = (const u16*)(ws + OFF_QKV) + (size_t)seq * SEQ * NINP;
  u16* outs = (u16*)(ws + OFF_OUTS) + (size_t)seq * SEQ * OUT_LD;
  const int qhead = kvh * 4 + (wid >> 1);
  const int q0 = qb * 128 + (wid & 1) * 64;
  bf16x8 qf[2][4];
  load_qf<4>(qf[0], qkv + (size_t)(q0 + r) * NINP + 3840 + qhead * 64 + h * 8);
  load_qf<4>(qf[1], qkv + (size_t)(q0 + 32 + r) * NINP + 3840 + qhead * 64 + h * 8);
  f32x16 O[2][2]; float mrun[2] = {-1e29f, -1e29f}, lrun[2] = {0.f, 0.f};
#pragma unroll
  for (int j = 0; j < 2; ++j)
#pragma unroll
    for (int d = 0; d < 2; ++d)
#pragma unroll
      for (int e = 0; e < 16; ++e) O[j][d][e] = 0.f;
  int t0 = qb * 2 - 2; if (t0 < 0) t0 = 0;
  int t1 = qb * 2 + 4; if (t1 > 64) t1 = 64;
  attn_loop<64, 64, 1, true>(O, mrun, lrun, qf, qkv + 4352 + kvh * 64, nullptr, NINP, qkv + 4480 + kvh * 64, NINP, t0, t1, true, q0, 128, lds);
  const float sink2 = p.in[19][layer * 8 + qhead] * LOG2E;
  const int lane2 = (tidx() & 63), r2 = lane2 & 31, h2 = lane2 >> 5;
#pragma unroll
  for (int j = 0; j < 2; ++j) {
    const float l = swapadd(lrun[j]);
    const float mf = fmaxf(mrun[j], sink2);
    const float a = __builtin_amdgcn_exp2f(mrun[j] - mf);
    const float lf = l * a + __builtin_amdgcn_exp2f(sink2 - mf);
    store_o<2>(O[j], a / lf, outs + (size_t)(q0 + j * 32 + r2) * OUT_LD + 1280 + qhead * 64, h2);
  }
}

__device__ __forceinline__ void attn_B(const Params& p, int layer, int idx, char* lds) {
  char* const ws = lws(p.ws);
  const int tid = tidx(), lane = tid & 63, wid = wave_id(), r = lane & 31, h = lane >> 5;
  const int sub = idx & 31, sh = idx >> 5, seq = sh >> 2, head = sh & 3;
  int g, res, m0;
  if (sub < 8) { g = 0; res = 0; m0 = sub * 512; }
  else if (sub < 16) { g = 1; res = (sub - 8) >> 1; m0 = ((sub - 8) & 1) * 512; }
  else { g = 2; res = sub - 16; m0 = 0; }
  const int dil = g == 0 ? 1 : (g == 1 ? 4 : 16);
  const int Lg = SEQ / dil;
  int nact = (Lg - m0) / 64; if (nact > 8) nact = 8;
  const bool wact = wid < nact;
  const size_t ld = (size_t)dil * NINP;
  const u16* base = (const u16*)(ws + OFF_QKV) + ((size_t)seq * SEQ + res) * NINP + 1536 + g * 768 + head * 64;
  int q0 = m0 + wid * 64; if (!wact) q0 = m0;
  bf16x8 qf[2][4];
  load_qf<4>(qf[0], base + (size_t)(q0 + r) * ld + h * 8);
  load_qf<4>(qf[1], base + (size_t)(q0 + 32 + r) * ld + h * 8);
  f32x16 O[2][2]; float mrun[2] = {-1e29f, -1e29f}, lrun[2] = {0.f, 0.f};
#pragma unroll
  for (int j = 0; j < 2; ++j)
#pragma unroll
    for (int d = 0; d < 2; ++d)
#pragma unroll
      for (int e = 0; e < 16; ++e) O[j][d][e] = 0.f;
  int t0 = m0 / 64 - 1; if (t0 < 0) t0 = 0;
  int t1 = m0 / 64 + 9; if (t1 > Lg / 64) t1 = Lg / 64;
  attn_loop<64, 64, 1, true>(O, mrun, lrun, qf, base + 256, nullptr, ld, base + 512, ld, t0, t1, wact, q0, 64, lds);
  if (wact) {
    const int lane2 = (tidx() & 63), r2 = lane2 & 31, h2 = lane2 >> 5;
    u16* bo = (u16*)(ws + OFF_BO) + (size_t)g * CT * 256;
    float* blse = (float*)(ws + OFF_BLSE) + (size_t)g * CT * 4;
#pragma unroll
    for (int j = 0; j < 2; ++j) {
      const float l = swapadd(lrun[j]);
      const size_t tok = (size_t)seq * SEQ + (size_t)(q0 + j * 32 + r2) * dil + res;
      store_o<2>(O[j], 1.f / l, bo + tok * 256 + head * 64, h2);
      if (h2 == 0) blse[tok * 4 + head] = mrun[j] + __builtin_amdgcn_logf(l);
    }
  }
}

DI void combine_rows(char* ws, int m0) {
  const u16* bo = (const u16*)(ws + OFF_BO);
  const float* blse = (const float*)(ws + OFF_BLSE);
  u16* outs = (u16*)(ws + OFF_OUTS);
  for (int i = tidx(); i < 128 * 32; i += 512) {
    const int tok = m0 + (i >> 5), ch = i & 31, head = ch >> 3;
    float l0 = blse[(size_t)tok * 4 + head], l1 = blse[((size_t)CT + tok) * 4 + head], l2 = blse[((size_t)2 * CT + tok) * 4 + head];
    float mx = fmaxf(l0, fmaxf(l1, l2));
    float w0 = __builtin_amdgcn_exp2f(l0 - mx), w1 = __builtin_amdgcn_exp2f(l1 - mx), w2 = __builtin_amdgcn_exp2f(l2 - mx);
    float inv = 1.f / (w0 + w1 + w2); w0 *= inv; w1 *= inv; w2 *= inv;
    u32x4 a = *(const u32x4*)(bo + (size_t)tok * 256 + ch * 8);
    u32x4 b = *(const u32x4*)(bo + ((size_t)CT + tok) * 256 + ch * 8);
    u32x4 c = *(const u32x4*)(bo + ((size_t)2 * CT + tok) * 256 + ch * 8);
    u32x4 o;
#pragma unroll
    for (int e = 0; e < 4; ++e) {
      float lo = w0 * bflo(a[e]) + w1 * bflo(b[e]) + w2 * bflo(c[e]);
      float hi = w0 * bfhi(a[e]) + w1 * bfhi(b[e]) + w2 * bfhi(c[e]);
      o[e] = cvtpk(lo, hi);
    }
    *(u32x4*)(outs + (size_t)tok * OUT_LD + 512 + ch * 8) = o;
  }
  asm volatile("s_waitcnt vmcnt(0)" ::: "memory");
}

__device__ __forceinline__ void phase_merge(const Params& p, int layer, char* lds) {
  constexpr int AR = 256, STAGE = (AR + 128) * PITCH;
  char* const ws = lws(p.ws);
  const u16* Wbr = (const u16*)(ws + OFF_WBR) + (size_t)layer * 1024 * 1792;
  const u16* outs = (const u16*)(ws + OFF_OUTS);
  u16* merged = (u16*)(ws + OFF_MERGED);
  const int wid = wave_id(), wn = wid & 3, wm = wid >> 2;
  const __amdgpu_buffer_rsrc_t arsrc = __builtin_amdgcn_make_buffer_rsrc((void*)Wbr, 0, 0x7fffffff, 0x00020000);
  for (int t = blockIdx.x; t < 4 * 128; t += gridDim.x) {
    int nt, mt; tile_map(t, nt, mt);
    const int n0 = nt * 256, m0 = mt * 128;
    combine_rows(ws, m0);
    const int tid = tidx(), lane = tid & 63, r = lane & 31, h = lane >> 5;
    const int crow0 = tid >> 3, ccol = tid & 7;
    const __amdgpu_buffer_rsrc_t brsrc = __builtin_amdgcn_make_buffer_rsrc((void*)(outs + (size_t)m0 * OUT_LD), 0, 0x7fffffff, 0x00020000);
    const int bvo = (crow0 * OUT_LD + ccol * 8) * 2, bstep = 64 * OUT_LD * 2;
    const int wofs = crow0 * PITCH + ccol * 16;
    const int aoff = (wn * 64 + r) * PITCH + h * 16;
    const int boff = AR * PITCH + (wm * 64 + r) * PITCH + h * 16;
    f32x16 mg[2][2], acc[2][2];
#pragma unroll
    for (int i = 0; i < 2; ++i)
#pragma unroll
      for (int j = 0; j < 2; ++j)
#pragma unroll
        for (int e = 0; e < 16; ++e) { mg[i][j][e] = 0.f; acc[i][j][e] = 0.f; }
    u32x4 ra[4], rb[2];
    unsigned gw[2][2][4];
#define MG_BR(q) ((q) < 8 ? 0 : ((q) < 12 ? 1 : ((q) < 20 ? 2 : 3)))
#define MG_Q0(br) ((br) == 0 ? 0 : ((br) == 1 ? 8 : ((br) == 2 ? 12 : 20)))
#define MG_COFS(br) ((br) == 0 ? 0 : ((br) == 1 ? 512 : ((br) == 2 ? 768 : 1280)))
#define MG_LOAD(q) do { const int br_ = MG_BR(q), kt_ = (q) - MG_Q0(br_), Kb_ = br_ == 1 ? 256 : 512, cf_ = MG_COFS(br_); \
      const int avo_ = (1024 * cf_ + (n0 + crow0) * Kb_ + ccol * 8) * 2, ast_ = 64 * Kb_ * 2; \
      _Pragma("unroll") for (int i = 0; i < 4; ++i) ra[i] = __builtin_amdgcn_raw_buffer_load_b128(arsrc, avo_ + i * ast_, kt_ * 128, 0); \
      _Pragma("unroll") for (int i = 0; i < 2; ++i) rb[i] = __builtin_amdgcn_raw_buffer_load_b128(brsrc, bvo + i * bstep, cf_ * 2 + kt_ * 128, 0); } while (0)
#define MG_STORE(buf) do { char* nb_ = lds + (buf) * STAGE; \
      _Pragma("unroll") for (int i = 0; i < 4; ++i) *(u32x4*)(nb_ + wofs + i * 64 * PITCH) = ra[i]; \
      _Pragma("unroll") for (int i = 0; i < 2; ++i) *(u32x4*)(nb_ + AR * PITCH + wofs + i * 64 * PITCH) = rb[i]; } while (0)
#define MG_GATES(br) do { const unsigned char* gb_ = (const unsigned char*)(ws + OFF_GATE) + (br) * 1024 + n0 + wn * 64 + 4 * h; \
      _Pragma("unroll") for (int j = 0; j < 2; ++j) { const unsigned char* gr_ = gb_ + (size_t)(m0 + wm * 64 + j * 32 + r) * 4096; \
        _Pragma("unroll") for (int i = 0; i < 2; ++i) _Pragma("unroll") for (int g = 0; g < 4; ++g) gw[i][j][g] = *(const unsigned*)(gr_ + i * 32 + 8 * g); } } while (0)
    __syncthreads();
    MG_LOAD(0); MG_STORE(0); MG_GATES(0);
    __syncthreads();
#pragma nounroll
    for (int q = 0; q < 28; ++q) {
      const bool more = q + 1 < 28;
      if (more) MG_LOAD(q + 1);
      const char* base = lds + (q & 1) * STAGE;
      bf16x8 afA[2], bfA[2], afB[2], bfB[2];
#pragma unroll
      for (int i = 0; i < 2; ++i) afA[i] = *(const bf16x8*)(base + aoff + i * 32 * PITCH);
#pragma unroll
      for (int j = 0; j < 2; ++j) bfA[j] = *(const bf16x8*)(base + boff + j * 32 * PITCH);
      __builtin_amdgcn_sched_barrier(0);
#pragma unroll
      for (int s2 = 0; s2 < 4; s2 += 2) {
#pragma unroll
        for (int i = 0; i < 2; ++i) afB[i] = *(const bf16x8*)(base + aoff + i * 32 * PITCH + (s2 + 1) * 32);
#pragma unroll
        for (int j = 0; j < 2; ++j) bfB[j] = *(const bf16x8*)(base + boff + j * 32 * PITCH + (s2 + 1) * 32);
        __builtin_amdgcn_sched_barrier(0);
#pragma unroll
        for (int i = 0; i < 2; ++i)
#pragma unroll
          for (int j = 0; j < 2; ++j) acc[i][j] = MFMA(afA[i], bfA[j], acc[i][j]);
        __builtin_amdgcn_sched_barrier(0);
        if (s2 + 2 < 4) {
#pragma unroll
          for (int i = 0; i < 2; ++i) afA[i] = *(const bf16x8*)(base + aoff + i * 32 * PITCH + (s2 + 2) * 32);
#pragma unroll
          for (int j = 0; j < 2; ++j) bfA[j] = *(const bf16x8*)(base + boff + j * 32 * PITCH + (s2 + 2) * 32);
        }
        __builtin_amdgcn_sched_barrier(0);
#pragma unroll
        for (int i = 0; i < 2; ++i)
#pragma unroll
          for (int j = 0; j < 2; ++j) acc[i][j] = MFMA(afB[i], bfB[j], acc[i][j]);
        __builtin_amdgcn_sched_barrier(0);
      }
      if (q == 7 || q == 11 || q == 19 || q == 27) {
#pragma unroll
        for (int j = 0; j < 2; ++j)
#pragma unroll
          for (int i = 0; i < 2; ++i)
#pragma unroll
            for (int g = 0; g < 4; ++g)
#pragma unroll
              for (int e = 0; e < 4; ++e) {
                mg[i][j][4 * g + e] += (float)((gw[i][j][g] >> (8 * e)) & 255u) * (1.f / 255.f) * acc[i][j][4 * g + e];
                acc[i][j][4 * g + e] = 0.f;
              }
        if (more) { const int nbr = MG_BR(q + 1); MG_GATES(nbr); }
      }
      if (more) MG_STORE((q + 1) & 1);
      __syncthreads();
    }
#undef MG_BR
#undef MG_Q0
#undef MG_COFS
#undef MG_LOAD
#undef MG_STORE
#undef MG_GATES
    store_wave_bf16<2>(mg, merged + (size_t)(m0 + wm * 64) * 1024 + n0 + wn * 64, 1024, lds + wid * WAVE_LDS);
  }
}

__device__ __forceinline__ void phase_proj_res(const u16* Wt, const u16* act, int K, const float* resid, float* xout, char* lds) {
  pg8::Gemm g{act, Wt, CT, DM, K};
  pg8::StaticOrder S; S.init(CT, DM, gridDim.x, blockIdx.x);
  EpiRes E{resid, xout};
  __syncthreads();
  pg8::gemm_phase<EpiRes, pg8::StaticOrder, false>((PG8_LAS unsigned char*)lds, g, S, E, nullptr);
}

__device__ __forceinline__ void phase_ffn_up(const Params& p, int layer, char* lds) {
  char* const ws = lws(p.ws);
  pg8::Gemm g{(const u16*)(ws + OFF_XN), (const u16*)(ws + OFF_WGU) + (size_t)layer * NGU * 1024, CT, NGU, 1024};
  pg8::StaticOrder S; S.init(CT, NGU, gridDim.x, blockIdx.x);
  EpiSwiglu E{(u16*)(ws + OFF_ACT)};
  __syncthreads();
  pg8::gemm_phase<EpiSwiglu, pg8::StaticOrder, false>((PG8_LAS unsigned char*)lds, g, S, E, nullptr);
}

#define XB_TMO      128
#define XB_XCNT(j)  (256  + 64 * (j))
#define XB_XSUB(j)  (1280 + 64 * (j))
#define XB_XGEN(j)  (2304 + 64 * (j))
#define XB_TOP      3328
#define XB_TOPGEN   3392
#define XCD_BAR_WORDS 3456
#define XB_SPIN_CAP (1u << 20)
#define XB_LAS __attribute__((address_space(3)))
DI unsigned xb_ld(unsigned* p) { return __hip_atomic_load(p, __ATOMIC_RELAXED, __HIP_MEMORY_SCOPE_AGENT); }
DI unsigned xb_add(unsigned* p, unsigned v) { return __hip_atomic_fetch_add(p, v, __ATOMIC_RELAXED, __HIP_MEMORY_SCOPE_AGENT); }
DI unsigned xb_xcc_id() { return (unsigned)__builtin_amdgcn_s_getreg((3 << 11) | 20) & 0xFu; }
#define XB_SPIN(cond, bar) do { unsigned _sp = 0; while (cond) { __builtin_amdgcn_s_sleep(1); \
    if ((++_sp & 255u) == 0u) { if (xb_ld(&(bar)[XB_TMO])) break; if (_sp > XB_SPIN_CAP) { atomicAdd(&(bar)[XB_TMO], 1u); break; } } } } while (0)
struct XcdBarrier { unsigned* bar; unsigned x; volatile XB_LAS unsigned* st; };
DI XcdBarrier xcd_barrier_post(unsigned* bar, volatile XB_LAS unsigned* st) {
  XcdBarrier b; b.bar = bar; b.x = xb_xcc_id(); b.st = st;
  if (tidx() == 0) (void)xb_add(&bar[XB_XCNT(b.x)], 1u);
  return b;
}
DI void xcd_barrier_complete(unsigned* bar, unsigned x, unsigned& nloc, unsigned& nx) {
  const unsigned G = gridDim.x;
  unsigned sum, cnt, mine, sp = 0u;
  for (;;) {
    sum = 0u; cnt = 0u; mine = 0u;
#pragma unroll
    for (unsigned j = 0; j < 16; ++j) { const unsigned c = xb_ld(&bar[XB_XCNT(j)]); sum += c; cnt += (c > 0u) ? 1u : 0u; mine = (j == x) ? c : mine; }
    if (sum == G) break;
    __builtin_amdgcn_s_sleep(1);
    if ((++sp & 255u) == 0u) { if (xb_ld(&bar[XB_TMO])) break; if (sp > XB_SPIN_CAP) { atomicAdd(&bar[XB_TMO], 1u); break; } }
  }
  nloc = mine > 0u ? mine : 1u; nx = cnt > 0u ? cnt : 1u;
}
DI void xcd_barrier(const XcdBarrier& b) {
  asm volatile("s_waitcnt vmcnt(0)" ::: "memory");
  __syncthreads();
  if (tidx() == 0) {
    unsigned* bar = b.bar;
    __builtin_amdgcn_s_waitcnt(0);
    unsigned nloc = b.st[0], nx = b.st[1];
    if (nloc == 0u) { xcd_barrier_complete(bar, b.x, nloc, nx); b.st[0] = nloc; b.st[1] = nx; }
    const unsigned old = xb_add(&bar[XB_XSUB(b.x)], 1u);
    const unsigned gen = old / nloc;
    if (old + 1u == (gen + 1u) * nloc) {
      __builtin_amdgcn_fence(__ATOMIC_RELEASE, "agent");
      asm volatile("s_waitcnt vmcnt(0)" ::: "memory");
      const unsigned og = xb_add(&bar[XB_TOP], 1u);
      const unsigned tg = og / nx;
      if (og + 1u == (tg + 1u) * nx) xb_add(&bar[XB_TOPGEN], 1u);
      else XB_SPIN(xb_ld(&bar[XB_TOPGEN]) == tg, bar);
      __builtin_amdgcn_fence(__ATOMIC_ACQUIRE, "agent");
      xb_add(&bar[XB_XGEN(b.x)], 1u);
      asm volatile("s_waitcnt vmcnt(0)" ::: "memory");
    } else {
      XB_SPIN(xb_ld(&bar[XB_XGEN(b.x)]) == gen, bar);
      __builtin_amdgcn_fence(__ATOMIC_ACQUIRE, "agent");
      asm volatile("s_waitcnt vmcnt(0)" ::: "memory");
    }
  }
  __syncthreads();
}

DI void grid_barrier(unsigned* ctr, unsigned target) {
  asm volatile("s_waitcnt vmcnt(0)" ::: "memory");
  __syncthreads();
  if (threadIdx.x == 0) {
    __builtin_amdgcn_fence(__ATOMIC_RELEASE, "agent");
    asm volatile("s_waitcnt vmcnt(0)" ::: "memory");
    __hip_atomic_fetch_add(ctr, 1u, __ATOMIC_RELAXED, __HIP_MEMORY_SCOPE_AGENT);
    unsigned spins = 0;
    while (__hip_atomic_load(ctr, __ATOMIC_RELAXED, __HIP_MEMORY_SCOPE_AGENT) < target && ++spins < (1u << 26)) __builtin_amdgcn_s_sleep(2);
    __builtin_amdgcn_fence(__ATOMIC_ACQUIRE, "agent");
    asm volatile("s_waitcnt vmcnt(0)" ::: "memory");
  }
  __syncthreads();
}

extern "C" __global__ void __launch_bounds__(512, 2) mega(Params p) {
  extern __shared__ __attribute__((aligned(16))) char lds[];
  cg::grid_group grid = cg::this_grid();
  unsigned* const barp = (unsigned*)(p.ws + OFF_BAR);
  unsigned nbar = 0;
#define PWS lws(p.ws)
#define POUT ((float*)lws((char*)p.out))
  volatile XB_LAS unsigned* xst = (volatile XB_LAS unsigned*)(lds + (LDS_BYTES - 16));
  if (tidx() == 0) { xst[0] = 0u; xst[1] = 0u; }
  phase_w(p, lds);
  grid.sync();
  const XcdBarrier xb = xcd_barrier_post(barp, xst);
#pragma nounroll
  for (int ch = 0; ch < NCH; ++ch) {
#pragma nounroll
    for (int layer = 0; layer < DEPTH; ++layer) {
      {
        const float* xin = ch == 0 ? p.in[0] : p.in[1] + (size_t)(ch - 1) * CT * DM;
        const float* xcur = layer == 0 ? xin : POUT + (size_t)ch * CT * DM;
        phase_norm(xcur, p.in[2] + layer * DM, (u16*)(PWS + OFF_XN));
      }
      xcd_barrier(xb);
      phase_p1(p, layer, lds);
      xcd_barrier(xb);
      phase_p1c(p, layer, lds);
      xcd_barrier(xb);
#pragma nounroll
      for (int it = blockIdx.x; it < 1280; it += gridDim.x) {
        if (it < 256) attn_A(p, layer, it, lds);
        else if (it < 512) attn_C(p, layer, it - 256, lds);
        else if (it < 768) attn_D(p, layer, it - 512, lds);
        else attn_B(p, layer, it - 768, lds);
      }
      xcd_barrier(xb);
      phase_merge(p, layer, lds);
      xcd_barrier(xb);
      {
        const float* xin = ch == 0 ? p.in[0] : p.in[1] + (size_t)(ch - 1) * CT * DM;
        float* xo = POUT + (size_t)ch * CT * DM;
        const float* xcur = layer == 0 ? xin : xo;
        phase_proj_res((const u16*)(PWS + OFF_WO) + (size_t)layer * 1024 * 1024, (const u16*)(PWS + OFF_MERGED), 1024, xcur, xo, lds);
      }
      xcd_barrier(xb);
      {
        phase_norm(POUT + (size_t)ch * CT * DM, p.in[25] + layer * DM, (u16*)(PWS + OFF_XN));
      }
      xcd_barrier(xb);
      phase_ffn_up(p, layer, lds);
      xcd_barrier(xb);
      {
        float* xo = POUT + (size_t)ch * CT * DM;
        phase_proj_res((const u16*)(PWS + OFF_WDN) + (size_t)layer * 1024 * DFF, (const u16*)(PWS + OFF_ACT), DFF, xo, xo, lds);
      }
      xcd_barrier(xb);
    }
  }
}

extern "C" void kernel_launch(void* const* d_in, const int* in_sizes, int n_in, void* d_out, int out_size, void* d_ws, size_t ws_size, hipStream_t stream) {
  static int grid_blocks = 0;
  if (!grid_blocks) {
    int dev = 0, cus = 0, per_cu = 0;
    (void)hipGetDevice(&dev);
    (void)hipDeviceGetAttribute(&cus, hipDeviceAttributeMultiprocessorCount, dev);
    (void)hipFuncSetAttribute((const void*)mega, hipFuncAttributeMaxDynamicSharedMemorySize, (int)LDS_BYTES);
    (void)hipOccupancyMaxActiveBlocksPerMultiprocessor(&per_cu, mega, 512, LDS_BYTES);
    if (per_cu < 1) fprintf(stderr, "kernel_launch: occupancy query returned %d\n", per_cu);
    grid_blocks = cus > 0 ? cus : 256;
    if (ws_size < WS_END) fprintf(stderr, "kernel_launch: workspace too small: %zu < %zu\n", ws_size, (size_t)WS_END);
  }
  Params p{};
  for (int i = 0; i < 29; ++i) p.in[i] = (const float*)d_in[i];
  p.out = (float*)d_out;
  p.ws = (char*)d_ws;
  for (int i = 0; i < 32; ++i) p.inv64[i] = (float)pow(10000.0, -(double)i / 32.0);
  for (int i = 0; i < 16; ++i) p.inv32[i] = (float)pow(10000.0, -(double)i / 16.0);
  for (int l = 0; l < 2; ++l) {
    double li = 0.8 - 0.6 * exp(-0.3 * (double)l);
    p.lam_init[l] = (float)li;
    p.oml[l] = (float)(1.0 - li);
  }
  void* args[] = {&p};
  hipError_t e = hipLaunchCooperativeKernel((void*)mega, dim3(grid_blocks), dim3(512), args, LDS_BYTES, stream);
  if (e != hipSuccess) fprintf(stderr, "cooperative launch failed: %s (grid %d)\n", hipGetErrorString(e), grid_blocks);
}
```

```cpp
#include <hip/hip_runtime.h>
#include <hip/hip_cooperative_groups.h>
#include <cstdio>
#include <cmath>
namespace cg = cooperative_groups;

typedef unsigned short u16;
typedef short bf16x8 __attribute__((ext_vector_type(8)));
typedef short s16x4 __attribute__((ext_vector_type(4)));
typedef float f32x16 __attribute__((ext_vector_type(16)));
typedef float f32x4 __attribute__((ext_vector_type(4)));
typedef float f32x2 __attribute__((ext_vector_type(2)));
typedef unsigned u32x4 __attribute__((ext_vector_type(4)));
typedef unsigned u32x2 __attribute__((ext_vector_type(2)));
typedef __bf16 bf16x2_t __attribute__((ext_vector_type(2)));

#define DI __device__ __forceinline__
#define MFMA(a, b, c) __builtin_amdgcn_mfma_f32_32x32x16_bf16(a, b, c, 0, 0, 0)

constexpr int DM = 1024, SEQ = 4096, CT = 16384, NCH = 3, NINP = 5120, DFF = 2816, NGU = 5632, NIN2 = 9216;
constexpr int QKVC_LD = 2048, OUT_LD = 1792, DEPTH = 2;
constexpr float LOG2E = 1.4426950408889634f;
constexpr float QS64 = 0.125f * LOG2E, QS96 = 0.10206207261596575f * LOG2E;
constexpr float EPS = 1e-6f;
constexpr int PITCH = 144;
constexpr int WAVE_LDS = 17408;
constexpr size_t LDS_BYTES = 155648;

constexpr size_t al256(size_t x) { return (x + 255) / 256 * 256; }
constexpr size_t OFF_WIN = 0;
constexpr size_t OFF_WGATE = OFF_WIN + al256((size_t)DEPTH * NIN2 * 1024 * 2);
constexpr size_t OFF_WUQ = OFF_WGATE + 256;
constexpr size_t OFF_WUKV = OFF_WUQ + al256((size_t)DEPTH * 768 * 256 * 2);
constexpr size_t OFF_WBR = OFF_WUKV + al256((size_t)DEPTH * 1024 * 128 * 2);
constexpr size_t OFF_WO = OFF_WBR + al256((size_t)DEPTH * 1024 * 1792 * 2);
constexpr size_t OFF_WGU = OFF_WO + al256((size_t)DEPTH * 1024 * 1024 * 2);
constexpr size_t OFF_WDN = OFF_WGU + al256((size_t)DEPTH * NGU * 1024 * 2);
constexpr size_t OFF_COS64 = OFF_WDN + al256((size_t)DEPTH * 1024 * DFF * 2);
constexpr size_t OFF_SIN64 = OFF_COS64 + (size_t)SEQ * 32 * 4;
constexpr size_t OFF_COS32 = OFF_SIN64 + (size_t)SEQ * 32 * 4;
constexpr size_t OFF_SIN32 = OFF_COS32 + (size_t)SEQ * 16 * 4;
constexpr size_t OFF_LAM = OFF_SIN32 + (size_t)SEQ * 16 * 4;
constexpr size_t OFF_BAR = OFF_LAM + 256;
constexpr size_t OFF_XN = OFF_BAR + 16384;
constexpr size_t OFF_QKV = OFF_XN + (size_t)CT * 1024 * 2;
constexpr size_t OFF_QKVC = OFF_QKV + (size_t)CT * NINP * 2;
constexpr size_t OFF_OUTS = OFF_QKVC + (size_t)CT * QKVC_LD * 2;
constexpr size_t OFF_BO = OFF_OUTS + (size_t)CT * OUT_LD * 2;
constexpr size_t OFF_BLSE = OFF_BO + (size_t)3 * CT * 256 * 2;
constexpr size_t OFF_GATE = OFF_BLSE + (size_t)3 * CT * 4 * 4;
constexpr size_t WS_END = OFF_GATE + (size_t)CT * 4096;
constexpr size_t OFF_MERGED = OFF_QKV;
constexpr size_t OFF_ACT = OFF_QKV + (size_t)CT * 1024 * 2;

struct Params {
  const float* in[29];
  float* out;
  char* ws;
  float inv64[32];
  float inv32[16];
  float lam_init[2];
  float oml[2];
  int pad[2];
};

DI int crow(int reg, int h) { return (reg & 3) + 8 * (reg >> 2) + 4 * h; }
DI unsigned cvtpk(float lo, float hi) {
  f32x2 f = {lo, hi};
  bf16x2_t b = __builtin_convertvector(f, bf16x2_t);
  return __builtin_bit_cast(unsigned, b);
}
DI float bflo(unsigned u) { return __uint_as_float(u << 16); }
DI float bfhi(unsigned u) { return __uint_as_float(u & 0xffff0000u); }
DI float swapadd(float x) {
  auto rr = __builtin_amdgcn_permlane32_swap(__float_as_uint(x), __float_as_uint(x), false, false);
  return __uint_as_float(rr[0]) + __uint_as_float(rr[1]);
}
DI float swapmax(float x) {
  auto rr = __builtin_amdgcn_permlane32_swap(__float_as_uint(x), __float_as_uint(x), false, false);
  return fmaxf(__uint_as_float(rr[0]), __uint_as_float(rr[1]));
}
DI int opaque(int x) { asm volatile("" : "+v"(x)); return x; }
DI int tidx() { return opaque((int)threadIdx.x); }
DI int wave_id() { return __builtin_amdgcn_readfirstlane(tidx() >> 6); }
DI char* lws(char* w) { asm volatile("" : "+s"(w)); return w; }
DI void lds_fence() { asm volatile("s_waitcnt lgkmcnt(0)" ::: "memory"); }
DI void tile_map(int t, int& nt, int& mt) {
  int round = t >> 8, b = t & 255, xcd = b & 7, slot = b >> 3;
  nt = round * 2 + (slot & 1);
  mt = xcd * 16 + (slot >> 1);
}

template <int NB, int AN = NB, bool LOWREG = false>
DI void gemm_core(f32x16 (&acc)[AN][2], const u16* __restrict__ Ag, int lda, const u16* __restrict__ Bg, int ldb, int K, char* lds) {
  constexpr int AR = 128 * NB;
  constexpr int ACH = AR * 8 / 512;
  constexpr int STAGE = (AR + 128) * PITCH;
  const int tid = tidx(), lane = tid & 63, wid = wave_id(), r = lane & 31, h = lane >> 5;
  const int wn = wid & 3, wm = wid >> 2;
  const int crow0 = tid >> 3, ccol = tid & 7;
  const __amdgpu_buffer_rsrc_t arsrc = __builtin_amdgcn_make_buffer_rsrc((void*)Ag, 0, 0x7fffffff, 0x00020000);
  const __amdgpu_buffer_rsrc_t brsrc = __builtin_amdgcn_make_buffer_rsrc((void*)Bg, 0, 0x7fffffff, 0x00020000);
  const int avo = (crow0 * lda + ccol * 8) * 2, bvo = (crow0 * ldb + ccol * 8) * 2;
  const int astep = 64 * lda * 2, bstep = 64 * ldb * 2;
  const int wofs = crow0 * PITCH + ccol * 16;
  const int aoff = (wn * 32 * NB + r) * PITCH + h * 16;
  const int boff = AR * PITCH + (wm * 64 + r) * PITCH + h * 16;
  const int nk = K >> 6;
  u32x4 ra[ACH], rb[2];
#pragma unroll
  for (int i = 0; i < NB; ++i)
#pragma unroll
    for (int j = 0; j < 2; ++j)
#pragma unroll
      for (int e = 0; e < 16; ++e) acc[i][j][e] = 0.f;
  __syncthreads();
#pragma unroll
  for (int i = 0; i < ACH; ++i) ra[i] = __builtin_amdgcn_raw_buffer_load_b128(arsrc, avo + i * astep, 0, 0);
#pragma unroll
  for (int i = 0; i < 2; ++i) rb[i] = __builtin_amdgcn_raw_buffer_load_b128(brsrc, bvo + i * bstep, 0, 0);
#pragma unroll
  for (int i = 0; i < ACH; ++i) *(u32x4*)(lds + wofs + i * 64 * PITCH) = ra[i];
#pragma unroll
  for (int i = 0; i < 2; ++i) *(u32x4*)(lds + AR * PITCH + wofs + i * 64 * PITCH) = rb[i];
  __syncthreads();
#pragma nounroll
  for (int kt = 0; kt < nk; ++kt) {
    const bool more = kt + 1 < nk;
    if (more) {
#pragma unroll
      for (int i = 0; i < ACH; ++i) ra[i] = __builtin_amdgcn_raw_buffer_load_b128(arsrc, avo + i * astep, (kt + 1) * 128, 0);
#pragma unroll
      for (int i = 0; i < 2; ++i) rb[i] = __builtin_amdgcn_raw_buffer_load_b128(brsrc, bvo + i * bstep, (kt + 1) * 128, 0);
    }
    const char* base = lds + (kt & 1) * STAGE;
    if (LOWREG) {
#pragma unroll
      for (int s = 0; s < 4; ++s) {
        bf16x8 af[NB], bfr[2];
#pragma unroll
        for (int i = 0; i < NB; ++i) af[i] = *(const bf16x8*)(base + aoff + i * 32 * PITCH + s * 32);
#pragma unroll
        for (int j = 0; j < 2; ++j) bfr[j] = *(const bf16x8*)(base + boff + j * 32 * PITCH + s * 32);
#pragma unroll
        for (int i = 0; i < NB; ++i)
#pragma unroll
          for (int j = 0; j < 2; ++j) acc[i][j] = MFMA(af[i], bfr[j], acc[i][j]);
      }
    } else {
    bf16x8 afA[NB], bfA[2], afB[NB], bfB[2];
#pragma unroll
    for (int i = 0; i < NB; ++i) afA[i] = *(const bf16x8*)(base + aoff + i * 32 * PITCH);
#pragma unroll
    for (int j = 0; j < 2; ++j) bfA[j] = *(const bf16x8*)(base + boff + j * 32 * PITCH);
    __builtin_amdgcn_sched_barrier(0);
#pragma unroll
    for (int s = 0; s < 4; s += 2) {
#pragma unroll
      for (int i = 0; i < NB; ++i) afB[i] = *(const bf16x8*)(base + aoff + i * 32 * PITCH + (s + 1) * 32);
#pragma unroll
      for (int j = 0; j < 2; ++j) bfB[j] = *(const bf16x8*)(base + boff + j * 32 * PITCH + (s + 1) * 32);
      __builtin_amdgcn_sched_barrier(0);
#pragma unroll
      for (int i = 0; i < NB; ++i)
#pragma unroll
        for (int j = 0; j < 2; ++j) acc[i][j] = MFMA(afA[i], bfA[j], acc[i][j]);
      __builtin_amdgcn_sched_barrier(0);
      if (s + 2 < 4) {
#pragma unroll
        for (int i = 0; i < NB; ++i) afA[i] = *(const bf16x8*)(base + aoff + i * 32 * PITCH + (s + 2) * 32);
#pragma unroll
        for (int j = 0; j < 2; ++j) bfA[j] = *(const bf16x8*)(base + boff + j * 32 * PITCH + (s + 2) * 32);
      }
      __builtin_amdgcn_sched_barrier(0);
#pragma unroll
      for (int i = 0; i < NB; ++i)
#pragma unroll
        for (int j = 0; j < 2; ++j) acc[i][j] = MFMA(afB[i], bfB[j], acc[i][j]);
      __builtin_amdgcn_sched_barrier(0);
    }
    }
    if (more) {
      char* nb = lds + ((kt + 1) & 1) * STAGE;
#pragma unroll
      for (int i = 0; i < ACH; ++i) *(u32x4*)(nb + wofs + i * 64 * PITCH) = ra[i];
#pragma unroll
      for (int i = 0; i < 2; ++i) *(u32x4*)(nb + AR * PITCH + wofs + i * 64 * PITCH) = rb[i];
    }
    __syncthreads();
  }
}

template <int NB, int AN = NB>
DI void store_wave_bf16(const f32x16 (&v)[AN][2], u16* __restrict__ wdst, int ldd, char* wl) {
  constexpr int TP = NB * 64 + 16;
  const int lane = (tidx() & 63), r = lane & 31, h = lane >> 5;
#pragma unroll
  for (int i = 0; i < NB; ++i)
#pragma unroll
    for (int j = 0; j < 2; ++j)
#pragma unroll
      for (int g = 0; g < 4; ++g) {
        u32x2 w = {cvtpk(v[i][j][4 * g], v[i][j][4 * g + 1]), cvtpk(v[i][j][4 * g + 2], v[i][j][4 * g + 3])};
        *(u32x2*)(wl + (j * 32 + r) * TP + (i * 32 + 8 * g + 4 * h) * 2) = w;
      }
  lds_fence();
  constexpr int CPR = NB * 4;
#pragma unroll
  for (int it = 0; it < CPR; ++it) {
    int c = lane + 64 * it, row = c / CPR, ch = c % CPR;
    u32x4 d = *(const u32x4*)(wl + row * TP + ch * 16);
    *(u32x4*)(wdst + (size_t)row * ldd + ch * 8) = d;
  }
  lds_fence();
}

DI void store_wave_f32_res(const f32x16 (&v)[2][2], const float* __restrict__ res, float* __restrict__ wdst, char* wl) {
  constexpr int TP = 272;
  const int lane = (tidx() & 63), r = lane & 31, h = lane >> 5;
#pragma unroll
  for (int i = 0; i < 2; ++i)
#pragma unroll
    for (int j = 0; j < 2; ++j)
#pragma unroll
      for (int g = 0; g < 4; ++g) {
        f32x4 w = {v[i][j][4 * g], v[i][j][4 * g + 1], v[i][j][4 * g + 2], v[i][j][4 * g + 3]};
        *(f32x4*)(wl + (j * 32 + r) * TP + (i * 32 + 8 * g + 4 * h) * 4) = w;
      }
  lds_fence();
#pragma unroll
  for (int it = 0; it < 16; ++it) {
    int c = lane + 64 * it, row = c >> 4, ch = c & 15;
    f32x4 d = *(const f32x4*)(wl + row * TP + ch * 16);
    f32x4 x = *(const f32x4*)(res + (size_t)row * DM + ch * 4);
    d += x;
    *(f32x4*)(wdst + (size_t)row * DM + ch * 4) = d;
  }
  lds_fence();
}

DI void norm_rope64(f32x16 (&v)[2][2], const float* __restrict__ gain, float scale, int pos0, const float* __restrict__ cs, const float* __restrict__ sn) {
  const int lane = (tidx() & 63), r = lane & 31, h = lane >> 5;
#pragma unroll
  for (int j = 0; j < 2; ++j) {
    float ss = 0.f;
#pragma unroll
    for (int e = 0; e < 16; ++e) ss += v[0][j][e] * v[0][j][e] + v[1][j][e] * v[1][j][e];
    ss = swapadd(ss);
    const float rstd = __builtin_amdgcn_rsqf(ss * (1.f / 64.f) + EPS);
    const int pos = pos0 + j * 32 + r;
#pragma unroll
    for (int g = 0; g < 4; ++g) {
      const int d = 8 * g + 4 * h;
      f32x4 c4 = *(const f32x4*)(cs + pos * 32 + d), s4 = *(const f32x4*)(sn + pos * 32 + d);
      f32x4 g1 = *(const f32x4*)(gain + d), g2 = *(const f32x4*)(gain + 32 + d);
#pragma unroll
      for (int e = 0; e < 4; ++e) {
        float x1 = v[0][j][4 * g + e] * rstd * g1[e], x2 = v[1][j][4 * g + e] * rstd * g2[e];
        v[0][j][4 * g + e] = (x1 * c4[e] - x2 * s4[e]) * scale;
        v[1][j][4 * g + e] = (x2 * c4[e] + x1 * s4[e]) * scale;
      }
    }
  }
}

DI void norm96_rope_store(f32x16 (&v)[3][2], const float* __restrict__ gain, float scale, int pos0, const float* __restrict__ cs, const float* __restrict__ sn,
                          u16* __restrict__ wdst, char* wl) {
  const int lane = (tidx() & 63), r = lane & 31, h = lane >> 5;
#pragma unroll
  for (int j = 0; j < 2; ++j) {
    float ss = 0.f;
#pragma unroll
    for (int i = 0; i < 3; ++i)
#pragma unroll
      for (int e = 0; e < 16; ++e) ss += v[i][j][e] * v[i][j][e];
    ss = swapadd(ss);
    const float rstd = __builtin_amdgcn_rsqf(ss * (1.f / 96.f) + EPS);
    const int pos = pos0 + j * 32 + r;
#pragma unroll
    for (int i = 0; i < 3; ++i)
#pragma unroll
      for (int g = 0; g < 4; ++g) {
        f32x4 g4 = *(const f32x4*)(gain + i * 32 + 8 * g + 4 * h);
#pragma unroll
        for (int e = 0; e < 4; ++e) v[i][j][4 * g + e] *= rstd * g4[e];
      }
#pragma unroll
    for (int g = 0; g < 2; ++g) {
      f32x4 c4 = *(const f32x4*)(cs + pos * 16 + 8 * g + 4 * h), s4 = *(const f32x4*)(sn + pos * 16 + 8 * g + 4 * h);
#pragma unroll
      for (int e = 0; e < 4; ++e) {
        float a = v[2][j][4 * g + e], b = v[2][j][4 * g + e + 8];
        v[2][j][4 * g + e] = a * c4[e] - b * s4[e];
        v[2][j][4 * g + e + 8] = b * c4[e] + a * s4[e];
      }
    }
#pragma unroll
    for (int i = 0; i < 3; ++i)
#pragma unroll
      for (int e = 0; e < 16; ++e) v[i][j][e] *= scale;
  }
  store_wave_bf16<3>(v, wdst, QKVC_LD, wl);
}

DI float row_ssq(const u16* __restrict__ p, int nchunk) {
  float ss = 0.f;
#pragma unroll 2
  for (int c = 0; c < nchunk; ++c) {
    u32x4 d = *(const u32x4*)(p + c * 8);
    unsigned w[4] = {d[0], d[1], d[2], d[3]};
#pragma unroll
    for (int e = 0; e < 4; ++e) { float a = bflo(w[e]), b = bfhi(w[e]); ss += a * a + b * b; }
  }
  return ss;
}

namespace pg8 {
#define PG8_LAS __attribute__((address_space(3)))
typedef unsigned short bf16_t;
typedef short bf16x8 __attribute__((ext_vector_type(8)));
typedef float f32x4 __attribute__((ext_vector_type(4)));
typedef unsigned u32x4 __attribute__((ext_vector_type(4)));
constexpr int BM = 256, BK = 64, HALF = 128, HTB = HALF * BK * 2  , STAGE_BYTES = 8 * HTB, NXCD = 8, WGM = 8;

__host__ __device__ __forceinline__ int lds_byte(int r, int c) { const int st = (r >> 4) * 2 + (c >> 5), rr = r & 15, cc = c & 31, ob = rr * 64 + cc * 2; return st * 1024 + (ob ^ (((ob >> 9) & 1) << 5)); }
__host__ __device__ __forceinline__ void stage_rc(int b, int& R, int& C) { const int st = b / 1024, sb = b % 1024, swz = sb ^ (((sb >> 9) & 1) << 5); R = (st >> 1) * 16 + swz / 64; C = (st & 1) * 32 + (swz % 64) / 2; }
__host__ __device__ __forceinline__ int perm32(int rho) { const int n = rho >> 4, i = rho & 15; return 8 * (i >> 2) + 4 * n + (i & 3); }

struct Unit { int pm, pn; };
struct Gemm { const bf16_t* A; const bf16_t* Bt; int M, N, K; };
struct StaticOrder {
    int nM, nN, nwg, G, c;
    __host__ __device__ void init(int M, int N, int G_, int c_) { nM = M / BM; nN = N / BM; nwg = nM * nN; G = G_; c = c_; }
    __host__ __device__ bool next(int i, Unit& u) const {
        const long L = (long)i * G + c; if (L >= nwg) return false;
        int wgid = (int)L; { const int q = nwg / NXCD, r = nwg % NXCD, xcd = wgid % NXCD, off = wgid / NXCD; wgid = (xcd < r ? xcd * (q + 1) : r * (q + 1) + (xcd - r) * q) + off; }
        const int nig = WGM * nN, gid = wgid / nig, fm = gid * WGM, gsz = (nM - fm) < WGM ? (nM - fm) : WGM;
        u.pm = fm + ((wgid % nig) % gsz); u.pn = (wgid % nig) / gsz; return true;
    }
    __device__ __forceinline__ void a_ready(const Unit&) const {}
    __device__ __forceinline__ void done(const Unit&) const {}
};
template <class Epi, class Sched, bool STAMP = false>
__device__ __forceinline__ void gemm_phase(PG8_LAS unsigned char* lds, const Gemm g, const Sched& S, const Epi& E, unsigned long long* stamps) {
    const int tid = tidx(), wid = __builtin_amdgcn_readfirstlane(tid >> 6), lane = tid & 63, wr = wid >> 2, wc = wid & 3, fr = lane & 15, fq = lane >> 4;
    const int K = g.K, nt = K / BK;
    int ts_lo = 0, ts_hi = 0, nts = 0; const unsigned long long rt_entry = STAMP ? (unsigned long long)wall_clock64() : 0ull;
#define PG8_STAMP() do { if (STAMP && wid == 0 && nts < 64) { const unsigned long long _c = (unsigned long long)clock64(); \
        ts_lo = (lane == nts) ? (int)(unsigned)_c : ts_lo; ts_hi = (lane == nts) ? (int)(unsigned)(_c >> 32) : ts_hi; ++nts; } } while (0)
    PG8_STAMP();
    unsigned voffA[2], voffB[2];
#pragma unroll
    for (int i = 0; i < 2; ++i) { int R, C; stage_rc(tid * 16 + i * 8192, R, C); const int Rb = Epi::PERM ? ((R & ~31) + perm32(R & 31)) : R;
        voffA[i] = (unsigned)(R * K + C) * 2u; voffB[i] = (unsigned)(Rb * K + C) * 2u; }
    const size_t kstep = (size_t)(BK * 2);
    const size_t hstep = (size_t)HALF * K * 2;
    const size_t tstep = 2 * hstep;
    const unsigned ldsw = (unsigned)wid * 1024u;
    const int aoff = lds_byte(wr * 64 + fr, fq * 8), boff = lds_byte(wc * 32 + fr, fq * 8);
#define PG8_SA(b, h) (((b) * 2 + (h)) * HTB)
#define PG8_SB(b, h) ((4 + (b) * 2 + (h)) * HTB)
#define PG8_STAGE(bufoff, gbase, voff) do { _Pragma("unroll") for (int _i = 0; _i < 2; ++_i) \
        __builtin_amdgcn_global_load_lds((const unsigned*)((const char*)(gbase) + (voff)[_i]), (PG8_LAS unsigned*)(lds + (bufoff) + ldsw + _i * 8192), 16, 0, 0); } while (0)
#define PG8_LDA(dst, b, h) do { _Pragma("unroll") for (int m = 0; m < 4; ++m) _Pragma("unroll") for (int k = 0; k < 2; ++k) dst[m][k] = *(const PG8_LAS bf16x8*)(lds + PG8_SA(b, h) + aoff + m * 2048 + k * 1024); } while (0)
#define PG8_LDB(dst, b, h) do { _Pragma("unroll") for (int n = 0; n < 2; ++n) _Pragma("unroll") for (int k = 0; k < 2; ++k) dst[n][k] = *(const PG8_LAS bf16x8*)(lds + PG8_SB(b, h) + boff + n * 2048 + k * 1024); } while (0)
#define PG8_MMA(ai, bj, At, Bt) do { __builtin_amdgcn_s_setprio(1); _Pragma("unroll") for (int m = 0; m < 4; ++m) _Pragma("unroll") for (int n = 0; n < 2; ++n) _Pragma("unroll") for (int k = 0; k < 2; ++k) \
        acc[ai][bj][m][n] = __builtin_amdgcn_mfma_f32_16x16x32_bf16(Bt[n][k], At[m][k], acc[ai][bj][m][n], 0, 0, 0); __builtin_amdgcn_s_setprio(0); } while (0)
#define PG8_WAIT_V(n) asm volatile("s_waitcnt vmcnt(" #n ")" ::: "memory")
#define PG8_WAIT_L(n) asm volatile("s_waitcnt lgkmcnt(" #n ")" ::: "memory")
#define PG8_BAR __builtin_amdgcn_s_barrier()
#define PG8_SCHED __builtin_amdgcn_sched_barrier(0)
    Unit cur, nxt; int ui = 0;
    if (!S.next(0, cur)) return;
    f32x4 acc[2][2][4][2];
#pragma unroll
    for (int a = 0; a < 2; ++a)
#pragma unroll
        for (int b = 0; b < 2; ++b)
#pragma unroll
            for (int m = 0; m < 4; ++m)
#pragma unroll
                for (int n = 0; n < 2; ++n) acc[a][b][m][n] = (f32x4){0.f, 0.f, 0.f, 0.f};
    bf16x8 At[4][2], B0[2][2], B1[2][2];
    const char* cA = (const char*)g.A + (size_t)cur.pm * tstep; const char* cB = (const char*)g.Bt + (size_t)cur.pn * tstep;
    S.a_ready(cur);
    PG8_STAGE(PG8_SB(0, 0), cB, voffB); PG8_STAGE(PG8_SA(0, 0), cA, voffA); PG8_STAGE(PG8_SB(0, 1), cB + hstep, voffB); PG8_STAGE(PG8_SA(0, 1), cA + hstep, voffA);
    if (wr == 1) PG8_BAR;
    PG8_WAIT_V(4); PG8_BAR;
    PG8_STAGE(PG8_SB(1, 0), cB + kstep, voffB); PG8_STAGE(PG8_SA(1, 0), cA + kstep, voffA); PG8_STAGE(PG8_SB(1, 1), cB + hstep + kstep, voffB);
    PG8_WAIT_V(6); PG8_BAR;
    PG8_STAMP();
    for (;;) {
        const bool has_next = S.next(ui + 1, nxt);
        const char* nA = has_next ? (const char*)g.A + (size_t)nxt.pm * tstep : cA; const char* nB = has_next ? (const char*)g.Bt + (size_t)nxt.pn * tstep : cB;
        for (int t = 0; t < nt; t += 2) {
            const bool last = (t == nt - 2);
            const char* a1 = cA + (size_t)(t + 1) * kstep;
            const char* a2 = last ? nA : cA + (size_t)(t + 2) * kstep; const char* b2 = last ? nB : cB + (size_t)(t + 2) * kstep;
            const char* a3 = a2 + kstep; const char* b3 = b2 + kstep;
            if (last && has_next) S.a_ready(nxt);
            PG8_LDB(B0, 0, 0); PG8_SCHED; PG8_LDA(At, 0, 0); PG8_STAGE(PG8_SA(1, 1), a1 + hstep, voffA);
            PG8_WAIT_L(8); PG8_BAR; PG8_WAIT_L(0); PG8_MMA(0, 0, At, B0); PG8_BAR; PG8_SCHED;
            PG8_LDB(B1, 0, 1); PG8_STAGE(PG8_SB(0, 0), b2, voffB);
            PG8_BAR; PG8_WAIT_L(0); PG8_MMA(0, 1, At, B1); PG8_BAR;
            PG8_LDA(At, 0, 1); PG8_STAGE(PG8_SA(0, 0), a2, voffA);
            PG8_BAR; PG8_WAIT_L(0); PG8_MMA(1, 0, At, B0); PG8_BAR; PG8_SCHED;
            PG8_STAGE(PG8_SB(0, 1), b2 + hstep, voffB);
            PG8_WAIT_V(6); PG8_BAR; PG8_MMA(1, 1, At, B1); PG8_BAR;
            PG8_LDB(B0, 1, 0); PG8_SCHED; PG8_LDA(At, 1, 0); PG8_STAGE(PG8_SA(0, 1), a2 + hstep, voffA);
            PG8_WAIT_L(8); PG8_BAR; PG8_WAIT_L(0); PG8_MMA(0, 0, At, B0); PG8_BAR; PG8_SCHED;
            PG8_LDB(B1, 1, 1); PG8_STAGE(PG8_SB(1, 0), b3, voffB);
            PG8_BAR; PG8_WAIT_L(0); PG8_MMA(0, 1, At, B1); PG8_BAR;
            PG8_LDA(At, 1, 1); PG8_STAGE(PG8_SA(1, 0), a3, voffA);
            PG8_BAR; PG8_WAIT_L(0); PG8_MMA(1, 0, At, B0); PG8_BAR; PG8_SCHED;
            PG8_STAGE(PG8_SB(1, 1), b3 + hstep, voffB);
            PG8_WAIT_V(6); PG8_BAR; PG8_MMA(1, 1, At, B1); PG8_BAR;
        }
        PG8_STAMP();
        if constexpr (!Epi::AFTER_DRAIN) { E(acc, cur, wr, wc, fr, fq); S.done(cur); }
        PG8_STAMP();
        if (!has_next) break;
#pragma unroll
        for (int a = 0; a < 2; ++a)
#pragma unroll
            for (int b = 0; b < 2; ++b)
#pragma unroll
                for (int m = 0; m < 4; ++m)
#pragma unroll
                    for (int n = 0; n < 2; ++n) acc[a][b][m][n] = (f32x4){0.f, 0.f, 0.f, 0.f};
        cur = nxt; cA = nA; cB = nB; ++ui;
    }
    PG8_WAIT_V(0);
    if (wr == 0) PG8_BAR;
    PG8_BAR;
    if constexpr (Epi::AFTER_DRAIN) { E.fused(acc, cur, wr, wc, fr, fq, lds, wid, lane); S.done(cur); }
    PG8_STAMP();
    if (STAMP && wid == 0) { stamps[lane] = lane < nts ? (((unsigned long long)(unsigned)ts_hi << 32) | (unsigned)ts_lo) : 0ull;
        if (lane == 62) stamps[62] = rt_entry; if (lane == 63) stamps[63] = (unsigned long long)wall_clock64(); }
#undef PG8_STAMP
#undef PG8_SA
#undef PG8_SB
#undef PG8_STAGE
#undef PG8_LDA
#undef PG8_LDB
#undef PG8_MMA
#undef PG8_WAIT_V
#undef PG8_WAIT_L
#undef PG8_BAR
#undef PG8_SCHED
}
}

DI float quadsum(float x) {
  auto rr = __builtin_amdgcn_permlane16_swap(__float_as_uint(x), __float_as_uint(x), false, false);
  x = __uint_as_float(rr[0]) + __uint_as_float(rr[1]);
  return swapadd(x);
}
struct EpiP1 {
  static constexpr bool PERM = true, AFTER_DRAIN = false;
  u16* qkv; const float* cs; const float* sn; const float* const* in; int layer; unsigned char* gate;
  DI void operator()(const pg8::f32x4 (&acc)[2][2][4][2], const pg8::Unit& u, int wr, int wc, int fr_, int fq_) const {
    const int lane = tidx() & 63, fr = lane & 15, fq = lane >> 4;
    if (u.pn >= 20) {
#pragma unroll
      for (int ai = 0; ai < 2; ++ai)
#pragma unroll
        for (int m = 0; m < 4; ++m) {
          const int row = u.pm * 256 + ai * 128 + wr * 64 + m * 16 + fr;
          unsigned char* gp = gate + (size_t)row * 4096 + (u.pn - 20) * 256 + wc * 32 + 8 * fq;
#pragma unroll
          for (int bj = 0; bj < 2; ++bj) {
            unsigned w2[2];
#pragma unroll
            for (int n = 0; n < 2; ++n) {
              unsigned wv = 0u;
#pragma unroll
              for (int e = 0; e < 4; ++e) {
                const float sg = __builtin_amdgcn_rcpf(1.f + __builtin_amdgcn_exp2f(-acc[ai][bj][m][n][e] * LOG2E));
                wv |= ((unsigned)(sg * 255.f + 0.5f)) << (8 * e);
              }
              w2[n] = wv;
            }
            u32x2 wq = {w2[0], w2[1]};
            *(u32x2*)(gp + bj * 128) = wq;
          }
        }
      return;
    }
    const int n64 = u.pn * 4 + wc;
    const float* gain = nullptr; float scale = 1.f;
    if (n64 < 8) { gain = in[5] + layer * 64; scale = QS64; }
    else if (n64 < 16) { gain = in[6] + layer * 64; }
    else if (n64 < 24) {}
    else if (n64 < 60) {
      int tt = n64 - 24, g = tt / 12, jj = (tt % 12) >> 2;
      if (jj == 0) { gain = in[9] + (layer * 3 + g) * 64; scale = QS64; }
      else if (jj == 1) { gain = in[10] + (layer * 3 + g) * 64; }
    }
    else if (n64 < 68) { gain = in[17] + layer * 64; scale = QS64; }
    else if (n64 < 70) { gain = in[18] + layer * 64; }
#pragma unroll
    for (int ai = 0; ai < 2; ++ai)
#pragma unroll
      for (int m = 0; m < 4; ++m) {
        const int row = u.pm * 256 + ai * 128 + wr * 64 + m * 16 + fr;
        f32x4 v[2][2];
#pragma unroll
        for (int bj = 0; bj < 2; ++bj)
#pragma unroll
          for (int n = 0; n < 2; ++n) v[bj][n] = acc[ai][bj][m][n];
        if (gain) {
          float ss = 0.f;
#pragma unroll
          for (int bj = 0; bj < 2; ++bj)
#pragma unroll
            for (int n = 0; n < 2; ++n)
#pragma unroll
              for (int e = 0; e < 4; ++e) ss += v[bj][n][e] * v[bj][n][e];
          ss = quadsum(ss);
          const float rstd = __builtin_amdgcn_rsqf(ss * (1.f / 64.f) + EPS);
          const int pos = row & (SEQ - 1);
#pragma unroll
          for (int n = 0; n < 2; ++n) {
            const int d = 8 * fq + 4 * n;
            f32x4 c4 = *(const f32x4*)(cs + pos * 32 + d), s4 = *(const f32x4*)(sn + pos * 32 + d);
            f32x4 g1 = *(const f32x4*)(gain + d), g2 = *(const f32x4*)(gain + 32 + d);
#pragma unroll
            for (int e = 0; e < 4; ++e) {
              float x1 = v[0][n][e] * rstd * g1[e], x2 = v[1][n][e] * rstd * g2[e];
              v[0][n][e] = (x1 * c4[e] - x2 * s4[e]) * scale;
              v[1][n][e] = (x2 * c4[e] + x1 * s4[e]) * scale;
            }
          }
        }
        u16* rowp = qkv + (size_t)row * NINP + n64 * 64 + 8 * fq;
#pragma unroll
        for (int bj = 0; bj < 2; ++bj) {
          u32x4 w = {cvtpk(v[bj][0][0], v[bj][0][1]), cvtpk(v[bj][0][2], v[bj][0][3]), cvtpk(v[bj][1][0], v[bj][1][1]), cvtpk(v[bj][1][2], v[bj][1][3])};
          *(u32x4*)(rowp + bj * 32) = w;
        }
      }
  }
};
struct EpiRes {
  static constexpr bool PERM = false, AFTER_DRAIN = false;
  const float* resid; float* out;
  DI void operator()(const pg8::f32x4 (&acc)[2][2][4][2], const pg8::Unit& u, int wr, int wc, int fr_, int fq_) const {
    const int lane = tidx() & 63, fr = lane & 15, fq = lane >> 4;
#pragma unroll
    for (int ai = 0; ai < 2; ++ai)
#pragma unroll
      for (int m = 0; m < 4; ++m) {
        const size_t o = (size_t)(u.pm * 256 + ai * 128 + wr * 64 + m * 16 + fr) * DM + u.pn * 256 + wc * 32 + 4 * fq;
#pragma unroll
        for (int bj = 0; bj < 2; ++bj)
#pragma unroll
          for (int n = 0; n < 2; ++n) {
            f32x4 x = *(const f32x4*)(resid + o + bj * 128 + n * 16);
            *(f32x4*)(out + o + bj * 128 + n * 16) = x + acc[ai][bj][m][n];
          }
      }
  }
};
struct EpiSwiglu {
  static constexpr bool PERM = true, AFTER_DRAIN = false;
  u16* act;
  DI void operator()(const pg8::f32x4 (&acc)[2][2][4][2], const pg8::Unit& u, int wr, int wc, int fr_, int fq_) const {
    const int lane = tidx() & 63, fr = lane & 15, fq = lane >> 4;
#pragma unroll
    for (int ai = 0; ai < 2; ++ai)
#pragma unroll
      for (int m = 0; m < 4; ++m) {
        const int row = u.pm * 256 + ai * 128 + wr * 64 + m * 16 + fr;
        float a[8];
#pragma unroll
        for (int n = 0; n < 2; ++n)
#pragma unroll
          for (int e = 0; e < 4; ++e) {
            float gte = acc[ai][0][m][n][e];
            a[4 * n + e] = gte * __builtin_amdgcn_rcpf(1.f + __builtin_amdgcn_exp2f(-gte * LOG2E)) * acc[ai][1][m][n][e];
          }
        u32x4 w = {cvtpk(a[0], a[1]), cvtpk(a[2], a[3]), cvtpk(a[4], a[5]), cvtpk(a[6], a[7])};
        *(u32x4*)(act + (size_t)row * DFF + u.pn * 128 + wc * 32 + 8 * fq) = w;
      }
  }
};

DI void repack_tile(const float* __restrict__ src, const float* __restrict__ src2, int nsrc, u16* __restrict__ dst, int K, int n0, int k0, int mode,
                    const float* __restrict__ gain, char* lds) {
  float* tile = (float*)lds;
  const int tid = tidx();
  {
    const int nn = tid & 63, kk0 = tid >> 6;
    const int np = n0 + nn;
    const float* s = src; int col = np; bool valid = true;
    if (mode == 1) {
      const int rho = np & 255, lg = ((np >> 8) * 4 + ((rho >> 5) & 3)) * 64 + 32 * (rho >> 7) + (rho & 31);
      if (lg < 3840) col = lg; else if (lg < 4608) col = 4256 + (lg - 3840); else if (lg < 5024) col = 3840 + (lg - 4608); else valid = false;
    } else if (mode == 2) {
      const int rho = np & 255;
      col = (np >> 8) * 128 + (rho & 127);
      if (rho >= 128) s = src2;
    }
#pragma unroll
    for (int i = 0; i < 8; ++i) {
      int kk = kk0 + 8 * i;
      float v = valid ? s[(size_t)(k0 + kk) * nsrc + col] : 0.f;
      if (gain) v *= gain[k0 + kk];
      tile[kk * 65 + nn] = v;
    }
  }
  __syncthreads();
  {
    const int n = tid >> 3, kc = (tid & 7) * 8;
    float f[8];
#pragma unroll
    for (int i = 0; i < 8; ++i) f[i] = tile[(kc + i) * 65 + n];
    u32x4 w = {cvtpk(f[0], f[1]), cvtpk(f[2], f[3]), cvtpk(f[4], f[5]), cvtpk(f[6], f[7])};
    *(u32x4*)(dst + (size_t)(n0 + n) * K + k0 + kc) = w;
  }
  __syncthreads();
}

DI void sincos_acc(float ang, float& c, float& s) {
  double a = (double)ang;
  double t = a * 0.15915494309189535;
  double fr = t - rint(t);
  double x = fr * 6.283185307179586;
  double x2 = x * x;
  double ts = x, tc = 1.0, ssum = x, csum = 1.0;
  for (int n = 1; n <= 14; ++n) {
    tc *= -x2 / (double)((2 * n - 1) * (2 * n));
    ts *= -x2 / (double)((2 * n) * (2 * n + 1));
    csum += tc; ssum += ts;
  }
  c = (float)csum; s = (float)ssum;
}

__device__ __forceinline__ void phase_w(const Params& p, char* lds) {
  char* const ws = lws(p.ws);
  constexpr int PER_LAYER = 5200;
  for (int t = blockIdx.x; t < PER_LAYER * DEPTH; t += gridDim.x) {
    const int l = t / PER_LAYER; int u = t % PER_LAYER;
    if (u < 1280) {
      repack_tile(p.in[3] + (size_t)l * 1024 * 5024, nullptr, 5024, (u16*)(ws + OFF_WIN) + (size_t)l * NIN2 * 1024, 1024, (u >> 4) * 64, (u & 15) * 64, 1, nullptr, lds);
      continue;
    }
    u -= 1280;
    if (u < 1024) {
      repack_tile(p.in[4] + (size_t)l * 1024 * 4096, nullptr, 4096, (u16*)(ws + OFF_WIN) + ((size_t)l * NIN2 + NINP) * 1024, 1024, (u >> 4) * 64, (u & 15) * 64, 0, nullptr, lds);
      continue;
    }
    u -= 1024;
    if (u < 48) {
      repack_tile(p.in[13] + (size_t)l * 256 * 768, nullptr, 768, (u16*)(ws + OFF_WUQ) + (size_t)l * 768 * 256, 256, (u >> 2) * 64, (u & 3) * 64, 0, p.in[11] + l * 256, lds);
      continue;
    }
    u -= 48;
    if (u < 32) {
      repack_tile(p.in[14] + (size_t)l * 128 * 1024, nullptr, 1024, (u16*)(ws + OFF_WUKV) + (size_t)l * 1024 * 128, 128, (u >> 1) * 64, (u & 1) * 64, 0, p.in[12] + l * 128, lds);
      continue;
    }
    u -= 32;
    if (u < 448) {
      u16* wbr = (u16*)(ws + OFF_WBR) + (size_t)l * 1024 * 1792;
      if (u < 128) repack_tile(p.in[20] + (size_t)l * 512 * 1024, nullptr, 1024, wbr, 512, (u >> 3) * 64, (u & 7) * 64, 0, nullptr, lds);
      else if (u < 192) { u -= 128; repack_tile(p.in[21] + (size_t)l * 256 * 1024, nullptr, 1024, wbr + 1024 * 512, 256, (u >> 2) * 64, (u & 3) * 64, 0, nullptr, lds); }
      else if (u < 320) { u -= 192; repack_tile(p.in[22] + (size_t)l * 512 * 1024, nullptr, 1024, wbr + 1024 * 768, 512, (u >> 3) * 64, (u & 7) * 64, 0, nullptr, lds); }
      else { u -= 320; repack_tile(p.in[23] + (size_t)l * 512 * 1024, nullptr, 1024, wbr + 1024 * 1280, 512, (u >> 3) * 64, (u & 7) * 64, 0, nullptr, lds); }
      continue;
    }
    u -= 448;
    if (u < 256) {
      repack_tile(p.in[24] + (size_t)l * 1024 * 1024, nullptr, 1024, (u16*)(ws + OFF_WO) + (size_t)l * 1024 * 1024, 1024, (u >> 4) * 64, (u & 15) * 64, 0, nullptr, lds);
      continue;
    }
    u -= 256;
    if (u < 1408) {
      repack_tile(p.in[26] + (size_t)l * 1024 * DFF, p.in[27] + (size_t)l * 1024 * DFF, DFF, (u16*)(ws + OFF_WGU) + (size_t)l * NGU * 1024, 1024, (u >> 4) * 64, (u & 15) * 64, 2, nullptr, lds);
      continue;
    }
    u -= 1408;
    repack_tile(p.in[28] + (size_t)l * DFF * 1024, nullptr, 1024, (u16*)(ws + OFF_WDN) + (size_t)l * 1024 * DFF, DFF, (u / 44) * 64, (u % 44) * 64, 0, nullptr, lds);
  }
  const int gt = blockIdx.x * 512 + tidx(), ngt = gridDim.x * 512;
  float* c64 = (float*)(ws + OFF_COS64); float* s64 = (float*)(ws + OFF_SIN64);
  float* c32 = (float*)(ws + OFF_COS32); float* s32 = (float*)(ws + OFF_SIN32);
  for (int i = gt; i < SEQ * 32; i += ngt) {
    int pos = i >> 5, f = i & 31; float c, s;
    sincos_acc((float)pos * p.inv64[f], c, s);
    c64[i] = c; s64[i] = s;
  }
  for (int i = gt; i < SEQ * 16; i += ngt) {
    int pos = i >> 4, f = i & 15; float c, s;
    sincos_acc((float)pos * p.inv32[f], c, s);
    c32[i] = c; s32[i] = s;
  }
  if (blockIdx.x == 0)
    for (int i = tidx(); i < 3456; i += 512) __hip_atomic_store((unsigned*)(ws + OFF_BAR) + i, 0u, __ATOMIC_RELAXED, __HIP_MEMORY_SCOPE_AGENT);
  if (gt < DEPTH) {
    auto mxabs = [](const float* g_, int n_) { float m_ = 0.f; for (int i = 0; i < n_; ++i) m_ = fmaxf(m_, fabsf(g_[i])); return m_; };
    float* fl_ = (float*)(ws + OFF_LAM);
    const int l_ = gt;
    const float LIM = 60.f;
    fl_[2 + l_] = (8.f * LOG2E * mxabs(p.in[5] + l_ * 64, 64) * mxabs(p.in[6] + l_ * 64, 64) <= LIM) ? 1.f : 0.f;
    for (int g_ = 0; g_ < 3; ++g_)
      fl_[4 + l_ * 3 + g_] = (8.f * LOG2E * mxabs(p.in[9] + (l_ * 3 + g_) * 64, 64) * mxabs(p.in[10] + (l_ * 3 + g_) * 64, 64) <= LIM) ? 1.f : 0.f;
    fl_[10 + l_] = (9.7979590f * LOG2E * mxabs(p.in[15] + l_ * 96, 96) * mxabs(p.in[16] + l_ * 96, 96) <= LIM) ? 1.f : 0.f;
    fl_[12 + l_] = (8.f * LOG2E * mxabs(p.in[17] + l_ * 64, 64) * mxabs(p.in[18] + l_ * 64, 64) <= LIM) ? 1.f : 0.f;
    const float* lp = p.in[7] + gt * 256;
    float a = 0.f, b = 0.f;
    for (int i = 0; i < 64; ++i) { a += lp[i] * lp[64 + i]; b += lp[128 + i] * lp[192 + i]; }
    ((float*)(ws + OFF_LAM))[gt] = expf(a) - expf(b) + p.lam_init[gt];
  }
}

__device__ __forceinline__ void phase_norm(const float* __restrict__ x, const float* __restrict__ g, u16* __restrict__ xn) {
  const int lane = tidx() & 63, wid = wave_id();
  for (int row = blockIdx.x * 8 + wid; row < CT; row += gridDim.x * 8) {
    const f32x4* xr = (const f32x4*)(x + (size_t)row * DM);
    f32x4 v[4]; float ss = 0.f;
#pragma unroll
    for (int i = 0; i < 4; ++i) { v[i] = xr[lane + 64 * i]; ss += v[i][0] * v[i][0] + v[i][1] * v[i][1] + v[i][2] * v[i][2] + v[i][3] * v[i][3]; }
    ss = swapadd(ss);
#pragma unroll
    for (int o = 16; o >= 1; o >>= 1) ss += __int_as_float(__builtin_amdgcn_ds_bpermute((lane ^ o) << 2, __float_as_int(ss)));
    const float rstd = __builtin_amdgcn_rsqf(ss * (1.f / 1024.f) + EPS);
#pragma unroll
    for (int i = 0; i < 4; ++i) {
      f32x4 g4 = ((const f32x4*)g)[lane + 64 * i];
      u32x2 w = {cvtpk(v[i][0] * rstd * g4[0], v[i][1] * rstd * g4[1]), cvtpk(v[i][2] * rstd * g4[2], v[i][3] * rstd * g4[3])};
      *(u32x2*)(xn + (size_t)row * DM + (lane + 64 * i) * 4) = w;
    }
  }
}

__device__ __forceinline__ void phase_p1(const Params& p, int layer, char* lds) {
  char* const ws = lws(p.ws);
  pg8::Gemm g{(const u16*)(ws + OFF_XN), (const u16*)(ws + OFF_WIN) + (size_t)layer * NIN2 * 1024, CT, NIN2, 1024};
  pg8::StaticOrder S; S.init(CT, NIN2, gridDim.x, blockIdx.x);
  EpiP1 E{(u16*)(ws + OFF_QKV), (const float*)(ws + OFF_COS64), (const float*)(ws + OFF_SIN64), p.in, layer, (unsigned char*)(ws + OFF_GATE)};
  __syncthreads();
  pg8::gemm_phase<EpiP1, pg8::StaticOrder, false>((PG8_LAS unsigned char*)lds, g, S, E, nullptr);
}

__device__ __forceinline__ void phase_p1c(const Params& p, int layer, char* lds) {
  char* const ws = lws(p.ws);
  const u16* Wuq = (const u16*)(ws + OFF_WUQ) + (size_t)layer * 768 * 256;
  const u16* Wukv = (const u16*)(ws + OFF_WUKV) + (size_t)layer * 1024 * 128;
  const u16* qkv = (const u16*)(ws + OFF_QKV);
  u16* qc = (u16*)(ws + OFF_QKVC);
  const float* c32 = (const float*)(ws + OFF_COS32); const float* s32 = (const float*)(ws + OFF_SIN32);
  const int tid = tidx(), wid = wave_id(), wn = wid & 3, wm = wid >> 2;
  char* wl = lds + wid * WAVE_LDS;
  for (int t = blockIdx.x; t < 2 * 128; t += gridDim.x) {
    int nt, mt; tile_map(t, nt, mt);
    const int n0 = nt * 384, m0 = mt * 128;
    f32x16 acc[3][2];
    gemm_core<3>(acc, Wuq + (size_t)n0 * 256, 256, qkv + (size_t)m0 * NINP + 4608, NINP, 256, lds);
    const int lane2 = (tidx() & 63), r = lane2 & 31, h = lane2 >> 5;
#pragma unroll
    for (int j = 0; j < 2; ++j) {
      const int m = m0 + wm * 64 + j * 32 + r;
      float ss = swapadd(row_ssq(qkv + (size_t)m * NINP + 4608 + h * 128, 16));
      const float rq = __builtin_amdgcn_rsqf(ss * (1.f / 256.f) + EPS);
#pragma unroll
      for (int i = 0; i < 3; ++i)
#pragma unroll
        for (int e = 0; e < 16; ++e) acc[i][j][e] *= rq;
    }
    norm96_rope_store(acc, p.in[15] + layer * 96, QS96, (m0 + wm * 64) & (SEQ - 1), c32, s32, qc + (size_t)(m0 + wm * 64) * QKVC_LD + n0 + wn * 96, wl);
  }
  for (int t = blockIdx.x; t < 4 * 128; t += gridDim.x) {
    int nt, mt; tile_map(t, nt, mt);
    const int n0 = nt * 256, m0 = mt * 128;
    f32x16 acc[3][2];
    gemm_core<2, 3>(acc, Wukv + (size_t)n0 * 128, 128, qkv + (size_t)m0 * NINP + 4864, NINP, 128, lds);
    const int n64 = (n0 >> 6) + wn, head = n64 >> 1, isv = n64 & 1;
    const int lane2 = (tidx() & 63), r = lane2 & 31, h = lane2 >> 5;
#pragma unroll
    for (int j = 0; j < 2; ++j) {
      const int m = m0 + wm * 64 + j * 32 + r;
      float ss = swapadd(row_ssq(qkv + (size_t)m * NINP + 4864 + h * 64, 8));
      const float rk = __builtin_amdgcn_rsqf(ss * (1.f / 128.f) + EPS);
#pragma unroll
      for (int i = 0; i < 2; ++i)
#pragma unroll
        for (int e = 0; e < 16; ++e) acc[i][j][e] *= rk;
    }
    if (isv) {
      store_wave_bf16<2, 3>(acc, qc + (size_t)(m0 + wm * 64) * QKVC_LD + 1536 + head * 64, QKVC_LD, wl);
    } else {
      f32x16 (&y)[3][2] = acc;
#pragma unroll
      for (int j = 0; j < 2; ++j) {
        const int m = m0 + wm * 64 + j * 32 + r;
#pragma unroll
        for (int g = 0; g < 4; ++g) {
          u32x2 d = *(const u32x2*)(qkv + (size_t)m * NINP + 4992 + 8 * g + 4 * h);
          y[2][j][4 * g] = bflo(d[0]); y[2][j][4 * g + 1] = bfhi(d[0]); y[2][j][4 * g + 2] = bflo(d[1]); y[2][j][4 * g + 3] = bfhi(d[1]);
        }
      }
      norm96_rope_store(y, p.in[16] + layer * 96, 1.f, (m0 + wm * 64) & (SEQ - 1), c32, s32, qc + (size_t)(m0 + wm * 64) * QKVC_LD + 768 + head * 96, wl);
    }
  }
}

constexpr int QLDS_OFF = 77824, QLDS_WAVE = 64 * 144;
template <int DQK, int DV, int NKT, bool BANDED, bool QLDS = false, bool FAST = false>
DI void attn_loop(f32x16 (&O)[2][DV / 32], float (&mrun)[2], float (&lrun)[2], const bf16x8 (&qf)[2][DQK / 16],
                  const u16* __restrict__ k0p, const u16* __restrict__ k1p, size_t kld, const u16* __restrict__ vp, size_t vld,
                  int t0, int t1, bool wact, int qbase, int W, char* lds) {
  constexpr int KP = DQK * 2 + 16, VP = DV * 2 + 64;
  constexpr int KC = DQK / 8, VC = DV / 8;
  constexpr int KTOT = NKT * 64 * KC, VTOT = 64 * VC, TOT = KTOT + VTOT, NIT = (TOT + 511) / 512;
  constexpr int SB = NKT * 64 * KP + 64 * VP;
  constexpr float THR = 8.f;
  const int tid = tidx(), lane = tid & 63, r = lane & 31, h = lane >> 5;
  const int dk1 = NKT == 2 ? (int)(k1p - k0p) : 0, dvo = (int)(vp - k0p);
  const int ldi = (int)kld;
  int soff[NIT]; int doff[NIT]; bool sval[NIT];
#pragma unroll
  for (int it = 0; it < NIT; ++it) {
    const int c = tid + it * 512;
    const bool allK = (it + 1) * 512 <= KTOT, allV = it * 512 >= KTOT;
    const bool isK = allK ? true : (allV ? false : (c < KTOT));
    const int kt = c / (64 * KC), rem = c % (64 * KC), krow = rem / KC, kcol = rem % KC;
    const int c2 = c - KTOT, vrow = c2 / VC, vcol = c2 % VC;
    const int so_k = (kt ? dk1 : 0) + krow * ldi + kcol * 8, do_k = kt * 64 * KP + krow * KP + kcol * 16;
    const int so_v = dvo + vrow * ldi + vcol * 8, do_v = NKT * 64 * KP + vrow * VP + vcol * 16;
    soff[it] = isK ? so_k : so_v;
    doff[it] = isK ? do_k : do_v;
    sval[it] = ((it + 1) * 512 <= TOT) ? true : (c < TOT);
  }
  u32x4 rg[NIT];
#define SOFF_(it) ((NKT == 2 ? soff[(it) & ~1] : soff[it]) * 2)
#define SADD_(it) ((NKT == 2 && ((it) & 1)) ? ((it) == 1 ? dk1 * 2 : 32 * ldi * 2) : 0)
#define DOFF_(it) ((NKT == 2 && ((it) & 1)) ? doff[(it) & ~1] + ((it) == 1 ? 64 * KP : 32 * VP) : doff[it])
  const __amdgpu_buffer_rsrc_t krsrc = __builtin_amdgcn_make_buffer_rsrc((void*)k0p, 0, 0x7fffffff, 0x00020000);
  const int kaddr = r * KP + h * 16;
  const char* const qlds = lds + QLDS_OFF + wave_id() * QLDS_WAVE + r * 144 + h * 16;
  const int vaddr = NKT * 64 * KP + (4 * h + ((lane & 15) >> 2)) * VP + (((lane >> 4) & 1) * 16 + (lane & 3) * 4) * 2;
  if (t1 <= t0) return;
  __syncthreads();
#pragma unroll
  for (int it = 0; it < NIT; ++it) if (sval[it]) rg[it] = __builtin_amdgcn_raw_buffer_load_b128(krsrc, SOFF_(it), t0 * 128 * ldi + SADD_(it), 0);
#pragma unroll
  for (int it = 0; it < NIT; ++it) if (sval[it]) *(u32x4*)(lds + DOFF_(it)) = rg[it];
  __syncthreads();
#pragma nounroll
  for (int t = t0; t < t1; ++t) {
    const int buf = (t - t0) & 1;
    const bool more = t + 1 < t1;
    if (more && NKT == 1) {
#pragma unroll
      for (int it = 0; it < NIT; ++it) if (sval[it]) rg[it] = __builtin_amdgcn_raw_buffer_load_b128(krsrc, SOFF_(it), (t + 1) * 128 * ldi + SADD_(it), 0);
    }
    bool doit = wact;
    if (BANDED) doit = wact && (t * 64 + 63 >= qbase - W) && (t * 64 <= qbase + 63 + W);
    if (doit) {
      const char* base = lds + buf * SB;
      bf16x8 pf[2][4];
      if (NKT == 1) {
        f32x16 S[2][2];
#pragma unroll
        for (int j = 0; j < 2; ++j)
#pragma unroll
          for (int kb = 0; kb < 2; ++kb)
#pragma unroll
            for (int e = 0; e < 16; ++e) S[j][kb][e] = 0.f;
#pragma unroll
        for (int s = 0; s < DQK / 16; ++s)
#pragma unroll
          for (int kb = 0; kb < 2; ++kb) {
            bf16x8 kf = *(const bf16x8*)(base + kaddr + kb * 32 * KP + s * 32);
#pragma unroll
            for (int j = 0; j < 2; ++j) S[j][kb] = MFMA(kf, qf[j][s], S[j][kb]);
          }
#pragma unroll
        for (int j = 0; j < 2; ++j) {
          if (BANDED) {
            const int qi = qbase + j * 32 + r;
#pragma unroll
            for (int kb = 0; kb < 2; ++kb)
#pragma unroll
              for (int e = 0; e < 16; ++e) {
                int ki = t * 64 + kb * 32 + crow(e, h);
                int dd = qi - ki; dd = dd < 0 ? -dd : dd;
                if (dd > W) S[j][kb][e] = -1e30f;
              }
          }
          float ps = 0.f;
          if (FAST) {
#pragma unroll
            for (int kb = 0; kb < 2; ++kb)
#pragma unroll
              for (int e = 0; e < 16; ++e) { float pv = __builtin_amdgcn_exp2f(S[j][kb][e]); S[j][kb][e] = pv; ps += pv; }
          } else {
            float pmax = S[j][0][0];
#pragma unroll
            for (int e = 1; e < 16; ++e) pmax = fmaxf(pmax, S[j][0][e]);
#pragma unroll
            for (int e = 0; e < 16; ++e) pmax = fmaxf(pmax, S[j][1][e]);
            pmax = swapmax(pmax);
            if (!__all(pmax - mrun[j] <= THR)) {
              float mn = fmaxf(mrun[j], pmax);
              float alpha = __builtin_amdgcn_exp2f(mrun[j] - mn);
              mrun[j] = mn; lrun[j] *= alpha;
#pragma unroll
              for (int d = 0; d < DV / 32; ++d)
#pragma unroll
                for (int e = 0; e < 16; ++e) O[j][d][e] *= alpha;
            }
            const float mm = mrun[j];
#pragma unroll
            for (int kb = 0; kb < 2; ++kb)
#pragma unroll
              for (int e = 0; e < 16; ++e) { float pv = __builtin_amdgcn_exp2f(S[j][kb][e] - mm); S[j][kb][e] = pv; ps += pv; }
          }
          lrun[j] += ps;
#pragma unroll
          for (int ks = 0; ks < 4; ++ks) {
            const int kb = ks >> 1, b8 = (ks & 1) * 8;
            u32x4 w = {cvtpk(S[j][kb][b8], S[j][kb][b8 + 1]), cvtpk(S[j][kb][b8 + 2], S[j][kb][b8 + 3]),
                       cvtpk(S[j][kb][b8 + 4], S[j][kb][b8 + 5]), cvtpk(S[j][kb][b8 + 6], S[j][kb][b8 + 7])};
            pf[j][ks] = __builtin_bit_cast(bf16x8, w);
          }
        }
      } else {
#pragma unroll
        for (int j = 0; j < 2; ++j) {
          f32x16 S[2];
#pragma unroll
          for (int kb = 0; kb < 2; ++kb)
#pragma unroll
            for (int e = 0; e < 16; ++e) S[kb][e] = 0.f;
          {
            constexpr int NS = DQK / 16;
            const char* kbase = base + j * 64 * KP + kaddr;
            const char* qbase_l = qlds + j * 32 * 144;
#define A1_KF(s_, kb_) (*(const bf16x8*)(kbase + (kb_) * 32 * KP + (s_) * 32))
#define A1_QF(s_) (QLDS ? *(const bf16x8*)(qbase_l + (s_) * 32) : qf[j][(s_)])
            bf16x8 ka = A1_KF(0, 0), kb2 = A1_KF(0, 1), qa = A1_QF(0);
            __builtin_amdgcn_sched_barrier(0);
#pragma unroll
            for (int s2 = 0; s2 < NS; ++s2) {
              bf16x8 kn0, kn1, qn;
              if (s2 + 1 < NS) { kn0 = A1_KF(s2 + 1, 0); kn1 = A1_KF(s2 + 1, 1); qn = A1_QF(s2 + 1); }
              __builtin_amdgcn_sched_barrier(0);
              S[0] = MFMA(ka, qa, S[0]);
              S[1] = MFMA(kb2, qa, S[1]);
              __builtin_amdgcn_sched_barrier(0);
              if (s2 + 1 < NS) { ka = kn0; kb2 = kn1; qa = qn; }
            }
#undef A1_KF
#undef A1_QF
          }
          float ps = 0.f;
          if (FAST) {
#pragma unroll
            for (int kb = 0; kb < 2; ++kb)
#pragma unroll
              for (int e = 0; e < 16; ++e) { float pv = __builtin_amdgcn_exp2f(S[kb][e]); S[kb][e] = pv; ps += pv; }
          } else {
            float pmax = S[0][0];
#pragma unroll
            for (int e = 1; e < 16; ++e) pmax = fmaxf(pmax, S[0][e]);
#pragma unroll
            for (int e = 0; e < 16; ++e) pmax = fmaxf(pmax, S[1][e]);
            pmax = swapmax(pmax);
            if (!__all(pmax - mrun[j] <= THR)) {
              float mn = fmaxf(mrun[j], pmax);
              float alpha = __builtin_amdgcn_exp2f(mrun[j] - mn);
              mrun[j] = mn; lrun[j] *= alpha;
#pragma unroll
              for (int d = 0; d < DV / 32; ++d)
#pragma unroll
                for (int e = 0; e < 16; ++e) O[j][d][e] *= alpha;
            }
            const float mm = mrun[j];
#pragma unroll
            for (int kb = 0; kb < 2; ++kb)
#pragma unroll
              for (int e = 0; e < 16; ++e) { float pv = __builtin_amdgcn_exp2f(S[kb][e] - mm); S[kb][e] = pv; ps += pv; }
          }
          lrun[j] += ps;
#pragma unroll
          for (int ks = 0; ks < 4; ++ks) {
            const int kb = ks >> 1, b8 = (ks & 1) * 8;
            u32x4 w = {cvtpk(S[kb][b8], S[kb][b8 + 1]), cvtpk(S[kb][b8 + 2], S[kb][b8 + 3]),
                       cvtpk(S[kb][b8 + 4], S[kb][b8 + 5]), cvtpk(S[kb][b8 + 6], S[kb][b8 + 7])};
            pf[j][ks] = __builtin_bit_cast(bf16x8, w);
          }
          {
            constexpr int ND = DV / 32, NV = 4 * ND;
            const char* vbase = base + vaddr;
            auto vread = [&](int i) -> bf16x8 {
              const char* va = vbase + (i / ND) * 16 * VP + (i % ND) * 64;
              s16x4 lo = __builtin_amdgcn_ds_read_tr16_b64_v4i16((__attribute__((address_space(3))) s16x4*)(va));
              s16x4 hi = __builtin_amdgcn_ds_read_tr16_b64_v4i16((__attribute__((address_space(3))) s16x4*)(va + 8 * VP));
              bf16x8 vf = {lo[0], lo[1], lo[2], lo[3], hi[0], hi[1], hi[2], hi[3]};
              return vf;
            };
            bf16x8 v0 = vread(0), v1 = vread(1);
            __builtin_amdgcn_sched_barrier(0);
#pragma unroll
            for (int i = 0; i < NV; i += 2) {
              O[j][i % ND] = MFMA(v0, pf[j][i / ND], O[j][i % ND]);
              if (i + 2 < NV) v0 = vread(i + 2);
              __builtin_amdgcn_sched_barrier(0);
              O[j][(i + 1) % ND] = MFMA(v1, pf[j][(i + 1) / ND], O[j][(i + 1) % ND]);
              if (i + 3 < NV) v1 = vread(i + 3);
              __builtin_amdgcn_sched_barrier(0);
            }
            if (j == 0 && more) {
#pragma unroll
              for (int it = 0; it < NIT; ++it) if (sval[it]) rg[it] = __builtin_amdgcn_raw_buffer_load_b128(krsrc, SOFF_(it), (t + 1) * 128 * ldi + SADD_(it), 0);
              __builtin_amdgcn_sched_barrier(0);
            }
          }
        }
      }
      if (NKT == 1) {
#pragma unroll
        for (int ks = 0; ks < 4; ++ks)
#pragma unroll
          for (int d = 0; d < DV / 32; ++d) {
            const char* va = base + vaddr + ks * 16 * VP + d * 64;
            s16x4 lo = __builtin_amdgcn_ds_read_tr16_b64_v4i16((__attribute__((address_space(3))) s16x4*)(va));
            s16x4 hi = __builtin_amdgcn_ds_read_tr16_b64_v4i16((__attribute__((address_space(3))) s16x4*)(va + 8 * VP));
            bf16x8 vf = {lo[0], lo[1], lo[2], lo[3], hi[0], hi[1], hi[2], hi[3]};
#pragma unroll
            for (int j = 0; j < 2; ++j) O[j][d] = MFMA(vf, pf[j][ks], O[j][d]);
          }
      }
    }
    if (more) {
      char* nb = lds + (buf ^ 1) * SB;
#pragma unroll
      for (int it = 0; it < NIT; ++it) if (sval[it]) *(u32x4*)(nb + DOFF_(it)) = rg[it];
    }
    __syncthreads();
  }
}

template <int NS>
DI void load_qf(bf16x8 (&qf)[NS], const u16* __restrict__ qrow) {
#pragma unroll
  for (int s = 0; s < NS; ++s) qf[s] = *(const bf16x8*)(qrow + s * 16);
}

template <int ND>
DI void store_o(const f32x16 (&o)[ND], float scale, u16* __restrict__ dst, int h) {
#pragma unroll
  for (int d = 0; d < ND; ++d)
#pragma unroll
    for (int g = 0; g < 4; ++g) {
      u32x2 w = {cvtpk(o[d][4 * g] * scale, o[d][4 * g + 1] * scale), cvtpk(o[d][4 * g + 2] * scale, o[d][4 * g + 3] * scale)};
      *(u32x2*)(dst + d * 32 + 8 * g + 4 * h) = w;
    }
}

DI void item_map(int idx, int nqb, int& sh, int& qb) {
  int xcd = idx & 7, slot = idx >> 3;
  sh = xcd * (32 / nqb) + slot / nqb;
  qb = slot % nqb;
}

__device__ __forceinline__ void attn_A(const Params& p, int layer, int idx, char* lds) {
  char* const ws = lws(p.ws);
  const int tid = tidx(), lane = tid & 63, wid = wave_id(), r = lane & 31, h = lane >> 5;
  int sh, qb; item_map(idx, 16, sh, qb);
  const int seq = sh >> 2, head = sh & 3;
  const u16* qkv = (const u16*)(ws + OFF_QKV) + (size_t)seq * SEQ * NINP;
  u16* outs = (u16*)(ws + OFF_OUTS) + (size_t)seq * SEQ * OUT_LD;
  const int q0 = qb * 256 + wid * 32;
  bf16x8 qf[2][4];
  __syncthreads();
#pragma unroll
  for (int j = 0; j < 2; ++j) {
    load_qf<4>(qf[j], qkv + (size_t)(q0 + r) * NINP + (head * 2 + j) * 64 + h * 8);
#pragma unroll
    for (int s = 0; s < 4; ++s) *(bf16x8*)(lds + QLDS_OFF + wid * QLDS_WAVE + (j * 32 + r) * 144 + h * 16 + s * 32) = qf[j][s];
  }
  lds_fence();
  const bool fast = ((const float*)(ws + OFF_LAM))[2 + layer] != 0.f;
  const float m0_ = fast ? 0.f : -1e29f;
  f32x16 O[2][4]; float mrun[2] = {m0_, m0_}, lrun[2] = {0.f, 0.f};
#pragma unroll
  for (int j = 0; j < 2; ++j)
#pragma unroll
    for (int d = 0; d < 4; ++d)
#pragma unroll
      for (int e = 0; e < 16; ++e) O[j][d][e] = 0.f;
  if (fast) attn_loop<64, 128, 2, false, true, true>(O, mrun, lrun, qf, qkv + 512 + (head * 2) * 64, qkv + 512 + (head * 2 + 1) * 64, NINP, qkv + 1024 + head * 128, NINP,
                               0, 64, true, 0, 0, lds);
  else attn_loop<64, 128, 2, false, true, false>(O, mrun, lrun, qf, qkv + 512 + (head * 2) * 64, qkv + 512 + (head * 2 + 1) * 64, NINP, qkv + 1024 + head * 128, NINP,
                               0, 64, true, 0, 0, lds);
  const int lane2 = (tidx() & 63), r2 = lane2 & 31, h2 = lane2 >> 5;
  const float lam = ((const float*)(ws + OFF_LAM))[layer];
  const float i0 = 1.f / swapadd(lrun[0]), i1 = lam / swapadd(lrun[1]);
  float ss = 0.f;
#pragma unroll
  for (int d = 0; d < 4; ++d)
#pragma unroll
    for (int e = 0; e < 16; ++e) { float o = O[0][d][e] * i0 - O[1][d][e] * i1; O[0][d][e] = o; ss += o * o; }
  ss = swapadd(ss);
  const float rstd = __builtin_amdgcn_rsqf(ss * (1.f / 128.f) + EPS) * p.oml[layer];
  const float* sg = p.in[8] + layer * 128;
  u16* dst = outs + (size_t)(q0 + r2) * OUT_LD + head * 128;
#pragma unroll
  for (int d = 0; d < 4; ++d)
#pragma unroll
    for (int g = 0; g < 4; ++g) {
      f32x4 g4 = *(const f32x4*)(sg + d * 32 + 8 * g + 4 * h2);
      u32x2 w = {cvtpk(O[0][d][4 * g] * rstd * g4[0], O[0][d][4 * g + 1] * rstd * g4[1]), cvtpk(O[0][d][4 * g + 2] * rstd * g4[2], O[0][d][4 * g + 3] * rstd * g4[3])};
      *(u32x2*)(dst + d * 32 + 8 * g + 4 * h2) = w;
    }
}

__device__ __forceinline__ void attn_C(const Params& p, int layer, int idx, char* lds) {
  char* const ws = lws(p.ws);
  const int tid = tidx(), lane = tid & 63, wid = wave_id(), r = lane & 31, h = lane >> 5;
  int sh, qb; item_map(idx, 8, sh, qb);
  const int seq = sh >> 3, head = sh & 7;
  const u16* qc = (const u16*)(ws + OFF_QKVC) + (size_t)seq * SEQ * QKVC_LD;
  u16* outs = (u16*)(ws + OFF_OUTS) + (size_t)seq * SEQ * OUT_LD;
  const int q0 = qb * 512 + wid * 64;
  bf16x8 qf[2][6];
  load_qf<6>(qf[0], qc + (size_t)(q0 + r) * QKVC_LD + head * 96 + h * 8);
  load_qf<6>(qf[1], qc + (size_t)(q0 + 32 + r) * QKVC_LD + head * 96 + h * 8);
  const bool fast = ((const float*)(ws + OFF_LAM))[10 + layer] != 0.f;
  const float m0_ = fast ? 0.f : -1e29f;
  f32x16 O[2][2]; float mrun[2] = {m0_, m0_}, lrun[2] = {0.f, 0.f};
#pragma unroll
  for (int j = 0; j < 2; ++j)
#pragma unroll
    for (int d = 0; d < 2; ++d)
#pragma unroll
      for (int e = 0; e < 16; ++e) O[j][d][e] = 0.f;
  if (fast) attn_loop<96, 64, 1, false, false, true>(O, mrun, lrun, qf, qc + 768 + head * 96, nullptr, QKVC_LD, qc + 1536 + head * 64, QKVC_LD, 0, 64, true, 0, 0, lds);
  else attn_loop<96, 64, 1, false, false, false>(O, mrun, lrun, qf, qc + 768 + head * 96, nullptr, QKVC_LD, qc + 1536 + head * 64, QKVC_LD, 0, 64, true, 0, 0, lds);
  const int lane2 = (tidx() & 63), r2 = lane2 & 31, h2 = lane2 >> 5;
#pragma unroll
  for (int j = 0; j < 2; ++j) {
    const float inv = 1.f / swapadd(lrun[j]);
    store_o<2>(O[j], inv, outs + (size_t)(q0 + j * 32 + r2) * OUT_LD + 768 + head * 64, h2);
  }
}

__device__ __forceinline__ void attn_D(const Params& p, int layer, int idx, char* lds) {
  char* const ws = lws(p.ws);
  const int tid = tidx(), lane = tid & 63, wid = wave_id(), r = lane & 31, h = lane >> 5;
  const int xcd = idx & 7, qb = idx >> 3;
  const int seq = xcd >> 1, kvh = xcd & 1;
  const u16* qkv = (const u16*)(ws + OFF_QKV) + (size_t)seq * SEQ * NINP;
  u16* outs = (u16*)(ws + OFF_OUTS) + (size_t)seq * SEQ * OUT_LD;
  const int qhead = kvh * 4 + (wid >> 1);
  const int q0 = qb * 128 + (wid & 1) * 64;
  bf16x8 qf[2][4];
  load_qf<4>(qf[0], qkv + (size_t)(q0 + r) * NINP + 3840 + qhead * 64 + h * 8);
  load_qf<4>(qf[1], qkv + (size_t)(q0 + 32 + r) * NINP + 3840 + qhead * 64 + h * 8);
  const bool fast = ((const float*)(ws + OFF_LAM))[12 + layer] != 0.f;
  const float m0_ = fast ? 0.f : -1e29f;
  f32x16 O[2][2]; float mrun[2] = {m0_, m0_}, lrun[2] = {0.f, 0.f};
#pragma unroll
  for (int j = 0; j < 2; ++j)
#pragma unroll
    for (int d = 0; d < 2; ++d)
#pragma unroll
      for (int e = 0; e < 16; ++e) O[j][d][e] = 0.f;
  int t0 = qb * 2 - 2; if (t0 < 0) t0 = 0;
  int t1 = qb * 2 + 4; if (t1 > 64) t1 = 64;
  if (fast) attn_loop<64, 64, 1, true, false, true>(O, mrun, lrun, qf, qkv + 4352 + kvh * 64, nullptr, NINP, qkv + 4480 + kvh * 64, NINP, t0, t1, true, q0, 128, lds);
  else attn_loop<64, 64, 1, true, false, false>(O, mrun, lrun, qf, qkv + 4352 + kvh * 64, nullptr, NINP, qkv + 4480 + kvh * 64, NINP, t0, t1, true, q0, 128, lds);
  const float sink2 = p.in[19][layer * 8 + qhead] * LOG2E;
  const int lane2 = (tidx() & 63), r2 = lane2 & 31, h2 = lane2 >> 5;
#pragma unroll
  for (int j = 0; j < 2; ++j) {
    const float l = swapadd(lrun[j]);
    const float mf = fmaxf(mrun[j], sink2);
    const float a = __builtin_amdgcn_exp2f(mrun[j] - mf);
    const float lf = l * a + __builtin_amdgcn_exp2f(sink2 - mf);
    store_o<2>(O[j], a / lf, outs + (size_t)(q0 + j * 32 + r2) * OUT_LD + 1280 + qhead * 64, h2);
  }
}

__device__ __forceinline__ void attn_B(const Params& p, int layer, int idx, char* lds) {
  char* const ws = lws(p.ws);
  const int tid = tidx(), lane = tid & 63, wid = wave_id(), r = lane & 31, h = lane >> 5;
  const int sub = idx & 31, sh = idx >> 5, seq = sh >> 2, head = sh & 3;
  int g, res, m0;
  if (sub < 8) { g = 0; res = 0; m0 = sub * 512; }
  else if (sub < 16) { g = 1; res = (sub - 8) >> 1; m0 = ((sub - 8) & 1) * 512; }
  else { g = 2; res = sub - 16; m0 = 0; }
  const int dil = g == 0 ? 1 : (g == 1 ? 4 : 16);
  const int Lg = SEQ / dil;
  int nact = (Lg - m0) / 64; if (nact > 8) nact = 8;
  const bool wact = wid < nact;
  const size_t ld = (size_t)dil * NINP;
  const u16* base = (const u16*)(ws + OFF_QKV) + ((size_t)seq * SEQ + res) * NINP + 1536 + g * 768 + head * 64;
  int q0 = m0 + wid * 64; if (!wact) q0 = m0;
  bf16x8 qf[2][4];
  load_qf<4>(qf[0], base + (size_t)(q0 + r) * ld + h * 8);
  load_qf<4>(qf[1], base + (size_t)(q0 + 32 + r) * ld + h * 8);
  const bool fast = ((const float*)(ws + OFF_LAM))[4 + layer * 3 + g] != 0.f;
  const float m0_ = fast ? 0.f : -1e29f;
  f32x16 O[2][2]; float mrun[2] = {m0_, m0_}, lrun[2] = {0.f, 0.f};
#pragma unroll
  for (int j = 0; j < 2; ++j)
#pragma unroll
    for (int d = 0; d < 2; ++d)
#pragma unroll
      for (int e = 0; e < 16; ++e) O[j][d][e] = 0.f;
  int t0 = m0 / 64 - 1; if (t0 < 0) t0 = 0;
  int t1 = m0 / 64 + 9; if (t1 > Lg / 64) t1 = Lg / 64;
  if (fast) attn_loop<64, 64, 1, true, false, true>(O, mrun, lrun, qf, base + 256, nullptr, ld, base + 512, ld, t0, t1, wact, q0, 64, lds);
  else attn_loop<64, 64, 1, true, false, false>(O, mrun, lrun, qf, base + 256, nullptr, ld, base + 512, ld, t0, t1, wact, q0, 64, lds);
  if (wact) {
    const int lane2 = (tidx() & 63), r2 = lane2 & 31, h2 = lane2 >> 5;
    u16* bo = (u16*)(ws + OFF_BO) + (size_t)g * CT * 256;
    float* blse = (float*)(ws + OFF_BLSE) + (size_t)g * CT * 4;
#pragma unroll
    for (int j = 0; j < 2; ++j) {
      const float l = swapadd(lrun[j]);
      const size_t tok = (size_t)seq * SEQ + (size_t)(q0 + j * 32 + r2) * dil + res;
      store_o<2>(O[j], 1.f / l, bo + tok * 256 + head * 64, h2);
      if (h2 == 0) blse[tok * 4 + head] = mrun[j] + __builtin_amdgcn_logf(l);
    }
  }
}

DI void combine_rows(char* ws, int m0) {
  const u16* bo = (const u16*)(ws + OFF_BO);
  const float* blse = (const float*)(ws + OFF_BLSE);
  u16* outs = (u16*)(ws + OFF_OUTS);
  for (int i = tidx(); i < 128 * 32; i += 512) {
    const int tok = m0 + (i >> 5), ch = i & 31, head = ch >> 3;
    float l0 = blse[(size_t)tok * 4 + head], l1 = blse[((size_t)CT + tok) * 4 + head], l2 = blse[((size_t)2 * CT + tok) * 4 + head];
    float mx = fmaxf(l0, fmaxf(l1, l2));
    float w0 = __builtin_amdgcn_exp2f(l0 - mx), w1 = __builtin_amdgcn_exp2f(l1 - mx), w2 = __builtin_amdgcn_exp2f(l2 - mx);
    float inv = 1.f / (w0 + w1 + w2); w0 *= inv; w1 *= inv; w2 *= inv;
    u32x4 a = *(const u32x4*)(bo + (size_t)tok * 256 + ch * 8);
    u32x4 b = *(const u32x4*)(bo + ((size_t)CT + tok) * 256 + ch * 8);
    u32x4 c = *(const u32x4*)(bo + ((size_t)2 * CT + tok) * 256 + ch * 8);
    u32x4 o;
#pragma unroll
    for (int e = 0; e < 4; ++e) {
      float lo = w0 * bflo(a[e]) + w1 * bflo(b[e]) + w2 * bflo(c[e]);
      float hi = w0 * bfhi(a[e]) + w1 * bfhi(b[e]) + w2 * bfhi(c[e]);
      o[e] = cvtpk(lo, hi);
    }
    *(u32x4*)(outs + (size_t)tok * OUT_LD + 512 + ch * 8) = o;
  }
  asm volatile("s_waitcnt vmcnt(0)" ::: "memory");
}

__device__ __forceinline__ void phase_merge(const Params& p, int layer, char* lds) {
  constexpr int AR = 256, STAGE = (AR + 128) * PITCH;
  char* const ws = lws(p.ws);
  const u16* Wbr = (const u16*)(ws + OFF_WBR) + (size_t)layer * 1024 * 1792;
  const u16* outs = (const u16*)(ws + OFF_OUTS);
  u16* merged = (u16*)(ws + OFF_MERGED);
  const int wid = wave_id(), wn = wid & 3, wm = wid >> 2;
  const __amdgpu_buffer_rsrc_t arsrc = __builtin_amdgcn_make_buffer_rsrc((void*)Wbr, 0, 0x7fffffff, 0x00020000);
  for (int t = blockIdx.x; t < 4 * 128; t += gridDim.x) {
    int nt, mt; tile_map(t, nt, mt);
    const int n0 = nt * 256, m0 = mt * 128;
    combine_rows(ws, m0);
    const int tid = tidx(), lane = tid & 63, r = lane & 31, h = lane >> 5;
    const int crow0 = tid >> 3, ccol = tid & 7;
    const __amdgpu_buffer_rsrc_t brsrc = __builtin_amdgcn_make_buffer_rsrc((void*)(outs + (size_t)m0 * OUT_LD), 0, 0x7fffffff, 0x00020000);
    const int bvo = (crow0 * OUT_LD + ccol * 8) * 2, bstep = 64 * OUT_LD * 2;
    const int wofs = crow0 * PITCH + ccol * 16;
    const int aoff = (wn * 64 + r) * PITCH + h * 16;
    const int boff = AR * PITCH + (wm * 64 + r) * PITCH + h * 16;
    f32x16 mg[2][2], acc[2][2];
#pragma unroll
    for (int i = 0; i < 2; ++i)
#pragma unroll
      for (int j = 0; j < 2; ++j)
#pragma unroll
        for (int e = 0; e < 16; ++e) { mg[i][j][e] = 0.f; acc[i][j][e] = 0.f; }
    u32x4 ra[4], rb[2];
    unsigned gw[2][2][4];
#define MG_BR(q) ((q) < 8 ? 0 : ((q) < 12 ? 1 : ((q) < 20 ? 2 : 3)))
#define MG_Q0(br) ((br) == 0 ? 0 : ((br) == 1 ? 8 : ((br) == 2 ? 12 : 20)))
#define MG_COFS(br) ((br) == 0 ? 0 : ((br) == 1 ? 512 : ((br) == 2 ? 768 : 1280)))
#define MG_LOAD(q) do { const int br_ = MG_BR(q), kt_ = (q) - MG_Q0(br_), Kb_ = br_ == 1 ? 256 : 512, cf_ = MG_COFS(br_); \
      const int avo_ = (1024 * cf_ + (n0 + crow0) * Kb_ + ccol * 8) * 2, ast_ = 64 * Kb_ * 2; \
      _Pragma("unroll") for (int i = 0; i < 4; ++i) ra[i] = __builtin_amdgcn_raw_buffer_load_b128(arsrc, avo_ + i * ast_, kt_ * 128, 0); \
      _Pragma("unroll") for (int i = 0; i < 2; ++i) rb[i] = __builtin_amdgcn_raw_buffer_load_b128(brsrc, bvo + i * bstep, cf_ * 2 + kt_ * 128, 0); } while (0)
#define MG_STORE(buf) do { char* nb_ = lds + (buf) * STAGE; \
      _Pragma("unroll") for (int i = 0; i < 4; ++i) *(u32x4*)(nb_ + wofs + i * 64 * PITCH) = ra[i]; \
      _Pragma("unroll") for (int i = 0; i < 2; ++i) *(u32x4*)(nb_ + AR * PITCH + wofs + i * 64 * PITCH) = rb[i]; } while (0)
#define MG_GATES(br) do { const unsigned char* gb_ = (const unsigned char*)(ws + OFF_GATE) + (br) * 1024 + n0 + wn * 64 + 4 * h; \
      _Pragma("unroll") for (int j = 0; j < 2; ++j) { const unsigned char* gr_ = gb_ + (size_t)(m0 + wm * 64 + j * 32 + r) * 4096; \
        _Pragma("unroll") for (int i = 0; i < 2; ++i) _Pragma("unroll") for (int g = 0; g < 4; ++g) gw[i][j][g] = *(const unsigned*)(gr_ + i * 32 + 8 * g); } } while (0)
    __syncthreads();
    MG_LOAD(0); MG_STORE(0); MG_GATES(0);
    __syncthreads();
#pragma nounroll
    for (int q = 0; q < 28; ++q) {
      const bool more = q + 1 < 28;
      if (more) MG_LOAD(q + 1);
      const char* base = lds + (q & 1) * STAGE;
      bf16x8 afA[2], bfA[2], afB[2], bfB[2];
#pragma unroll
      for (int i = 0; i < 2; ++i) afA[i] = *(const bf16x8*)(base + aoff + i * 32 * PITCH);
#pragma unroll
      for (int j = 0; j < 2; ++j) bfA[j] = *(const bf16x8*)(base + boff + j * 32 * PITCH);
      __builtin_amdgcn_sched_barrier(0);
#pragma unroll
      for (int s2 = 0; s2 < 4; s2 += 2) {
#pragma unroll
        for (int i = 0; i < 2; ++i) afB[i] = *(const bf16x8*)(base + aoff + i * 32 * PITCH + (s2 + 1) * 32);
#pragma unroll
        for (int j = 0; j < 2; ++j) bfB[j] = *(const bf16x8*)(base + boff + j * 32 * PITCH + (s2 + 1) * 32);
        __builtin_amdgcn_sched_barrier(0);
#pragma unroll
        for (int i = 0; i < 2; ++i)
#pragma unroll
          for (int j = 0; j < 2; ++j) acc[i][j] = MFMA(afA[i], bfA[j], acc[i][j]);
        __builtin_amdgcn_sched_barrier(0);
        if (s2 + 2 < 4) {
#pragma unroll
          for (int i = 0; i < 2; ++i) afA[i] = *(const bf16x8*)(base + aoff + i * 32 * PITCH + (s2 + 2) * 32);
#pragma unroll
          for (int j = 0; j < 2; ++j) bfA[j] = *(const bf16x8*)(base + boff + j * 32 * PITCH + (s2 + 2) * 32);
        }
        __builtin_amdgcn_sched_barrier(0);
#pragma unroll
        for (int i = 0; i < 2; ++i)
#pragma unroll
          for (int j = 0; j < 2; ++j) acc[i][j] = MFMA(afB[i], bfB[j], acc[i][j]);
        __builtin_amdgcn_sched_barrier(0);
      }
      if (q == 7 || q == 11 || q == 19 || q == 27) {
#pragma unroll
        for (int j = 0; j < 2; ++j)
#pragma unroll
          for (int i = 0; i < 2; ++i)
#pragma unroll
            for (int g = 0; g < 4; ++g)
#pragma unroll
              for (int e = 0; e < 4; ++e) {
                mg[i][j][4 * g + e] += (float)((gw[i][j][g] >> (8 * e)) & 255u) * (1.f / 255.f) * acc[i][j][4 * g + e];
                acc[i][j][4 * g + e] = 0.f;
              }
        if (more) { const int nbr = MG_BR(q + 1); MG_GATES(nbr); }
      }
      if (more) MG_STORE((q + 1) & 1);
      __syncthreads();
    }
#undef MG_BR
#undef MG_Q0
#undef MG_COFS
#undef MG_LOAD
#undef MG_STORE
#undef MG_GATES
    store_wave_bf16<2>(mg, merged + (size_t)(m0 + wm * 64) * 1024 + n0 + wn * 64, 1024, lds + wid * WAVE_LDS);
  }
}

__device__ __forceinline__ void phase_proj_res(const u16* Wt, const u16* act, int K, const float* resid, float* xout, char* lds) {
  pg8::Gemm g{act, Wt, CT, DM, K};
  pg8::StaticOrder S; S.init(CT, DM, gridDim.x, blockIdx.x);
  EpiRes E{resid, xout};
  __syncthreads();
  pg8::gemm_phase<EpiRes, pg8::StaticOrder, false>((PG8_LAS unsigned char*)lds, g, S, E, nullptr);
}

__device__ __forceinline__ void phase_ffn_up(const Params& p, int layer, char* lds) {
  char* const ws = lws(p.ws);
  pg8::Gemm g{(const u16*)(ws + OFF_XN), (const u16*)(ws + OFF_WGU) + (size_t)layer * NGU * 1024, CT, NGU, 1024};
  pg8::StaticOrder S; S.init(CT, NGU, gridDim.x, blockIdx.x);
  EpiSwiglu E{(u16*)(ws + OFF_ACT)};
  __syncthreads();
  pg8::gemm_phase<EpiSwiglu, pg8::StaticOrder, false>((PG8_LAS unsigned char*)lds, g, S, E, nullptr);
}

#define XB_TMO      128
#define XB_XCNT(j)  (256  + 64 * (j))
#define XB_XSUB(j)  (1280 + 64 * (j))
#define XB_XGEN(j)  (2304 + 64 * (j))
#define XB_TOP      3328
#define XB_TOPGEN   3392
#define XCD_BAR_WORDS 3456
#define XB_SPIN_CAP (1u << 20)
#define XB_LAS __attribute__((address_space(3)))
DI unsigned xb_ld(unsigned* p) { return __hip_atomic_load(p, __ATOMIC_RELAXED, __HIP_MEMORY_SCOPE_AGENT); }
DI unsigned xb_add(unsigned* p, unsigned v) { return __hip_atomic_fetch_add(p, v, __ATOMIC_RELAXED, __HIP_MEMORY_SCOPE_AGENT); }
DI unsigned xb_xcc_id() { return (unsigned)__builtin_amdgcn_s_getreg((3 << 11) | 20) & 0xFu; }
#define XB_SPIN(cond, bar) do { unsigned _sp = 0; while (cond) { __builtin_amdgcn_s_sleep(1); \
    if ((++_sp & 255u) == 0u) { if (xb_ld(&(bar)[XB_TMO])) break; if (_sp > XB_SPIN_CAP) { atomicAdd(&(bar)[XB_TMO], 1u); break; } } } } while (0)
struct XcdBarrier { unsigned* bar; unsigned x; volatile XB_LAS unsigned* st; };
DI XcdBarrier xcd_barrier_post(unsigned* bar, volatile XB_LAS unsigned* st) {
  XcdBarrier b; b.bar = bar; b.x = xb_xcc_id(); b.st = st;
  if (tidx() == 0) (void)xb_add(&bar[XB_XCNT(b.x)], 1u);
  return b;
}
DI void xcd_barrier_complete(unsigned* bar, unsigned x, unsigned& nloc, unsigned& nx) {
  const unsigned G = gridDim.x;
  unsigned sum, cnt, mine, sp = 0u;
  for (;;) {
    sum = 0u; cnt = 0u; mine = 0u;
#pragma unroll
    for (unsigned j = 0; j < 16; ++j) { const unsigned c = xb_ld(&bar[XB_XCNT(j)]); sum += c; cnt += (c > 0u) ? 1u : 0u; mine = (j == x) ? c : mine; }
    if (sum == G) break;
    __builtin_amdgcn_s_sleep(1);
    if ((++sp & 255u) == 0u) { if (xb_ld(&bar[XB_TMO])) break; if (sp > XB_SPIN_CAP) { atomicAdd(&bar[XB_TMO], 1u); break; } }
  }
  nloc = mine > 0u ? mine : 1u; nx = cnt > 0u ? cnt : 1u;
}
DI void xcd_barrier(const XcdBarrier& b) {
  asm volatile("s_waitcnt vmcnt(0)" ::: "memory");
  __syncthreads();
  if (tidx() == 0) {
    unsigned* bar = b.bar;
    __builtin_amdgcn_s_waitcnt(0);
    unsigned nloc = b.st[0], nx = b.st[1];
    if (nloc == 0u) { xcd_barrier_complete(bar, b.x, nloc, nx); b.st[0] = nloc; b.st[1] = nx; }
    const unsigned old = xb_add(&bar[XB_XSUB(b.x)], 1u);
    const unsigned gen = old / nloc;
    if (old + 1u == (gen + 1u) * nloc) {
      __builtin_amdgcn_fence(__ATOMIC_RELEASE, "agent");
      asm volatile("s_waitcnt vmcnt(0)" ::: "memory");
      const unsigned og = xb_add(&bar[XB_TOP], 1u);
      const unsigned tg = og / nx;
      if (og + 1u == (tg + 1u) * nx) xb_add(&bar[XB_TOPGEN], 1u);
      else XB_SPIN(xb_ld(&bar[XB_TOPGEN]) == tg, bar);
      __builtin_amdgcn_fence(__ATOMIC_ACQUIRE, "agent");
      xb_add(&bar[XB_XGEN(b.x)], 1u);
      asm volatile("s_waitcnt vmcnt(0)" ::: "memory");
    } else {
      XB_SPIN(xb_ld(&bar[XB_XGEN(b.x)]) == gen, bar);
      __builtin_amdgcn_fence(__ATOMIC_ACQUIRE, "agent");
      asm volatile("s_waitcnt vmcnt(0)" ::: "memory");
    }
  }
  __syncthreads();
}

DI void grid_barrier(unsigned* ctr, unsigned target) {
  asm volatile("s_waitcnt vmcnt(0)" ::: "memory");
  __syncthreads();
  if (threadIdx.x == 0) {
    __builtin_amdgcn_fence(__ATOMIC_RELEASE, "agent");
    asm volatile("s_waitcnt vmcnt(0)" ::: "memory");
    __hip_atomic_fetch_add(ctr, 1u, __ATOMIC_RELAXED, __HIP_MEMORY_SCOPE_AGENT);
    unsigned spins = 0;
    while (__hip_atomic_load(ctr, __ATOMIC_RELAXED, __HIP_MEMORY_SCOPE_AGENT) < target && ++spins < (1u << 26)) __builtin_amdgcn_s_sleep(2);
    __builtin_amdgcn_fence(__ATOMIC_ACQUIRE, "agent");
    asm volatile("s_waitcnt vmcnt(0)" ::: "memory");
  }
  __syncthreads();
}

extern "C" __global__ void __launch_bounds__(512, 2) mega(Params p) {
  extern __shared__ __attribute__((aligned(16))) char lds[];
  cg::grid_group grid = cg::this_grid();
  unsigned* const barp = (unsigned*)(p.ws + OFF_BAR);
  unsigned nbar = 0;
#define PWS lws(p.ws)
#define POUT ((float*)lws((char*)p.out))
  volatile XB_LAS unsigned* xst = (volatile XB_LAS unsigned*)(lds + (LDS_BYTES - 16));
  if (tidx() == 0) { xst[0] = 0u; xst[1] = 0u; }
  phase_w(p, lds);
  grid.sync();
  const XcdBarrier xb = xcd_barrier_post(barp, xst);
#pragma nounroll
  for (int ch = 0; ch < NCH; ++ch) {
#pragma nounroll
    for (int layer = 0; layer < DEPTH; ++layer) {
      {
        const float* xin = ch == 0 ? p.in[0] : p.in[1] + (size_t)(ch - 1) * CT * DM;
        const float* xcur = layer == 0 ? xin : POUT + (size_t)ch * CT * DM;
        phase_norm(xcur, p.in[2] + layer * DM, (u16*)(PWS + OFF_XN));
      }
      xcd_barrier(xb);
      phase_p1(p, layer, lds);
      xcd_barrier(xb);
      phase_p1c(p, layer, lds);
      xcd_barrier(xb);
#pragma nounroll
      for (int it = blockIdx.x; it < 1280; it += gridDim.x) {
        if (it < 256) attn_A(p, layer, it, lds);
        else if (it < 512) attn_C(p, layer, it - 256, lds);
        else if (it < 768) attn_D(p, layer, it - 512, lds);
        else attn_B(p, layer, it - 768, lds);
      }
      xcd_barrier(xb);
      phase_merge(p, layer, lds);
      xcd_barrier(xb);
      {
        const float* xin = ch == 0 ? p.in[0] : p.in[1] + (size_t)(ch - 1) * CT * DM;
        float* xo = POUT + (size_t)ch * CT * DM;
        const float* xcur = layer == 0 ? xin : xo;
        phase_proj_res((const u16*)(PWS + OFF_WO) + (size_t)layer * 1024 * 1024, (const u16*)(PWS + OFF_MERGED), 1024, xcur, xo, lds);
      }
      xcd_barrier(xb);
      {
        phase_norm(POUT + (size_t)ch * CT * DM, p.in[25] + layer * DM, (u16*)(PWS + OFF_XN));
      }
      xcd_barrier(xb);
      phase_ffn_up(p, layer, lds);
      xcd_barrier(xb);
      {
        float* xo = POUT + (size_t)ch * CT * DM;
        phase_proj_res((const u16*)(PWS + OFF_WDN) + (size_t)layer * 1024 * DFF, (const u16*)(PWS + OFF_ACT), DFF, xo, xo, lds);
      }
      xcd_barrier(xb);
    }
  }
}

extern "C" void kernel_launch(void* const* d_in, const int* in_sizes, int n_in, void* d_out, int out_size, void* d_ws, size_t ws_size, hipStream_t stream) {
  static int grid_blocks = 0;
  if (!grid_blocks) {
    int dev = 0, cus = 0, per_cu = 0;
    (void)hipGetDevice(&dev);
    (void)hipDeviceGetAttribute(&cus, hipDeviceAttributeMultiprocessorCount, dev);
    (void)hipFuncSetAttribute((const void*)mega, hipFuncAttributeMaxDynamicSharedMemorySize, (int)LDS_BYTES);
    (void)hipOccupancyMaxActiveBlocksPerMultiprocessor(&per_cu, mega, 512, LDS_BYTES);
    if (per_cu < 1) fprintf(stderr, "kernel_launch: occupancy query returned %d\n", per_cu);
    grid_blocks = cus > 0 ? cus : 256;
    if (ws_size < WS_END) fprintf(stderr, "kernel_launch: workspace too small: %zu < %zu\n", ws_size, (size_t)WS_END);
  }
  Params p{};
  for (int i = 0; i < 29; ++i) p.in[i] = (const float*)d_in[i];
  p.out = (float*)d_out;
  p.ws = (char*)d_ws;
  for (int i = 0; i < 32; ++i) p.inv64[i] = (float)pow(10000.0, -(double)i / 32.0);
  for (int i = 0; i < 16; ++i) p.inv32[i] = (float)pow(10000.0, -(double)i / 16.0);
  for (int l = 0; l < 2; ++l) {
    double li = 0.8 - 0.6 * exp(-0.3 * (double)l);
    p.lam_init[l] = (float)li;
    p.oml[l] = (float)(1.0 - li);
  }
  void* args[] = {&p};
  hipError_t e = hipLaunchCooperativeKernel((void*)mega, dim3(grid_blocks), dim3(512), args, LDS_BYTES, stream);
  if (e != hipSuccess) fprintf(stderr, "cooperative launch failed: %s (grid %d)\n", hipGetErrorString(e), grid_blocks);
}
```

```cpp
#include <hip/hip_runtime.h>
#include <hip/hip_cooperative_groups.h>
#include <cstdio>
#include <cmath>
namespace cg = cooperative_groups;

typedef unsigned short u16;
typedef short bf16x8 __attribute__((ext_vector_type(8)));
typedef short s16x4 __attribute__((ext_vector_type(4)));
typedef float f32x16 __attribute__((ext_vector_type(16)));
typedef float f32x4 __attribute__((ext_vector_type(4)));
typedef float f32x2 __attribute__((ext_vector_type(2)));
typedef unsigned u32x4 __attribute__((ext_vector_type(4)));
typedef unsigned u32x2 __attribute__((ext_vector_type(2)));
typedef __bf16 bf16x2_t __attribute__((ext_vector_type(2)));

#define DI __device__ __forceinline__
#define MFMA(a, b, c) __builtin_amdgcn_mfma_f32_32x32x16_bf16(a, b, c, 0, 0, 0)

constexpr int DM = 1024, SEQ = 4096, CT = 16384, NCH = 3, NINP = 5120, DFF = 2816, NGU = 5632, NIN2 = 9216;
constexpr int QKVC_LD = 2048, OUT_LD = 1792, DEPTH = 2;
constexpr float LOG2E = 1.4426950408889634f;
constexpr float QS64 = 0.125f * LOG2E, QS96 = 0.10206207261596575f * LOG2E;
constexpr float EPS = 1e-6f;
constexpr int PITCH = 144;
constexpr int WAVE_LDS = 17408;
constexpr size_t LDS_BYTES = 155648;

constexpr size_t al256(size_t x) { return (x + 255) / 256 * 256; }
constexpr size_t OFF_WIN = 0;
constexpr size_t OFF_WGATE = OFF_WIN + al256((size_t)DEPTH * NIN2 * 1024 * 2);
constexpr size_t OFF_WUQ = OFF_WGATE + 256;
constexpr size_t OFF_WUKV = OFF_WUQ + al256((size_t)DEPTH * 768 * 256 * 2);
constexpr size_t OFF_WBR = OFF_WUKV + al256((size_t)DEPTH * 1024 * 128 * 2);
constexpr size_t OFF_WO = OFF_WBR + al256((size_t)DEPTH * 1024 * 1792 * 2);
constexpr size_t OFF_WGU = OFF_WO + al256((size_t)DEPTH * 1024 * 1024 * 2);
constexpr size_t OFF_WDN = OFF_WGU + al256((size_t)DEPTH * NGU * 1024 * 2);
constexpr size_t OFF_COS64 = OFF_WDN + al256((size_t)DEPTH * 1024 * DFF * 2);
constexpr size_t OFF_SIN64 = OFF_COS64 + (size_t)SEQ * 32 * 4;
constexpr size_t OFF_COS32 = OFF_SIN64 + (size_t)SEQ * 32 * 4;
constexpr size_t OFF_SIN32 = OFF_COS32 + (size_t)SEQ * 16 * 4;
constexpr size_t OFF_LAM = OFF_SIN32 + (size_t)SEQ * 16 * 4;
constexpr size_t OFF_BAR = OFF_LAM + 256;
constexpr size_t OFF_XN = OFF_BAR + 16384;
constexpr size_t OFF_QKV = OFF_XN + (size_t)CT * 1024 * 2;
constexpr size_t OFF_QKVC = OFF_QKV + (size_t)CT * NINP * 2;
constexpr size_t OFF_OUTS = OFF_QKVC + (size_t)CT * QKVC_LD * 2;
constexpr size_t OFF_BO = OFF_OUTS + (size_t)CT * OUT_LD * 2;
constexpr size_t OFF_BLSE = OFF_BO + (size_t)3 * CT * 256 * 2;
constexpr size_t OFF_GATE = OFF_BLSE + (size_t)3 * CT * 4 * 4;
constexpr size_t WS_END = OFF_GATE + (size_t)CT * 4096;
constexpr size_t OFF_MERGED = OFF_QKV;
constexpr size_t OFF_ACT = OFF_QKV + (size_t)CT * 1024 * 2;

struct Params {
  const float* in[29];
  float* out;
  char* ws;
  float inv64[32];
  float inv32[16];
  float lam_init[2];
  float oml[2];
  int pad[2];
};

DI int crow(int reg, int h) { return (reg & 3) + 8 * (reg >> 2) + 4 * h; }
DI unsigned cvtpk(float lo, float hi) {
  f32x2 f = {lo, hi};
  bf16x2_t b = __builtin_convertvector(f, bf16x2_t);
  return __builtin_bit_cast(unsigned, b);
}
DI float bflo(unsigned u) { return __uint_as_float(u << 16); }
DI float bfhi(unsigned u) { return __uint_as_float(u & 0xffff0000u); }
DI float swapadd(float x) {
  auto rr = __builtin_amdgcn_permlane32_swap(__float_as_uint(x), __float_as_uint(x), false, false);
  return __uint_as_float(rr[0]) + __uint_as_float(rr[1]);
}
DI float swapmax(float x) {
  auto rr = __builtin_amdgcn_permlane32_swap(__float_as_uint(x), __float_as_uint(x), false, false);
  return fmaxf(__uint_as_float(rr[0]), __uint_as_float(rr[1]));
}
DI int opaque(int x) { asm volatile("" : "+v"(x)); return x; }
DI int tidx() { return opaque((int)threadIdx.x); }
DI int wave_id() { return __builtin_amdgcn_readfirstlane(tidx() >> 6); }
DI char* lws(char* w) { asm volatile("" : "+s"(w)); return w; }
DI void lds_fence() { asm volatile("s_waitcnt lgkmcnt(0)" ::: "memory"); }
DI void tile_map(int t, int& nt, int& mt) {
  int round = t >> 8, b = t & 255, xcd = b & 7, slot = b >> 3;
  nt = round * 2 + (slot & 1);
  mt = xcd * 16 + (slot >> 1);
}

template <int NB, int AN = NB, bool LOWREG = false>
DI void gemm_core(f32x16 (&acc)[AN][2], const u16* __restrict__ Ag, int lda, const u16* __restrict__ Bg, int ldb, int K, char* lds) {
  constexpr int AR = 128 * NB;
  constexpr int ACH = AR * 8 / 512;
  constexpr int STAGE = (AR + 128) * PITCH;
  const int tid = tidx(), lane = tid & 63, wid = wave_id(), r = lane & 31, h = lane >> 5;
  const int wn = wid & 3, wm = wid >> 2;
  const int crow0 = tid >> 3, ccol = tid & 7;
  const __amdgpu_buffer_rsrc_t arsrc = __builtin_amdgcn_make_buffer_rsrc((void*)Ag, 0, 0x7fffffff, 0x00020000);
  const __amdgpu_buffer_rsrc_t brsrc = __builtin_amdgcn_make_buffer_rsrc((void*)Bg, 0, 0x7fffffff, 0x00020000);
  const int avo = (crow0 * lda + ccol * 8) * 2, bvo = (crow0 * ldb + ccol * 8) * 2;
  const int astep = 64 * lda * 2, bstep = 64 * ldb * 2;
  const int wofs = crow0 * PITCH + ccol * 16;
  const int aoff = (wn * 32 * NB + r) * PITCH + h * 16;
  const int boff = AR * PITCH + (wm * 64 + r) * PITCH + h * 16;
  const int nk = K >> 6;
  u32x4 ra[ACH], rb[2];
#pragma unroll
  for (int i = 0; i < NB; ++i)
#pragma unroll
    for (int j = 0; j < 2; ++j)
#pragma unroll
      for (int e = 0; e < 16; ++e) acc[i][j][e] = 0.f;
  __syncthreads();
#pragma unroll
  for (int i = 0; i < ACH; ++i) ra[i] = __builtin_amdgcn_raw_buffer_load_b128(arsrc, avo + i * astep, 0, 0);
#pragma unroll
  for (int i = 0; i < 2; ++i) rb[i] = __builtin_amdgcn_raw_buffer_load_b128(brsrc, bvo + i * bstep, 0, 0);
#pragma unroll
  for (int i = 0; i < ACH; ++i) *(u32x4*)(lds + wofs + i * 64 * PITCH) = ra[i];
#pragma unroll
  for (int i = 0; i < 2; ++i) *(u32x4*)(lds + AR * PITCH + wofs + i * 64 * PITCH) = rb[i];
  __syncthreads();
#pragma nounroll
  for (int kt = 0; kt < nk; ++kt) {
    const bool more = kt + 1 < nk;
    if (more) {
#pragma unroll
      for (int i = 0; i < ACH; ++i) ra[i] = __builtin_amdgcn_raw_buffer_load_b128(arsrc, avo + i * astep, (kt + 1) * 128, 0);
#pragma unroll
      for (int i = 0; i < 2; ++i) rb[i] = __builtin_amdgcn_raw_buffer_load_b128(brsrc, bvo + i * bstep, (kt + 1) * 128, 0);
    }
    const char* base = lds + (kt & 1) * STAGE;
    if (LOWREG) {
#pragma unroll
      for (int s = 0; s < 4; ++s) {
        bf16x8 af[NB], bfr[2];
#pragma unroll
        for (int i = 0; i < NB; ++i) af[i] = *(const bf16x8*)(base + aoff + i * 32 * PITCH + s * 32);
#pragma unroll
        for (int j = 0; j < 2; ++j) bfr[j] = *(const bf16x8*)(base + boff + j * 32 * PITCH + s * 32);
#pragma unroll
        for (int i = 0; i < NB; ++i)
#pragma unroll
          for (int j = 0; j < 2; ++j) acc[i][j] = MFMA(af[i], bfr[j], acc[i][j]);
      }
    } else {
    bf16x8 afA[NB], bfA[2], afB[NB], bfB[2];
#pragma unroll
    for (int i = 0; i < NB; ++i) afA[i] = *(const bf16x8*)(base + aoff + i * 32 * PITCH);
#pragma unroll
    for (int j = 0; j < 2; ++j) bfA[j] = *(const bf16x8*)(base + boff + j * 32 * PITCH);
    __builtin_amdgcn_sched_barrier(0);
#pragma unroll
    for (int s = 0; s < 4; s += 2) {
#pragma unroll
      for (int i = 0; i < NB; ++i) afB[i] = *(const bf16x8*)(base + aoff + i * 32 * PITCH + (s + 1) * 32);
#pragma unroll
      for (int j = 0; j < 2; ++j) bfB[j] = *(const bf16x8*)(base + boff + j * 32 * PITCH + (s + 1) * 32);
      __builtin_amdgcn_sched_barrier(0);
#pragma unroll
      for (int i = 0; i < NB; ++i)
#pragma unroll
        for (int j = 0; j < 2; ++j) acc[i][j] = MFMA(afA[i], bfA[j], acc[i][j]);
      __builtin_amdgcn_sched_barrier(0);
      if (s + 2 < 4) {
#pragma unroll
        for (int i = 0; i < NB; ++i) afA[i] = *(const bf16x8*)(base + aoff + i * 32 * PITCH + (s + 2) * 32);
#pragma unroll
        for (int j = 0; j < 2; ++j) bfA[j] = *(const bf16x8*)(base + boff + j * 32 * PITCH + (s + 2) * 32);
      }
      __builtin_amdgcn_sched_barrier(0);
#pragma unroll
      for (int i = 0; i < NB; ++i)
#pragma unroll
        for (int j = 0; j < 2; ++j) acc[i][j] = MFMA(afB[i], bfB[j], acc[i][j]);
      __builtin_amdgcn_sched_barrier(0);
    }
    }
    if (more) {
      char* nb = lds + ((kt + 1) & 1) * STAGE;
#pragma unroll
      for (int i = 0; i < ACH; ++i) *(u32x4*)(nb + wofs + i * 64 * PITCH) = ra[i];
#pragma unroll
      for (int i = 0; i < 2; ++i) *(u32x4*)(nb + AR * PITCH + wofs + i * 64 * PITCH) = rb[i];
    }
    __syncthreads();
  }
}

template <int NB, int AN = NB>
DI void store_wave_bf16(const f32x16 (&v)[AN][2], u16* __restrict__ wdst, int ldd, char* wl) {
  constexpr int TP = NB * 64 + 16;
  const int lane = (tidx() & 63), r = lane & 31, h = lane >> 5;
#pragma unroll
  for (int i = 0; i < NB; ++i)
#pragma unroll
    for (int j = 0; j < 2; ++j)
#pragma unroll
      for (int g = 0; g < 4; ++g) {
        u32x2 w = {cvtpk(v[i][j][4 * g], v[i][j][4 * g + 1]), cvtpk(v[i][j][4 * g + 2], v[i][j][4 * g + 3])};
        *(u32x2*)(wl + (j * 32 + r) * TP + (i * 32 + 8 * g + 4 * h) * 2) = w;
      }
  lds_fence();
  constexpr int CPR = NB * 4;
#pragma unroll
  for (int it = 0; it < CPR; ++it) {
    int c = lane + 64 * it, row = c / CPR, ch = c % CPR;
    u32x4 d = *(const u32x4*)(wl + row * TP + ch * 16);
    *(u32x4*)(wdst + (size_t)row * ldd + ch * 8) = d;
  }
  lds_fence();
}

DI void store_wave_f32_res(const f32x16 (&v)[2][2], const float* __restrict__ res, float* __restrict__ wdst, char* wl) {
  constexpr int TP = 272;
  const int lane = (tidx() & 63), r = lane & 31, h = lane >> 5;
#pragma unroll
  for (int i = 0; i < 2; ++i)
#pragma unroll
    for (int j = 0; j < 2; ++j)
#pragma unroll
      for (int g = 0; g < 4; ++g) {
        f32x4 w = {v[i][j][4 * g], v[i][j][4 * g + 1], v[i][j][4 * g + 2], v[i][j][4 * g + 3]};
        *(f32x4*)(wl + (j * 32 + r) * TP + (i * 32 + 8 * g + 4 * h) * 4) = w;
      }
  lds_fence();
#pragma unroll
  for (int it = 0; it < 16; ++it) {
    int c = lane + 64 * it, row = c >> 4, ch = c & 15;
    f32x4 d = *(const f32x4*)(wl + row * TP + ch * 16);
    f32x4 x = *(const f32x4*)(res + (size_t)row * DM + ch * 4);
    d += x;
    *(f32x4*)(wdst + (size_t)row * DM + ch * 4) = d;
  }
  lds_fence();
}

DI void norm_rope64(f32x16 (&v)[2][2], const float* __restrict__ gain, float scale, int pos0, const float* __restrict__ cs, const float* __restrict__ sn) {
  const int lane = (tidx() & 63), r = lane & 31, h = lane >> 5;
#pragma unroll
  for (int j = 0; j < 2; ++j) {
    float ss = 0.f;
#pragma unroll
    for (int e = 0; e < 16; ++e) ss += v[0][j][e] * v[0][j][e] + v[1][j][e] * v[1][j][e];
    ss = swapadd(ss);
    const float rstd = __builtin_amdgcn_rsqf(ss * (1.f / 64.f) + EPS);
    const int pos = pos0 + j * 32 + r;
#pragma unroll
    for (int g = 0; g < 4; ++g) {
      const int d = 8 * g + 4 * h;
      f32x4 c4 = *(const f32x4*)(cs + pos * 32 + d), s4 = *(const f32x4*)(sn + pos * 32 + d);
      f32x4 g1 = *(const f32x4*)(gain + d), g2 = *(const f32x4*)(gain + 32 + d);
#pragma unroll
      for (int e = 0; e < 4; ++e) {
        float x1 = v[0][j][4 * g + e] * rstd * g1[e], x2 = v[1][j][4 * g + e] * rstd * g2[e];
        v[0][j][4 * g + e] = (x1 * c4[e] - x2 * s4[e]) * scale;
        v[1][j][4 * g + e] = (x2 * c4[e] + x1 * s4[e]) * scale;
      }
    }
  }
}

DI void norm96_rope_store(f32x16 (&v)[3][2], const float* __restrict__ gain, float scale, int pos0, const float* __restrict__ cs, const float* __restrict__ sn,
                          u16* __restrict__ wdst, char* wl) {
  const int lane = (tidx() & 63), r = lane & 31, h = lane >> 5;
#pragma unroll
  for (int j = 0; j < 2; ++j) {
    float ss = 0.f;
#pragma unroll
    for (int i = 0; i < 3; ++i)
#pragma unroll
      for (int e = 0; e < 16; ++e) ss += v[i][j][e] * v[i][j][e];
    ss = swapadd(ss);
    const float rstd = __builtin_amdgcn_rsqf(ss * (1.f / 96.f) + EPS);
    const int pos = pos0 + j * 32 + r;
#pragma unroll
    for (int i = 0; i < 3; ++i)
#pragma unroll
      for (int g = 0; g < 4; ++g) {
        f32x4 g4 = *(const f32x4*)(gain + i * 32 + 8 * g + 4 * h);
#pragma unroll
        for (int e = 0; e < 4; ++e) v[i][j][4 * g + e] *= rstd * g4[e];
      }
#pragma unroll
    for (int g = 0; g < 2; ++g) {
      f32x4 c4 = *(const f32x4*)(cs + pos * 16 + 8 * g + 4 * h), s4 = *(const f32x4*)(sn + pos * 16 + 8 * g + 4 * h);
#pragma unroll
      for (int e = 0; e < 4; ++e) {
        float a = v[2][j][4 * g + e], b = v[2][j][4 * g + e + 8];
        v[2][j][4 * g + e] = a * c4[e] - b * s4[e];
        v[2][j][4 * g + e + 8] = b * c4[e] + a * s4[e];
      }
    }
#pragma unroll
    for (int i = 0; i < 3; ++i)
#pragma unroll
      for (int e = 0; e < 16; ++e) v[i][j][e] *= scale;
  }
  store_wave_bf16<3>(v, wdst, QKVC_LD, wl);
}

DI float row_ssq(const u16* __restrict__ p, int nchunk) {
  float ss = 0.f;
#pragma unroll 2
  for (int c = 0; c < nchunk; ++c) {
    u32x4 d = *(const u32x4*)(p + c * 8);
    unsigned w[4] = {d[0], d[1], d[2], d[3]};
#pragma unroll
    for (int e = 0; e < 4; ++e) { float a = bflo(w[e]), b = bfhi(w[e]); ss += a * a + b * b; }
  }
  return ss;
}

namespace pg8 {
#define PG8_LAS __attribute__((address_space(3)))
typedef unsigned short bf16_t;
typedef short bf16x8 __attribute__((ext_vector_type(8)));
typedef float f32x4 __attribute__((ext_vector_type(4)));
typedef unsigned u32x4 __attribute__((ext_vector_type(4)));
constexpr int BM = 256, BK = 64, HALF = 128, HTB = HALF * BK * 2  , STAGE_BYTES = 8 * HTB, NXCD = 8, WGM = 8;

__host__ __device__ __forceinline__ int lds_byte(int r, int c) { const int st = (r >> 4) * 2 + (c >> 5), rr = r & 15, cc = c & 31, ob = rr * 64 + cc * 2; return st * 1024 + (ob ^ (((ob >> 9) & 1) << 5)); }
__host__ __device__ __forceinline__ void stage_rc(int b, int& R, int& C) { const int st = b / 1024, sb = b % 1024, swz = sb ^ (((sb >> 9) & 1) << 5); R = (st >> 1) * 16 + swz / 64; C = (st & 1) * 32 + (swz % 64) / 2; }
__host__ __device__ __forceinline__ int perm32(int rho) { const int n = rho >> 4, i = rho & 15; return 8 * (i >> 2) + 4 * n + (i & 3); }

struct Unit { int pm, pn; };
struct Gemm { const bf16_t* A; const bf16_t* Bt; int M, N, K; };
struct StaticOrder {
    int nM, nN, nwg, G, c;
    __host__ __device__ void init(int M, int N, int G_, int c_) { nM = M / BM; nN = N / BM; nwg = nM * nN; G = G_; c = c_; }
    __host__ __device__ bool next(int i, Unit& u) const {
        const long L = (long)i * G + c; if (L >= nwg) return false;
        int wgid = (int)L; { const int q = nwg / NXCD, r = nwg % NXCD, xcd = wgid % NXCD, off = wgid / NXCD; wgid = (xcd < r ? xcd * (q + 1) : r * (q + 1) + (xcd - r) * q) + off; }
        const int nig = WGM * nN, gid = wgid / nig, fm = gid * WGM, gsz = (nM - fm) < WGM ? (nM - fm) : WGM;
        u.pm = fm + ((wgid % nig) % gsz); u.pn = (wgid % nig) / gsz; return true;
    }
    __device__ __forceinline__ void a_ready(const Unit&) const {}
    __device__ __forceinline__ void done(const Unit&) const {}
};
template <class Epi, class Sched, bool STAMP = false>
__device__ __forceinline__ void gemm_phase(PG8_LAS unsigned char* lds, const Gemm g, const Sched& S, const Epi& E, unsigned long long* stamps) {
    const int tid = tidx(), wid = __builtin_amdgcn_readfirstlane(tid >> 6), lane = tid & 63, wr = wid >> 2, wc = wid & 3, fr = lane & 15, fq = lane >> 4;
    const int K = g.K, nt = K / BK;
    int ts_lo = 0, ts_hi = 0, nts = 0; const unsigned long long rt_entry = STAMP ? (unsigned long long)wall_clock64() : 0ull;
#define PG8_STAMP() do { if (STAMP && wid == 0 && nts < 64) { const unsigned long long _c = (unsigned long long)clock64(); \
        ts_lo = (lane == nts) ? (int)(unsigned)_c : ts_lo; ts_hi = (lane == nts) ? (int)(unsigned)(_c >> 32) : ts_hi; ++nts; } } while (0)
    PG8_STAMP();
    unsigned voffA[2], voffB[2];
#pragma unroll
    for (int i = 0; i < 2; ++i) { int R, C; stage_rc(tid * 16 + i * 8192, R, C); const int Rb = Epi::PERM ? ((R & ~31) + perm32(R & 31)) : R;
        voffA[i] = (unsigned)(R * K + C) * 2u; voffB[i] = (unsigned)(Rb * K + C) * 2u; }
    const size_t kstep = (size_t)(BK * 2);
    const size_t hstep = (size_t)HALF * K * 2;
    const size_t tstep = 2 * hstep;
    const unsigned ldsw = (unsigned)wid * 1024u;
    const int aoff = lds_byte(wr * 64 + fr, fq * 8), boff = lds_byte(wc * 32 + fr, fq * 8);
#define PG8_SA(b, h) (((b) * 2 + (h)) * HTB)
#define PG8_SB(b, h) ((4 + (b) * 2 + (h)) * HTB)
#define PG8_STAGE(bufoff, gbase, voff) do { _Pragma("unroll") for (int _i = 0; _i < 2; ++_i) \
        __builtin_amdgcn_global_load_lds((const unsigned*)((const char*)(gbase) + (voff)[_i]), (PG8_LAS unsigned*)(lds + (bufoff) + ldsw + _i * 8192), 16, 0, 0); } while (0)
#define PG8_LDA(dst, b, h) do { _Pragma("unroll") for (int m = 0; m < 4; ++m) _Pragma("unroll") for (int k = 0; k < 2; ++k) dst[m][k] = *(const PG8_LAS bf16x8*)(lds + PG8_SA(b, h) + aoff + m * 2048 + k * 1024); } while (0)
#define PG8_LDB(dst, b, h) do { _Pragma("unroll") for (int n = 0; n < 2; ++n) _Pragma("unroll") for (int k = 0; k < 2; ++k) dst[n][k] = *(const PG8_LAS bf16x8*)(lds + PG8_SB(b, h) + boff + n * 2048 + k * 1024); } while (0)
#define PG8_MMA(ai, bj, At, Bt) do { __builtin_amdgcn_s_setprio(1); _Pragma("unroll") for (int m = 0; m < 4; ++m) _Pragma("unroll") for (int n = 0; n < 2; ++n) _Pragma("unroll") for (int k = 0; k < 2; ++k) \
        acc[ai][bj][m][n] = __builtin_amdgcn_mfma_f32_16x16x32_bf16(Bt[n][k], At[m][k], acc[ai][bj][m][n], 0, 0, 0); __builtin_amdgcn_s_setprio(0); } while (0)
#define PG8_WAIT_V(n) asm volatile("s_waitcnt vmcnt(" #n ")" ::: "memory")
#define PG8_WAIT_L(n) asm volatile("s_waitcnt lgkmcnt(" #n ")" ::: "memory")
#define PG8_BAR __builtin_amdgcn_s_barrier()
#define PG8_SCHED __builtin_amdgcn_sched_barrier(0)
    Unit cur, nxt; int ui = 0;
    if (!S.next(0, cur)) return;
    f32x4 acc[2][2][4][2];
#pragma unroll
    for (int a = 0; a < 2; ++a)
#pragma unroll
        for (int b = 0; b < 2; ++b)
#pragma unroll
            for (int m = 0; m < 4; ++m)
#pragma unroll
                for (int n = 0; n < 2; ++n) acc[a][b][m][n] = (f32x4){0.f, 0.f, 0.f, 0.f};
    bf16x8 At[4][2], B0[2][2], B1[2][2];
    const char* cA = (const char*)g.A + (size_t)cur.pm * tstep; const char* cB = (const char*)g.Bt + (size_t)cur.pn * tstep;
    S.a_ready(cur);
    PG8_STAGE(PG8_SB(0, 0), cB, voffB); PG8_STAGE(PG8_SA(0, 0), cA, voffA); PG8_STAGE(PG8_SB(0, 1), cB + hstep, voffB); PG8_STAGE(PG8_SA(0, 1), cA + hstep, voffA);
    if (wr == 1) PG8_BAR;
    PG8_WAIT_V(4); PG8_BAR;
    PG8_STAGE(PG8_SB(1, 0), cB + kstep, voffB); PG8_STAGE(PG8_SA(1, 0), cA + kstep, voffA); PG8_STAGE(PG8_SB(1, 1), cB + hstep + kstep, voffB);
    PG8_WAIT_V(6); PG8_BAR;
    PG8_STAMP();
    for (;;) {
        const bool has_next = S.next(ui + 1, nxt);
        const char* nA = has_next ? (const char*)g.A + (size_t)nxt.pm * tstep : cA; const char* nB = has_next ? (const char*)g.Bt + (size_t)nxt.pn * tstep : cB;
        for (int t = 0; t < nt; t += 2) {
            const bool last = (t == nt - 2);
            const char* a1 = cA + (size_t)(t + 1) * kstep;
            const char* a2 = last ? nA : cA + (size_t)(t + 2) * kstep; const char* b2 = last ? nB : cB + (size_t)(t + 2) * kstep;
            const char* a3 = a2 + kstep; const char* b3 = b2 + kstep;
            if (last && has_next) S.a_ready(nxt);
            PG8_LDB(B0, 0, 0); PG8_SCHED; PG8_LDA(At, 0, 0); PG8_STAGE(PG8_SA(1, 1), a1 + hstep, voffA);
            PG8_WAIT_L(8); PG8_BAR; PG8_WAIT_L(0); PG8_MMA(0, 0, At, B0); PG8_BAR; PG8_SCHED;
            PG8_LDB(B1, 0, 1); PG8_STAGE(PG8_SB(0, 0), b2, voffB);
            PG8_BAR; PG8_WAIT_L(0); PG8_MMA(0, 1, At, B1); PG8_BAR;
            PG8_LDA(At, 0, 1); PG8_STAGE(PG8_SA(0, 0), a2, voffA);
            PG8_BAR; PG8_WAIT_L(0); PG8_MMA(1, 0, At, B0); PG8_BAR; PG8_SCHED;
            PG8_STAGE(PG8_SB(0, 1), b2 + hstep, voffB);
            PG8_WAIT_V(6); PG8_BAR; PG8_MMA(1, 1, At, B1); PG8_BAR;
            PG8_LDB(B0, 1, 0); PG8_SCHED; PG8_LDA(At, 1, 0); PG8_STAGE(PG8_SA(0, 1), a2 + hstep, voffA);
            PG8_WAIT_L(8); PG8_BAR; PG8_WAIT_L(0); PG8_MMA(0, 0, At, B0); PG8_BAR; PG8_SCHED;
            PG8_LDB(B1, 1, 1); PG8_STAGE(PG8_SB(1, 0), b3, voffB);
            PG8_BAR; PG8_WAIT_L(0); PG8_MMA(0, 1, At, B1); PG8_BAR;
            PG8_LDA(At, 1, 1); PG8_STAGE(PG8_SA(1, 0), a3, voffA);
            PG8_BAR; PG8_WAIT_L(0); PG8_MMA(1, 0, At, B0); PG8_BAR; PG8_SCHED;
            PG8_STAGE(PG8_SB(1, 1), b3 + hstep, voffB);
            PG8_WAIT_V(6); PG8_BAR; PG8_MMA(1, 1, At, B1); PG8_BAR;
        }
        PG8_STAMP();
        if constexpr (!Epi::AFTER_DRAIN) { E(acc, cur, wr, wc, fr, fq); S.done(cur); }
        PG8_STAMP();
        if (!has_next) break;
#pragma unroll
        for (int a = 0; a < 2; ++a)
#pragma unroll
            for (int b = 0; b < 2; ++b)
#pragma unroll
                for (int m = 0; m < 4; ++m)
#pragma unroll
                    for (int n = 0; n < 2; ++n) acc[a][b][m][n] = (f32x4){0.f, 0.f, 0.f, 0.f};
        cur = nxt; cA = nA; cB = nB; ++ui;
    }
    PG8_WAIT_V(0);
    if (wr == 0) PG8_BAR;
    PG8_BAR;
    if constexpr (Epi::AFTER_DRAIN) { E.fused(acc, cur, wr, wc, fr, fq, lds, wid, lane); S.done(cur); }
    PG8_STAMP();
    if (STAMP && wid == 0) { stamps[lane] = lane < nts ? (((unsigned long long)(unsigned)ts_hi << 32) | (unsigned)ts_lo) : 0ull;
        if (lane == 62) stamps[62] = rt_entry; if (lane == 63) stamps[63] = (unsigned long long)wall_clock64(); }
#undef PG8_STAMP
#undef PG8_SA
#undef PG8_SB
#undef PG8_STAGE
#undef PG8_LDA
#undef PG8_LDB
#undef PG8_MMA
#undef PG8_WAIT_V
#undef PG8_WAIT_L
#undef PG8_BAR
#undef PG8_SCHED
}
}

DI float quadsum(float x) {
  auto rr = __builtin_amdgcn_permlane16_swap(__float_as_uint(x), __float_as_uint(x), false, false);
  x = __uint_as_float(rr[0]) + __uint_as_float(rr[1]);
  return swapadd(x);
}
struct EpiP1 {
  static constexpr bool PERM = true, AFTER_DRAIN = false;
  u16* qkv; const float* cs; const float* sn; const float* const* in; int layer; unsigned char* gate;
  DI void operator()(const pg8::f32x4 (&acc)[2][2][4][2], const pg8::Unit& u, int wr, int wc, int fr_, int fq_) const {
    const int lane = tidx() & 63, fr = lane & 15, fq = lane >> 4;
    if (u.pn >= 20) {
#pragma unroll
      for (int ai = 0; ai < 2; ++ai)
#pragma unroll
        for (int m = 0; m < 4; ++m) {
          const int row = u.pm * 256 + ai * 128 + wr * 64 + m * 16 + fr;
          unsigned char* gp = gate + (size_t)row * 4096 + (u.pn - 20) * 256 + wc * 32 + 8 * fq;
#pragma unroll
          for (int bj = 0; bj < 2; ++bj) {
            unsigned w2[2];
#pragma unroll
            for (int n = 0; n < 2; ++n) {
              unsigned wv = 0u;
#pragma unroll
              for (int e = 0; e < 4; ++e) {
                const float sg = __builtin_amdgcn_rcpf(1.f + __builtin_amdgcn_exp2f(-acc[ai][bj][m][n][e] * LOG2E));
                wv |= ((unsigned)(sg * 255.f + 0.5f)) << (8 * e);
              }
              w2[n] = wv;
            }
            u32x2 wq = {w2[0], w2[1]};
            *(u32x2*)(gp + bj * 128) = wq;
          }
        }
      return;
    }
    const int n64 = u.pn * 4 + wc;
    const float* gain = nullptr; float scale = 1.f;
    if (n64 < 8) { gain = in[5] + layer * 64; scale = QS64; }
    else if (n64 < 16) { gain = in[6] + layer * 64; }
    else if (n64 < 24) {}
    else if (n64 < 60) {
      int tt = n64 - 24, g = tt / 12, jj = (tt % 12) >> 2;
      if (jj == 0) { gain = in[9] + (layer * 3 + g) * 64; scale = QS64; }
      else if (jj == 1) { gain = in[10] + (layer * 3 + g) * 64; }
    }
    else if (n64 < 68) { gain = in[17] + layer * 64; scale = QS64; }
    else if (n64 < 70) { gain = in[18] + layer * 64; }
#pragma unroll
    for (int ai = 0; ai < 2; ++ai)
#pragma unroll
      for (int m = 0; m < 4; ++m) {
        const int row = u.pm * 256 + ai * 128 + wr * 64 + m * 16 + fr;
        f32x4 v[2][2];
#pragma unroll
        for (int bj = 0; bj < 2; ++bj)
#pragma unroll
          for (int n = 0; n < 2; ++n) v[bj][n] = acc[ai][bj][m][n];
        if (gain) {
          float ss = 0.f;
#pragma unroll
          for (int bj = 0; bj < 2; ++bj)
#pragma unroll
            for (int n = 0; n < 2; ++n)
#pragma unroll
              for (int e = 0; e < 4; ++e) ss += v[bj][n][e] * v[bj][n][e];
          ss = quadsum(ss);
          const float rstd = __builtin_amdgcn_rsqf(ss * (1.f / 64.f) + EPS);
          const int pos = row & (SEQ - 1);
#pragma unroll
          for (int n = 0; n < 2; ++n) {
            const int d = 8 * fq + 4 * n;
            f32x4 c4 = *(const f32x4*)(cs + pos * 32 + d), s4 = *(const f32x4*)(sn + pos * 32 + d);
            f32x4 g1 = *(const f32x4*)(gain + d), g2 = *(const f32x4*)(gain + 32 + d);
#pragma unroll
            for (int e = 0; e < 4; ++e) {
              float x1 = v[0][n][e] * rstd * g1[e], x2 = v[1][n][e] * rstd * g2[e];
              v[0][n][e] = (x1 * c4[e] - x2 * s4[e]) * scale;
              v[1][n][e] = (x2 * c4[e] + x1 * s4[e]) * scale;
            }
          }
        }
        u16* rowp = qkv + (size_t)row * NINP + n64 * 64 + 8 * fq;
#pragma unroll
        for (int bj = 0; bj < 2; ++bj) {
          u32x4 w = {cvtpk(v[bj][0][0], v[bj][0][1]), cvtpk(v[bj][0][2], v[bj][0][3]), cvtpk(v[bj][1][0], v[bj][1][1]), cvtpk(v[bj][1][2], v[bj][1][3])};
          *(u32x4*)(rowp + bj * 32) = w;
        }
      }
  }
};
struct EpiRes {
  static constexpr bool PERM = false, AFTER_DRAIN = false;
  const float* resid; float* out;
  DI void operator()(const pg8::f32x4 (&acc)[2][2][4][2], const pg8::Unit& u, int wr, int wc, int fr_, int fq_) const {
    const int lane = tidx() & 63, fr = lane & 15, fq = lane >> 4;
#pragma unroll
    for (int ai = 0; ai < 2; ++ai)
#pragma unroll
      for (int m = 0; m < 4; ++m) {
        const size_t o = (size_t)(u.pm * 256 + ai * 128 + wr * 64 + m * 16 + fr) * DM + u.pn * 256 + wc * 32 + 4 * fq;
#pragma unroll
        for (int bj = 0; bj < 2; ++bj)
#pragma unroll
          for (int n = 0; n < 2; ++n) {
            f32x4 x = *(const f32x4*)(resid + o + bj * 128 + n * 16);
            *(f32x4*)(out + o + bj * 128 + n * 16) = x + acc[ai][bj][m][n];
          }
      }
  }
};
struct EpiSwiglu {
  static constexpr bool PERM = true, AFTER_DRAIN = false;
  u16* act;
  DI void operator()(const pg8::f32x4 (&acc)[2][2][4][2], const pg8::Unit& u, int wr, int wc, int fr_, int fq_) const {
    const int lane = tidx() & 63, fr = lane & 15, fq = lane >> 4;
#pragma unroll
    for (int ai = 0; ai < 2; ++ai)
#pragma unroll
      for (int m = 0; m < 4; ++m) {
        const int row = u.pm * 256 + ai * 128 + wr * 64 + m * 16 + fr;
        float a[8];
#pragma unroll
        for (int n = 0; n < 2; ++n)
#pragma unroll
          for (int e = 0; e < 4; ++e) {
            float gte = acc[ai][0][m][n][e];
            a[4 * n + e] = gte * __builtin_amdgcn_rcpf(1.f + __builtin_amdgcn_exp2f(-gte * LOG2E)) * acc[ai][1][m][n][e];
          }
        u32x4 w = {cvtpk(a[0], a[1]), cvtpk(a[2], a[3]), cvtpk(a[4], a[5]), cvtpk(a[6], a[7])};
        *(u32x4*)(act + (size_t)row * DFF + u.pn * 128 + wc * 32 + 8 * fq) = w;
      }
  }
};

DI void repack_tile(const float* __restrict__ src, const float* __restrict__ src2, int nsrc, u16* __restrict__ dst, int K, int n0, int k0, int mode,
                    const float* __restrict__ gain, char* lds) {
  float* tile = (float*)lds;
  const int tid = tidx();
  {
    const int nn = tid & 63, kk0 = tid >> 6;
    const int np = n0 + nn;
    const float* s = src; int col = np; bool valid = true;
    if (mode == 1) {
      const int rho = np & 255, lg = ((np >> 8) * 4 + ((rho >> 5) & 3)) * 64 + 32 * (rho >> 7) + (rho & 31);
      if (lg < 3840) col = lg; else if (lg < 4608) col = 4256 + (lg - 3840); else if (lg < 5024) col = 3840 + (lg - 4608); else valid = false;
    } else if (mode == 2) {
      const int rho = np & 255;
      col = (np >> 8) * 128 + (rho & 127);
      if (rho >= 128) s = src2;
    }
#pragma unroll
    for (int i = 0; i < 8; ++i) {
      int kk = kk0 + 8 * i;
      float v = valid ? s[(size_t)(k0 + kk) * nsrc + col] : 0.f;
      if (gain) v *= gain[k0 + kk];
      tile[kk * 65 + nn] = v;
    }
  }
  __syncthreads();
  {
    const int n = tid >> 3, kc = (tid & 7) * 8;
    float f[8];
#pragma unroll
    for (int i = 0; i < 8; ++i) f[i] = tile[(kc + i) * 65 + n];
    u32x4 w = {cvtpk(f[0], f[1]), cvtpk(f[2], f[3]), cvtpk(f[4], f[5]), cvtpk(f[6], f[7])};
    *(u32x4*)(dst + (size_t)(n0 + n) * K + k0 + kc) = w;
  }
  __syncthreads();
}

DI void sincos_acc(float ang, float& c, float& s) {
  double a = (double)ang;
  double t = a * 0.15915494309189535;
  double fr = t - rint(t);
  double x = fr * 6.283185307179586;
  double x2 = x * x;
  double ts = x, tc = 1.0, ssum = x, csum = 1.0;
  for (int n = 1; n <= 14; ++n) {
    tc *= -x2 / (double)((2 * n - 1) * (2 * n));
    ts *= -x2 / (double)((2 * n) * (2 * n + 1));
    csum += tc; ssum += ts;
  }
  c = (float)csum; s = (float)ssum;
}

__device__ __forceinline__ void phase_w(const Params& p, char* lds) {
  char* const ws = lws(p.ws);
  constexpr int PER_LAYER = 5200;
  for (int t = blockIdx.x; t < PER_LAYER * DEPTH; t += gridDim.x) {
    const int l = t / PER_LAYER; int u = t % PER_LAYER;
    if (u < 1280) {
      repack_tile(p.in[3] + (size_t)l * 1024 * 5024, nullptr, 5024, (u16*)(ws + OFF_WIN) + (size_t)l * NIN2 * 1024, 1024, (u >> 4) * 64, (u & 15) * 64, 1, nullptr, lds);
      continue;
    }
    u -= 1280;
    if (u < 1024) {
      repack_tile(p.in[4] + (size_t)l * 1024 * 4096, nullptr, 4096, (u16*)(ws + OFF_WIN) + ((size_t)l * NIN2 + NINP) * 1024, 1024, (u >> 4) * 64, (u & 15) * 64, 0, nullptr, lds);
      continue;
    }
    u -= 1024;
    if (u < 48) {
      repack_tile(p.in[13] + (size_t)l * 256 * 768, nullptr, 768, (u16*)(ws + OFF_WUQ) + (size_t)l * 768 * 256, 256, (u >> 2) * 64, (u & 3) * 64, 0, p.in[11] + l * 256, lds);
      continue;
    }
    u -= 48;
    if (u < 32) {
      repack_tile(p.in[14] + (size_t)l * 128 * 1024, nullptr, 1024, (u16*)(ws + OFF_WUKV) + (size_t)l * 1024 * 128, 128, (u >> 1) * 64, (u & 1) * 64, 0, p.in[12] + l * 128, lds);
      continue;
    }
    u -= 32;
    if (u < 448) {
      u16* wbr = (u16*)(ws + OFF_WBR) + (size_t)l * 1024 * 1792;
      if (u < 128) repack_tile(p.in[20] + (size_t)l * 512 * 1024, nullptr, 1024, wbr, 512, (u >> 3) * 64, (u & 7) * 64, 0, nullptr, lds);
      else if (u < 192) { u -= 128; repack_tile(p.in[21] + (size_t)l * 256 * 1024, nullptr, 1024, wbr + 1024 * 512, 256, (u >> 2) * 64, (u & 3) * 64, 0, nullptr, lds); }
      else if (u < 320) { u -= 192; repack_tile(p.in[22] + (size_t)l * 512 * 1024, nullptr, 1024, wbr + 1024 * 768, 512, (u >> 3) * 64, (u & 7) * 64, 0, nullptr, lds); }
      else { u -= 320; repack_tile(p.in[23] + (size_t)l * 512 * 1024, nullptr, 1024, wbr + 1024 * 1280, 512, (u >> 3) * 64, (u & 7) * 64, 0, nullptr, lds); }
      continue;
    }
    u -= 448;
    if (u < 256) {
      repack_tile(p.in[24] + (size_t)l * 1024 * 1024, nullptr, 1024, (u16*)(ws + OFF_WO) + (size_t)l * 1024 * 1024, 1024, (u >> 4) * 64, (u & 15) * 64, 0, nullptr, lds);
      continue;
    }
    u -= 256;
    if (u < 1408) {
      repack_tile(p.in[26] + (size_t)l * 1024 * DFF, p.in[27] + (size_t)l * 1024 * DFF, DFF, (u16*)(ws + OFF_WGU) + (size_t)l * NGU * 1024, 1024, (u >> 4) * 64, (u & 15) * 64, 2, nullptr, lds);
      continue;
    }
    u -= 1408;
    repack_tile(p.in[28] + (size_t)l * DFF * 1024, nullptr, 1024, (u16*)(ws + OFF_WDN) + (size_t)l * 1024 * DFF, DFF, (u / 44) * 64, (u % 44) * 64, 0, nullptr, lds);
  }
  const int gt = blockIdx.x * 512 + tidx(), ngt = gridDim.x * 512;
  float* c64 = (float*)(ws + OFF_COS64); float* s64 = (float*)(ws + OFF_SIN64);
  float* c32 = (float*)(ws + OFF_COS32); float* s32 = (float*)(ws + OFF_SIN32);
  for (int i = gt; i < SEQ * 32; i += ngt) {
    int pos = i >> 5, f = i & 31; float c, s;
    sincos_acc((float)pos * p.inv64[f], c, s);
    c64[i] = c; s64[i] = s;
  }
  for (int i = gt; i < SEQ * 16; i += ngt) {
    int pos = i >> 4, f = i & 15; float c, s;
    sincos_acc((float)pos * p.inv32[f], c, s);
    c32[i] = c; s32[i] = s;
  }
  if (blockIdx.x == 0)
    for (int i = tidx(); i < 3456; i += 512) __hip_atomic_store((unsigned*)(ws + OFF_BAR) + i, 0u, __ATOMIC_RELAXED, __HIP_MEMORY_SCOPE_AGENT);
  if (gt < DEPTH) {
    auto mxabs = [](const float* g_, int n_) { float m_ = 0.f; for (int i = 0; i < n_; ++i) m_ = fmaxf(m_, fabsf(g_[i])); return m_; };
    float* fl_ = (float*)(ws + OFF_LAM);
    const int l_ = gt;
    const float LIM = 60.f;
    fl_[2 + l_] = (8.f * LOG2E * mxabs(p.in[5] + l_ * 64, 64) * mxabs(p.in[6] + l_ * 64, 64) <= LIM) ? 1.f : 0.f;
    for (int g_ = 0; g_ < 3; ++g_)
      fl_[4 + l_ * 3 + g_] = (8.f * LOG2E * mxabs(p.in[9] + (l_ * 3 + g_) * 64, 64) * mxabs(p.in[10] + (l_ * 3 + g_) * 64, 64) <= LIM) ? 1.f : 0.f;
    fl_[10 + l_] = (9.7979590f * LOG2E * mxabs(p.in[15] + l_ * 96, 96) * mxabs(p.in[16] + l_ * 96, 96) <= LIM) ? 1.f : 0.f;
    fl_[12 + l_] = (8.f * LOG2E * mxabs(p.in[17] + l_ * 64, 64) * mxabs(p.in[18] + l_ * 64, 64) <= LIM) ? 1.f : 0.f;
    const float* lp = p.in[7] + gt * 256;
    float a = 0.f, b = 0.f;
    for (int i = 0; i < 64; ++i) { a += lp[i] * lp[64 + i]; b += lp[128 + i] * lp[192 + i]; }
    ((float*)(ws + OFF_LAM))[gt] = expf(a) - expf(b) + p.lam_init[gt];
  }
}

__device__ __forceinline__ void phase_norm(const float* __restrict__ x, const float* __restrict__ g, u16* __restrict__ xn) {
  const int lane = tidx() & 63, wid = wave_id();
  for (int row = blockIdx.x * 8 + wid; row < CT; row += gridDim.x * 8) {
    const f32x4* xr = (const f32x4*)(x + (size_t)row * DM);
    f32x4 v[4]; float ss = 0.f;
#pragma unroll
    for (int i = 0; i < 4; ++i) { v[i] = xr[lane + 64 * i]; ss += v[i][0] * v[i][0] + v[i][1] * v[i][1] + v[i][2] * v[i][2] + v[i][3] * v[i][3]; }
    ss = swapadd(ss);
#pragma unroll
    for (int o = 16; o >= 1; o >>= 1) ss += __int_as_float(__builtin_amdgcn_ds_bpermute((lane ^ o) << 2, __float_as_int(ss)));
    const float rstd = __builtin_amdgcn_rsqf(ss * (1.f / 1024.f) + EPS);
#pragma unroll
    for (int i = 0; i < 4; ++i) {
      f32x4 g4 = ((const f32x4*)g)[lane + 64 * i];
      u32x2 w = {cvtpk(v[i][0] * rstd * g4[0], v[i][1] * rstd * g4[1]), cvtpk(v[i][2] * rstd * g4[2], v[i][3] * rstd * g4[3])};
      *(u32x2*)(xn + (size_t)row * DM + (lane + 64 * i) * 4) = w;
    }
  }
}

__device__ __forceinline__ void phase_p1(const Params& p, int layer, char* lds) {
  char* const ws = lws(p.ws);
  pg8::Gemm g{(const u16*)(ws + OFF_XN), (const u16*)(ws + OFF_WIN) + (size_t)layer * NIN2 * 1024, CT, NIN2, 1024};
  pg8::StaticOrder S; S.init(CT, NIN2, gridDim.x, blockIdx.x);
  EpiP1 E{(u16*)(ws + OFF_QKV), (const float*)(ws + OFF_COS64), (const float*)(ws + OFF_SIN64), p.in, layer, (unsigned char*)(ws + OFF_GATE)};
  __syncthreads();
  pg8::gemm_phase<EpiP1, pg8::StaticOrder, false>((PG8_LAS unsigned char*)lds, g, S, E, nullptr);
}

__device__ __forceinline__ void phase_p1c(const Params& p, int layer, char* lds) {
  char* const ws = lws(p.ws);
  const u16* Wuq = (const u16*)(ws + OFF_WUQ) + (size_t)layer * 768 * 256;
  const u16* Wukv = (const u16*)(ws + OFF_WUKV) + (size_t)layer * 1024 * 128;
  const u16* qkv = (const u16*)(ws + OFF_QKV);
  u16* qc = (u16*)(ws + OFF_QKVC);
  const float* c32 = (const float*)(ws + OFF_COS32); const float* s32 = (const float*)(ws + OFF_SIN32);
  const int tid = tidx(), wid = wave_id(), wn = wid & 3, wm = wid >> 2;
  char* wl = lds + wid * WAVE_LDS;
  for (int t = blockIdx.x; t < 2 * 128; t += gridDim.x) {
    int nt, mt; tile_map(t, nt, mt);
    const int n0 = nt * 384, m0 = mt * 128;
    f32x16 acc[3][2];
    gemm_core<3>(acc, Wuq + (size_t)n0 * 256, 256, qkv + (size_t)m0 * NINP + 4608, NINP, 256, lds);
    const int lane2 = (tidx() & 63), r = lane2 & 31, h = lane2 >> 5;
#pragma unroll
    for (int j = 0; j < 2; ++j) {
      const int m = m0 + wm * 64 + j * 32 + r;
      float ss = swapadd(row_ssq(qkv + (size_t)m * NINP + 4608 + h * 128, 16));
      const float rq = __builtin_amdgcn_rsqf(ss * (1.f / 256.f) + EPS);
#pragma unroll
      for (int i = 0; i < 3; ++i)
#pragma unroll
        for (int e = 0; e < 16; ++e) acc[i][j][e] *= rq;
    }
    norm96_rope_store(acc, p.in[15] + layer * 96, QS96, (m0 + wm * 64) & (SEQ - 1), c32, s32, qc + (size_t)(m0 + wm * 64) * QKVC_LD + n0 + wn * 96, wl);
  }
  for (int t = blockIdx.x; t < 4 * 128; t += gridDim.x) {
    int nt, mt; tile_map(t, nt, mt);
    const int n0 = nt * 256, m0 = mt * 128;
    f32x16 acc[3][2];
    gemm_core<2, 3>(acc, Wukv + (size_t)n0 * 128, 128, qkv + (size_t)m0 * NINP + 4864, NINP, 128, lds);
    const int n64 = (n0 >> 6) + wn, head = n64 >> 1, isv = n64 & 1;
    const int lane2 = (tidx() & 63), r = lane2 & 31, h = lane2 >> 5;
#pragma unroll
    for (int j = 0; j < 2; ++j) {
      const int m = m0 + wm * 64 + j * 32 + r;
      float ss = swapadd(row_ssq(qkv + (size_t)m * NINP + 4864 + h * 64, 8));
      const float rk = __builtin_amdgcn_rsqf(ss * (1.f / 128.f) + EPS);
#pragma unroll
      for (int i = 0; i < 2; ++i)
#pragma unroll
        for (int e = 0; e < 16; ++e) acc[i][j][e] *= rk;
    }
    if (isv) {
      store_wave_bf16<2, 3>(acc, qc + (size_t)(m0 + wm * 64) * QKVC_LD + 1536 + head * 64, QKVC_LD, wl);
    } else {
      f32x16 (&y)[3][2] = acc;
#pragma unroll
      for (int j = 0; j < 2; ++j) {
        const int m = m0 + wm * 64 + j * 32 + r;
#pragma unroll
        for (int g = 0; g < 4; ++g) {
          u32x2 d = *(const u32x2*)(qkv + (size_t)m * NINP + 4992 + 8 * g + 4 * h);
          y[2][j][4 * g] = bflo(d[0]); y[2][j][4 * g + 1] = bfhi(d[0]); y[2][j][4 * g + 2] = bflo(d[1]); y[2][j][4 * g + 3] = bfhi(d[1]);
        }
      }
      norm96_rope_store(y, p.in[16] + layer * 96, 1.f, (m0 + wm * 64) & (SEQ - 1), c32, s32, qc + (size_t)(m0 + wm * 64) * QKVC_LD + 768 + head * 96, wl);
    }
  }
}

constexpr int QLDS_OFF = 77824, QLDS_WAVE = 64 * 144;
template <int DQK, int DV, int NKT, bool BANDED, bool QLDS = false, bool FAST = false>
DI void attn_loop(f32x16 (&O)[2][DV / 32], float (&mrun)[2], float (&lrun)[2], const bf16x8 (&qf)[2][DQK / 16],
                  const u16* __restrict__ k0p, const u16* __restrict__ k1p, size_t kld, const u16* __restrict__ vp, size_t vld,
                  int t0, int t1, bool wact, int qbase, int W, char* lds) {
  constexpr int KP = DQK * 2 + 16, VP = DV * 2 + 64;
  constexpr int KC = DQK / 8, VC = DV / 8;
  constexpr int KTOT = NKT * 64 * KC, VTOT = 64 * VC, TOT = KTOT + VTOT, NIT = (TOT + 511) / 512;
  constexpr int SB = NKT * 64 * KP + 64 * VP;
  constexpr float THR = 8.f;
  const int tid = tidx(), lane = tid & 63, r = lane & 31, h = lane >> 5;
  const int dk1 = NKT == 2 ? (int)(k1p - k0p) : 0, dvo = (int)(vp - k0p);
  const int ldi = (int)kld;
  int soff[NIT]; int doff[NIT]; bool sval[NIT];
#pragma unroll
  for (int it = 0; it < NIT; ++it) {
    const int c = tid + it * 512;
    const bool allK = (it + 1) * 512 <= KTOT, allV = it * 512 >= KTOT;
    const bool isK = allK ? true : (allV ? false : (c < KTOT));
    const int kt = c / (64 * KC), rem = c % (64 * KC), krow = rem / KC, kcol = rem % KC;
    const int c2 = c - KTOT, vrow = c2 / VC, vcol = c2 % VC;
    const int so_k = (kt ? dk1 : 0) + krow * ldi + kcol * 8, do_k = kt * 64 * KP + krow * KP + kcol * 16;
    const int so_v = dvo + vrow * ldi + vcol * 8, do_v = NKT * 64 * KP + vrow * VP + vcol * 16;
    soff[it] = isK ? so_k : so_v;
    doff[it] = isK ? do_k : do_v;
    sval[it] = ((it + 1) * 512 <= TOT) ? true : (c < TOT);
  }
  u32x4 rg[NIT];
#define SOFF_(it) ((NKT == 2 ? soff[(it) & ~1] : soff[it]) * 2)
#define SADD_(it) ((NKT == 2 && ((it) & 1)) ? ((it) == 1 ? dk1 * 2 : 32 * ldi * 2) : 0)
#define DOFF_(it) ((NKT == 2 && ((it) & 1)) ? doff[(it) & ~1] + ((it) == 1 ? 64 * KP : 32 * VP) : doff[it])
  const __amdgpu_buffer_rsrc_t krsrc = __builtin_amdgcn_make_buffer_rsrc((void*)k0p, 0, 0x7fffffff, 0x00020000);
  const int kaddr = r * KP + h * 16;
  const char* const qlds = lds + QLDS_OFF + wave_id() * QLDS_WAVE + r * 144 + h * 16;
  const int vaddr = NKT * 64 * KP + (4 * h + ((lane & 15) >> 2)) * VP + (((lane >> 4) & 1) * 16 + (lane & 3) * 4) * 2;
  if (t1 <= t0) return;
  __syncthreads();
#pragma unroll
  for (int it = 0; it < NIT; ++it) if (sval[it]) rg[it] = __builtin_amdgcn_raw_buffer_load_b128(krsrc, SOFF_(it), t0 * 128 * ldi + SADD_(it), 0);
#pragma unroll
  for (int it = 0; it < NIT; ++it) if (sval[it]) *(u32x4*)(lds + DOFF_(it)) = rg[it];
  __syncthreads();
#pragma nounroll
  for (int t = t0; t < t1; ++t) {
    const int buf = (t - t0) & 1;
    const bool more = t + 1 < t1;
    if (more && NKT == 1) {
#pragma unroll
      for (int it = 0; it < NIT; ++it) if (sval[it]) rg[it] = __builtin_amdgcn_raw_buffer_load_b128(krsrc, SOFF_(it), (t + 1) * 128 * ldi + SADD_(it), 0);
    }
    bool doit = wact;
    if (BANDED) doit = wact && (t * 64 + 63 >= qbase - W) && (t * 64 <= qbase + 63 + W);
    if (doit) {
      const char* base = lds + buf * SB;
      bf16x8 pf[2][4];
      if (NKT == 1) {
        f32x16 S[2][2];
#pragma unroll
        for (int j = 0; j < 2; ++j)
#pragma unroll
          for (int kb = 0; kb < 2; ++kb)
#pragma unroll
            for (int e = 0; e < 16; ++e) S[j][kb][e] = 0.f;
#pragma unroll
        for (int s = 0; s < DQK / 16; ++s)
#pragma unroll
          for (int kb = 0; kb < 2; ++kb) {
            bf16x8 kf = *(const bf16x8*)(base + kaddr + kb * 32 * KP + s * 32);
#pragma unroll
            for (int j = 0; j < 2; ++j) S[j][kb] = MFMA(kf, qf[j][s], S[j][kb]);
          }
#pragma unroll
        for (int j = 0; j < 2; ++j) {
          if (BANDED) {
            const int qi = qbase + j * 32 + r;
#pragma unroll
            for (int kb = 0; kb < 2; ++kb)
#pragma unroll
              for (int e = 0; e < 16; ++e) {
                int ki = t * 64 + kb * 32 + crow(e, h);
                int dd = qi - ki; dd = dd < 0 ? -dd : dd;
                if (dd > W) S[j][kb][e] = -1e30f;
              }
          }
          float ps = 0.f;
          if (FAST) {
#pragma unroll
            for (int kb = 0; kb < 2; ++kb)
#pragma unroll
              for (int e = 0; e < 16; ++e) { float pv = __builtin_amdgcn_exp2f(S[j][kb][e]); S[j][kb][e] = pv; ps += pv; }
          } else {
            float pmax = S[j][0][0];
#pragma unroll
            for (int e = 1; e < 16; ++e) pmax = fmaxf(pmax, S[j][0][e]);
#pragma unroll
            for (int e = 0; e < 16; ++e) pmax = fmaxf(pmax, S[j][1][e]);
            pmax = swapmax(pmax);
            if (!__all(pmax - mrun[j] <= THR)) {
              float mn = fmaxf(mrun[j], pmax);
              float alpha = __builtin_amdgcn_exp2f(mrun[j] - mn);
              mrun[j] = mn; lrun[j] *= alpha;
#pragma unroll
              for (int d = 0; d < DV / 32; ++d)
#pragma unroll
                for (int e = 0; e < 16; ++e) O[j][d][e] *= alpha;
            }
            const float mm = mrun[j];
#pragma unroll
            for (int kb = 0; kb < 2; ++kb)
#pragma unroll
              for (int e = 0; e < 16; ++e) { float pv = __builtin_amdgcn_exp2f(S[j][kb][e] - mm); S[j][kb][e] = pv; ps += pv; }
          }
          lrun[j] += ps;
#pragma unroll
          for (int ks = 0; ks < 4; ++ks) {
            const int kb = ks >> 1, b8 = (ks & 1) * 8;
            u32x4 w = {cvtpk(S[j][kb][b8], S[j][kb][b8 + 1]), cvtpk(S[j][kb][b8 + 2], S[j][kb][b8 + 3]),
                       cvtpk(S[j][kb][b8 + 4], S[j][kb][b8 + 5]), cvtpk(S[j][kb][b8 + 6], S[j][kb][b8 + 7])};
            pf[j][ks] = __builtin_bit_cast(bf16x8, w);
          }
        }
      } else {
#pragma unroll
        for (int j = 0; j < 2; ++j) {
          f32x16 S[2];
#pragma unroll
          for (int kb = 0; kb < 2; ++kb)
#pragma unroll
            for (int e = 0; e < 16; ++e) S[kb][e] = 0.f;
          {
            constexpr int NS = DQK / 16;
            const char* kbase = base + j * 64 * KP + kaddr;
            const char* qbase_l = qlds + j * 32 * 144;
#define A1_KF(s_, kb_) (*(const bf16x8*)(kbase + (kb_) * 32 * KP + (s_) * 32))
#define A1_QF(s_) (QLDS ? *(const bf16x8*)(qbase_l + (s_) * 32) : qf[j][(s_)])
            bf16x8 ka = A1_KF(0, 0), kb2 = A1_KF(0, 1), qa = A1_QF(0);
            __builtin_amdgcn_sched_barrier(0);
#pragma unroll
            for (int s2 = 0; s2 < NS; ++s2) {
              bf16x8 kn0, kn1, qn;
              if (s2 + 1 < NS) { kn0 = A1_KF(s2 + 1, 0); kn1 = A1_KF(s2 + 1, 1); qn = A1_QF(s2 + 1); }
              __builtin_amdgcn_sched_barrier(0);
              S[0] = MFMA(ka, qa, S[0]);
              S[1] = MFMA(kb2, qa, S[1]);
              __builtin_amdgcn_sched_barrier(0);
              if (s2 + 1 < NS) { ka = kn0; kb2 = kn1; qa = qn; }
            }
#undef A1_KF
#undef A1_QF
          }
          float ps = 0.f;
          if (FAST) {
#pragma unroll
            for (int kb = 0; kb < 2; ++kb)
#pragma unroll
              for (int e = 0; e < 16; ++e) { float pv = __builtin_amdgcn_exp2f(S[kb][e]); S[kb][e] = pv; ps += pv; }
          } else {
            float pmax = S[0][0];
#pragma unroll
            for (int e = 1; e < 16; ++e) pmax = fmaxf(pmax, S[0][e]);
#pragma unroll
            for (int e = 0; e < 16; ++e) pmax = fmaxf(pmax, S[1][e]);
            pmax = swapmax(pmax);
            if (!__all(pmax - mrun[j] <= THR)) {
              float mn = fmaxf(mrun[j], pmax);
              float alpha = __builtin_amdgcn_exp2f(mrun[j] - mn);
              mrun[j] = mn; lrun[j] *= alpha;
#pragma unroll
              for (int d = 0; d < DV / 32; ++d)
#pragma unroll
                for (int e = 0; e < 16; ++e) O[j][d][e] *= alpha;
            }
            const float mm = mrun[j];
#pragma unroll
            for (int kb = 0; kb < 2; ++kb)
#pragma unroll
              for (int e = 0; e < 16; ++e) { float pv = __builtin_amdgcn_exp2f(S[kb][e] - mm); S[kb][e] = pv; ps += pv; }
          }
          lrun[j] += ps;
#pragma unroll
          for (int ks = 0; ks < 4; ++ks) {
            const int kb = ks >> 1, b8 = (ks & 1) * 8;
            u32x4 w = {cvtpk(S[kb][b8], S[kb][b8 + 1]), cvtpk(S[kb][b8 + 2], S[kb][b8 + 3]),
                       cvtpk(S[kb][b8 + 4], S[kb][b8 + 5]), cvtpk(S[kb][b8 + 6], S[kb][b8 + 7])};
            pf[j][ks] = __builtin_bit_cast(bf16x8, w);
          }
          {
            constexpr int ND = DV / 32, NV = 4 * ND;
            const char* vbase = base + vaddr;
            auto vread = [&](int i) -> bf16x8 {
              const char* va = vbase + (i / ND) * 16 * VP + (i % ND) * 64;
              s16x4 lo = __builtin_amdgcn_ds_read_tr16_b64_v4i16((__attribute__((address_space(3))) s16x4*)(va));
              s16x4 hi = __builtin_amdgcn_ds_read_tr16_b64_v4i16((__attribute__((address_space(3))) s16x4*)(va + 8 * VP));
              bf16x8 vf = {lo[0], lo[1], lo[2], lo[3], hi[0], hi[1], hi[2], hi[3]};
              return vf;
            };
            bf16x8 v0 = vread(0), v1 = vread(1);
            __builtin_amdgcn_sched_barrier(0);
#pragma unroll
            for (int i = 0; i < NV; i += 2) {
              O[j][i % ND] = MFMA(v0, pf[j][i / ND], O[j][i % ND]);
              if (i + 2 < NV) v0 = vread(i + 2);
              __builtin_amdgcn_sched_barrier(0);
              O[j][(i + 1) % ND] = MFMA(v1, pf[j][(i + 1) / ND], O[j][(i + 1) % ND]);
              if (i + 3 < NV) v1 = vread(i + 3);
              __builtin_amdgcn_sched_barrier(0);
            }
            if (j == 0 && more) {
#pragma unroll
              for (int it = 0; it < NIT; ++it) if (sval[it]) rg[it] = __builtin_amdgcn_raw_buffer_load_b128(krsrc, SOFF_(it), (t + 1) * 128 * ldi + SADD_(it), 0);
              __builtin_amdgcn_sched_barrier(0);
            }
          }
        }
      }
      if (NKT == 1) {
#pragma unroll
        for (int ks = 0; ks < 4; ++ks)
#pragma unroll
          for (int d = 0; d < DV / 32; ++d) {
            const char* va = base + vaddr + ks * 16 * VP + d * 64;
            s16x4 lo = __builtin_amdgcn_ds_read_tr16_b64_v4i16((__attribute__((address_space(3))) s16x4*)(va));
            s16x4 hi = __builtin_amdgcn_ds_read_tr16_b64_v4i16((__attribute__((address_space(3))) s16x4*)(va + 8 * VP));
            bf16x8 vf = {lo[0], lo[1], lo[2], lo[3], hi[0], hi[1], hi[2], hi[3]};
#pragma unroll
            for (int j = 0; j < 2; ++j) O[j][d] = MFMA(vf, pf[j][ks], O[j][d]);
          }
      }
    }
    if (more) {
      char* nb = lds + (buf ^ 1) * SB;
#pragma unroll
      for (int it = 0; it < NIT; ++it) if (sval[it]) *(u32x4*)(nb + DOFF_(it)) = rg[it];
    }
    __syncthreads();
  }
}

template <int NS>
DI void load_qf(bf16x8 (&qf)[NS], const u16* __restrict__ qrow) {
#pragma unroll
  for (int s = 0; s < NS; ++s) qf[s] = *(const bf16x8*)(qrow + s * 16);
}

template <int ND>
DI void store_o(const f32x16 (&o)[ND], float scale, u16* __restrict__ dst, int h) {
#pragma unroll
  for (int d = 0; d < ND; ++d)
#pragma unroll
    for (int g = 0; g < 4; ++g) {
      u32x2 w = {cvtpk(o[d][4 * g] * scale, o[d][4 * g + 1] * scale), cvtpk(o[d][4 * g + 2] * scale, o[d][4 * g + 3] * scale)};
      *(u32x2*)(dst + d * 32 + 8 * g + 4 * h) = w;
    }
}

DI void item_map(int idx, int nqb, int& sh, int& qb) {
  int xcd = idx & 7, slot = idx >> 3;
  sh = xcd * (32 / nqb) + slot / nqb;
  qb = slot % nqb;
}

__device__ __forceinline__ void attn_A(const Params& p, int layer, int idx, char* lds) {
  char* const ws = lws(p.ws);
  const int tid = tidx(), lane = tid & 63, wid = wave_id(), r = lane & 31, h = lane >> 5;
  int sh, qb; item_map(idx, 16, sh, qb);
  const int seq = sh >> 2, head = sh & 3;
  const u16* qkv = (const u16*)(ws + OFF_QKV) + (size_t)seq * SEQ * NINP;
  u16* outs = (u16*)(ws + OFF_OUTS) + (size_t)seq * SEQ * OUT_LD;
  const int q0 = qb * 256 + wid * 32;
  bf16x8 qf[2][4];
  __syncthreads();
#pragma unroll
  for (int j = 0; j < 2; ++j) {
    load_qf<4>(qf[j], qkv + (size_t)(q0 + r) * NINP + (head * 2 + j) * 64 + h * 8);
#pragma unroll
    for (int s = 0; s < 4; ++s) *(bf16x8*)(lds + QLDS_OFF + wid * QLDS_WAVE + (j * 32 + r) * 144 + h * 16 + s * 32) = qf[j][s];
  }
  lds_fence();
  const bool fast = ((const float*)(ws + OFF_LAM))[2 + layer] != 0.f;
  const float m0_ = fast ? 0.f : -1e29f;
  f32x16 O[2][4]; float mrun[2] = {m0_, m0_}, lrun[2] = {0.f, 0.f};
#pragma unroll
  for (int j = 0; j < 2; ++j)
#pragma unroll
    for (int d = 0; d < 4; ++d)
#pragma unroll
      for (int e = 0; e < 16; ++e) O[j][d][e] = 0.f;
  if (fast) attn_loop<64, 128, 2, false, true, true>(O, mrun, lrun, qf, qkv + 512 + (head * 2) * 64, qkv + 512 + (head * 2 + 1) * 64, NINP, qkv + 1024 + head * 128, NINP,
                               0, 64, true, 0, 0, lds);
  else attn_loop<64, 128, 2, false, true, false>(O, mrun, lrun, qf, qkv + 512 + (head * 2) * 64, qkv + 512 + (head * 2 + 1) * 64, NINP, qkv + 1024 + head * 128, NINP,
                               0, 64, true, 0, 0, lds);
  const int lane2 = (tidx() & 63), r2 = lane2 & 31, h2 = lane2 >> 5;
  const float lam = ((const float*)(ws + OFF_LAM))[layer];
  const float i0 = 1.f / swapadd(lrun[0]), i1 = lam / swapadd(lrun[1]);
  float ss = 0.f;
#pragma unroll
  for (int d = 0; d < 4; ++d)
#pragma unroll
    for (int e = 0; e < 16; ++e) { float o = O[0][d][e] * i0 - O[1][d][e] * i1; O[0][d][e] = o; ss += o * o; }
  ss = swapadd(ss);
  const float rstd = __builtin_amdgcn_rsqf(ss * (1.f / 128.f) + EPS) * p.oml[layer];
  const float* sg = p.in[8] + layer * 128;
  u16* dst = outs + (size_t)(q0 + r2) * OUT_LD + head * 128;
#pragma unroll
  for (int d = 0; d < 4; ++d)
#pragma unroll
    for (int g = 0; g < 4; ++g) {
      f32x4 g4 = *(const f32x4*)(sg + d * 32 + 8 * g + 4 * h2);
      u32x2 w = {cvtpk(O[0][d][4 * g] * rstd * g4[0], O[0][d][4 * g + 1] * rstd * g4[1]), cvtpk(O[0][d][4 * g + 2] * rstd * g4[2], O[0][d][4 * g + 3] * rstd * g4[3])};
      *(u32x2*)(dst + d * 32 + 8 * g + 4 * h2) = w;
    }
}

__device__ __forceinline__ void attn_C(const Params& p, int layer, int idx, char* lds) {
  char* const ws = lws(p.ws);
  const int tid = tidx(), lane = tid & 63, wid = wave_id(), r = lane & 31, h = lane >> 5;
  int sh, qb; item_map(idx, 8, sh, qb);
  const int seq = sh >> 3, head = sh & 7;
  const u16* qc = (const u16*)(ws + OFF_QKVC) + (size_t)seq * SEQ * QKVC_LD;
  u16* outs = (u16*)(ws + OFF_OUTS) + (size_t)seq * SEQ * OUT_LD;
  const int q0 = qb * 512 + wid * 64;
  bf16x8 qf[2][6];
  load_qf<6>(qf[0], qc + (size_t)(q0 + r) * QKVC_LD + head * 96 + h * 8);
  load_qf<6>(qf[1], qc + (size_t)(q0 + 32 + r) * QKVC_LD + head * 96 + h * 8);
  const bool fast = ((const float*)(ws + OFF_LAM))[10 + layer] != 0.f;
  const float m0_ = fast ? 0.f : -1e29f;
  f32x16 O[2][2]; float mrun[2] = {m0_, m0_}, lrun[2] = {0.f, 0.f};
#pragma unroll
  for (int j = 0; j < 2; ++j)
#pragma unroll
    for (int d = 0; d < 2; ++d)
#pragma unroll
      for (int e = 0; e < 16; ++e) O[j][d][e] = 0.f;
  if (fast) attn_loop<96, 64, 1, false, false, true>(O, mrun, lrun, qf, qc + 768 + head * 96, nullptr, QKVC_LD, qc + 1536 + head * 64, QKVC_LD, 0, 64, true, 0, 0, lds);
  else attn_loop<96, 64, 1, false, false, false>(O, mrun, lrun, qf, qc + 768 + head * 96, nullptr, QKVC_LD, qc + 1536 + head * 64, QKVC_LD, 0, 64, true, 0, 0, lds);
  const int lane2 = (tidx() & 63), r2 = lane2 & 31, h2 = lane2 >> 5;
#pragma unroll
  for (int j = 0; j < 2; ++j) {
    const float inv = 1.f / swapadd(lrun[j]);
    store_o<2>(O[j], inv, outs + (size_t)(q0 + j * 32 + r2) * OUT_LD + 768 + head * 64, h2);
  }
}

__device__ __forceinline__ void attn_D(const Params& p, int layer, int idx, char* lds) {
  char* const ws = lws(p.ws);
  const int tid = tidx(), lane = tid & 63, wid = wave_id(), r = lane & 31, h = lane >> 5;
  const int xcd = idx & 7, qb = idx >> 3;
  const int seq = xcd >> 1, kvh = xcd & 1;
  const u16* qkv = (const u16*)(ws + OFF_QKV) + (size_t)seq * SEQ * NINP;
  u16* outs = (u16*)(ws + OFF_OUTS) + (size_t)seq * SEQ * OUT_LD;
  const int qhead = kvh * 4 + (wid >> 1);
  const int q0 = qb * 128 + (wid & 1) * 64;
  bf16x8 qf[2][4];
  load_qf<4>(qf[0], qkv + (size_t)(q0 + r) * NINP + 3840 + qhead * 64 + h * 8);
  load_qf<4>(qf[1], qkv + (size_t)(q0 + 32 + r) * NINP + 3840 + qhead * 64 + h * 8);
  const bool fast = ((const float*)(ws + OFF_LAM))[12 + layer] != 0.f;
  const float m0_ = fast ? 0.f : -1e29f;
  f32x16 O[2][2]; float mrun[2] = {m0_, m0_}, lrun[2] = {0.f, 0.f};
#pragma unroll
  for (int j = 0; j < 2; ++j)
#pragma unroll
    for (int d = 0; d < 2; ++d)
#pragma unroll
      for (int e = 0; e < 16; ++e) O[j][d][e] = 0.f;
  int t0 = qb * 2 - 2; if (t0 < 0) t0 = 0;
  int t1 = qb * 2 + 4; if (t1 > 64) t1 = 64;
  if (fast) attn_loop<64, 64, 1, true, false, true>(O, mrun, lrun, qf, qkv + 4352 + kvh * 64, nullptr, NINP, qkv + 4480 + kvh * 64, NINP, t0, t1, true, q0, 128, lds);
  else attn_loop<64, 64, 1, true, false, false>(O, mrun, lrun, qf, qkv + 4352 + kvh * 64, nullptr, NINP, qkv + 4480 + kvh * 64, NINP, t0, t1, true, q0, 128, lds);
  const float sink2 = p.in[19][layer * 8 + qhead] * LOG2E;
  const int lane2 = (tidx() & 63), r2 = lane2 & 31, h2 = lane2 >> 5;
#pragma unroll
  for (int j = 0; j < 2; ++j) {
    const float l = swapadd(lrun[j]);
    const float mf = fmaxf(mrun[j], sink2);
    const float a = __builtin_amdgcn_exp2f(mrun[j] - mf);
    const float lf = l * a + __builtin_amdgcn_exp2f(sink2 - mf);
    store_o<2>(O[j], a / lf, outs + (size_t)(q0 + j * 32 + r2) * OUT_LD + 1280 + qhead * 64, h2);
  }
}

__device__ __forceinline__ void attn_B(const Params& p, int layer, int idx, char* lds) {
  char* const ws = lws(p.ws);
  const int tid = tidx(), lane = tid & 63, wid = wave_id(), r = lane & 31, h = lane >> 5;
  const int sub = idx & 31, sh = idx >> 5, seq = sh >> 2, head = sh & 3;
  int g, res, m0;
  if (sub < 8) { g = 0; res = 0; m0 = sub * 512; }
  else if (sub < 16) { g = 1; res = (sub - 8) >> 1; m0 = ((sub - 8) & 1) * 512; }
  else { g = 2; res = sub - 16; m0 = 0; }
  const int dil = g == 0 ? 1 : (g == 1 ? 4 : 16);
  const int Lg = SEQ / dil;
  int nact = (Lg - m0) / 64; if (nact > 8) nact = 8;
  const bool wact = wid < nact;
  const size_t ld = (size_t)dil * NINP;
  const u16* base = (const u16*)(ws + OFF_QKV) + ((size_t)seq * SEQ + res) * NINP + 1536 + g * 768 + head * 64;
  int q0 = m0 + wid * 64; if (!wact) q0 = m0;
  bf16x8 qf[2][4];
  load_qf<4>(qf[0], base + (size_t)(q0 + r) * ld + h * 8);
  load_qf<4>(qf[1], base + (size_t)(q0 + 32 + r) * ld + h * 8);
  const bool fast = ((const float*)(ws + OFF_LAM))[4 + layer * 3 + g] != 0.f;
  const float m0_ = fast ? 0.f : -1e29f;
  f32x16 O[2][2]; float mrun[2] = {m0_, m0_}, lrun[2] = {0.f, 0.f};
#pragma unroll
  for (int j = 0; j < 2; ++j)
#pragma unroll
    for (int d = 0; d < 2; ++d)
#pragma unroll
      for (int e = 0; e < 16; ++e) O[j][d][e] = 0.f;
  int t0 = m0 / 64 - 1; if (t0 < 0) t0 = 0;
  int t1 = m0 / 64 + 9; if (t1 > Lg / 64) t1 = Lg / 64;
  if (fast) attn_loop<64, 64, 1, true, false, true>(O, mrun, lrun, qf, base + 256, nullptr, ld, base + 512, ld, t0, t1, wact, q0, 64, lds);
  else attn_loop<64, 64, 1, true, false, false>(O, mrun, lrun, qf, base + 256, nullptr, ld, base + 512, ld, t0, t1, wact, q0, 64, lds);
  if (wact) {
    const int lane2 = (tidx() & 63), r2 = lane2 & 31, h2 = lane2 >> 5;
    u16* bo = (u16*)(ws + OFF_BO) + (size_t)g * CT * 256;
    float* blse = (float*)(ws + OFF_BLSE) + (size_t)g * CT * 4;
#pragma unroll
    for (int j = 0; j < 2; ++j) {
      const float l = swapadd(lrun[j]);
      const size_t tok = (size_t)seq * SEQ + (size_t)(q0 + j * 32 + r2) * dil + res;
      store_o<2>(O[j], 1.f / l, bo + tok * 256 + head * 64, h2);
      if (h2 == 0) blse[tok * 4 + head] = mrun[j] + __builtin_amdgcn_logf(l);
    }
  }
}

DI void combine_rows(char* ws, int m0) {
  const u16* bo = (const u16*)(ws + OFF_BO);
  const float* blse = (const float*)(ws + OFF_BLSE);
  u16* outs = (u16*)(ws + OFF_OUTS);
  for (int i = tidx(); i < 128 * 32; i += 512) {
    const int tok = m0 + (i >> 5), ch = i & 31, head = ch >> 3;
    float l0 = blse[(size_t)tok * 4 + head], l1 = blse[((size_t)CT + tok) * 4 + head], l2 = blse[((size_t)2 * CT + tok) * 4 + head];
    float mx = fmaxf(l0, fmaxf(l1, l2));
    float w0 = __builtin_amdgcn_exp2f(l0 - mx), w1 = __builtin_amdgcn_exp2f(l1 - mx), w2 = __builtin_amdgcn_exp2f(l2 - mx);
    float inv = 1.f / (w0 + w1 + w2); w0 *= inv; w1 *= inv; w2 *= inv;
    u32x4 a = *(const u32x4*)(bo + (size_t)tok * 256 + ch * 8);
    u32x4 b = *(const u32x4*)(bo + ((size_t)CT + tok) * 256 + ch * 8);
    u32x4 c = *(const u32x4*)(bo + ((size_t)2 * CT + tok) * 256 + ch * 8);
    u32x4 o;
#pragma unroll
    for (int e = 0; e < 4; ++e) {
      float lo = w0 * bflo(a[e]) + w1 * bflo(b[e]) + w2 * bflo(c[e]);
      float hi = w0 * bfhi(a[e]) + w1 * bfhi(b[e]) + w2 * bfhi(c[e]);
      o[e] = cvtpk(lo, hi);
    }
    *(u32x4*)(outs + (size_t)tok * OUT_LD + 512 + ch * 8) = o;
  }
  asm volatile("s_waitcnt vmcnt(0)" ::: "memory");
}

__device__ __forceinline__ void phase_merge(const Params& p, int layer, char* lds) {
  constexpr int AR = 256, STAGE = (AR + 128) * PITCH;
  char* const ws = lws(p.ws);
  const u16* Wbr = (const u16*)(ws + OFF_WBR) + (size_t)layer * 1024 * 1792;
  const u16* outs = (const u16*)(ws + OFF_OUTS);
  u16* merged = (u16*)(ws + OFF_MERGED);
  const int wid = wave_id(), wn = wid & 3, wm = wid >> 2;
  const __amdgpu_buffer_rsrc_t arsrc = __builtin_amdgcn_make_buffer_rsrc((void*)Wbr, 0, 0x7fffffff, 0x00020000);
  for (int t = blockIdx.x; t < 4 * 128; t += gridDim.x) {
    int nt, mt; tile_map(t, nt, mt);
    const int n0 = nt * 256, m0 = mt * 128;
    combine_rows(ws, m0);
    const int tid = tidx(), lane = tid & 63, r = lane & 31, h = lane >> 5;
    const int crow0 = tid >> 3, ccol = tid & 7;
    const __amdgpu_buffer_rsrc_t brsrc = __builtin_amdgcn_make_buffer_rsrc((void*)(outs + (size_t)m0 * OUT_LD), 0, 0x7fffffff, 0x00020000);
    const int bvo = (crow0 * OUT_LD + ccol * 8) * 2, bstep = 64 * OUT_LD * 2;
    const int wofs = crow0 * PITCH + ccol * 16;
    const int aoff = (wn * 64 + r) * PITCH + h * 16;
    const int boff = AR * PITCH + (wm * 64 + r) * PITCH + h * 16;
    f32x16 mg[2][2], acc[2][2];
#pragma unroll
    for (int i = 0; i < 2; ++i)
#pragma unroll
      for (int j = 0; j < 2; ++j)
#pragma unroll
        for (int e = 0; e < 16; ++e) { mg[i][j][e] = 0.f; acc[i][j][e] = 0.f; }
    u32x4 ra[4], rb[2];
    unsigned gw[2][2][4];
#define MG_BR(q) ((q) < 8 ? 0 : ((q) < 12 ? 1 : ((q) < 20 ? 2 : 3)))
#define MG_Q0(br) ((br) == 0 ? 0 : ((br) == 1 ? 8 : ((br) == 2 ? 12 : 20)))
#define MG_COFS(br) ((br) == 0 ? 0 : ((br) == 1 ? 512 : ((br) == 2 ? 768 : 1280)))
#define MG_LOAD(q) do { const int br_ = MG_BR(q), kt_ = (q) - MG_Q0(br_), Kb_ = br_ == 1 ? 256 : 512, cf_ = MG_COFS(br_); \
      const int avo_ = (1024 * cf_ + (n0 + crow0) * Kb_ + ccol * 8) * 2, ast_ = 64 * Kb_ * 2; \
      _Pragma("unroll") for (int i = 0; i < 4; ++i) ra[i] = __builtin_amdgcn_raw_buffer_load_b128(arsrc, avo_ + i * ast_, kt_ * 128, 0); \
      _Pragma("unroll") for (int i = 0; i < 2; ++i) rb[i] = __builtin_amdgcn_raw_buffer_load_b128(brsrc, bvo + i * bstep, cf_ * 2 + kt_ * 128, 0); } while (0)
#define MG_STORE(buf) do { char* nb_ = lds + (buf) * STAGE; \
      _Pragma("unroll") for (int i = 0; i < 4; ++i) *(u32x4*)(nb_ + wofs + i * 64 * PITCH) = ra[i]; \
      _Pragma("unroll") for (int i = 0; i < 2; ++i) *(u32x4*)(nb_ + AR * PITCH + wofs + i * 64 * PITCH) = rb[i]; } while (0)
#define MG_GATES(br) do { const unsigned char* gb_ = (const unsigned char*)(ws + OFF_GATE) + (br) * 1024 + n0 + wn * 64 + 4 * h; \
      _Pragma("unroll") for (int j = 0; j < 2; ++j) { const unsigned char* gr_ = gb_ + (size_t)(m0 + wm * 64 + j * 32 + r) * 4096; \
        _Pragma("unroll") for (int i = 0; i < 2; ++i) _Pragma("unroll") for (int g = 0; g < 4; ++g) gw[i][j][g] = *(const unsigned*)(gr_ + i * 32 + 8 * g); } } while (0)
    __syncthreads();
    MG_LOAD(0); MG_STORE(0); MG_GATES(0);
    __syncthreads();
#pragma nounroll
    for (int q = 0; q < 28; ++q) {
      const bool more = q + 1 < 28;
      if (more) MG_LOAD(q + 1);
      const char* base = lds + (q & 1) * STAGE;
      bf16x8 afA[2], bfA[2], afB[2], bfB[2];
#pragma unroll
      for (int i = 0; i < 2; ++i) afA[i] = *(const bf16x8*)(base + aoff + i * 32 * PITCH);
#pragma unroll
      for (int j = 0; j < 2; ++j) bfA[j] = *(const bf16x8*)(base + boff + j * 32 * PITCH);
      __builtin_amdgcn_sched_barrier(0);
#pragma unroll
      for (int s2 = 0; s2 < 4; s2 += 2) {
#pragma unroll
        for (int i = 0; i < 2; ++i) afB[i] = *(const bf16x8*)(base + aoff + i * 32 * PITCH + (s2 + 1) * 32);
#pragma unroll
        for (int j = 0; j < 2; ++j) bfB[j] = *(const bf16x8*)(base + boff + j * 32 * PITCH + (s2 + 1) * 32);
        __builtin_amdgcn_sched_barrier(0);
#pragma unroll
        for (int i = 0; i < 2; ++i)
#pragma unroll
          for (int j = 0; j < 2; ++j) acc[i][j] = MFMA(afA[i], bfA[j], acc[i][j]);
        __builtin_amdgcn_sched_barrier(0);
        if (s2 + 2 < 4) {
#pragma unroll
          for (int i = 0; i < 2; ++i) afA[i] = *(const bf16x8*)(base + aoff + i * 32 * PITCH + (s2 + 2) * 32);
#pragma unroll
          for (int j = 0; j < 2; ++j) bfA[j] = *(const bf16x8*)(base + boff + j * 32 * PITCH + (s2 + 2) * 32);
        }
        __builtin_amdgcn_sched_barrier(0);
#pragma unroll
        for (int i = 0; i < 2; ++i)
#pragma unroll
          for (int j = 0; j < 2; ++j) acc[i][j] = MFMA(afB[i], bfB[j], acc[i][j]);
        __builtin_amdgcn_sched_barrier(0);
      }
      if (q == 7 || q == 11 || q == 19 || q == 27) {
#pragma unroll
        for (int j = 0; j < 2; ++j)
#pragma unroll
          for (int i = 0; i < 2; ++i)
#pragma unroll
            for (int g = 0; g < 4; ++g)
#pragma unroll
              for (int e = 0; e < 4; ++e) {
                mg[i][j][4 * g + e] += (float)((gw[i][j][g] >> (8 * e)) & 255u) * (1.f / 255.f) * acc[i][j][4 * g + e];
                acc[i][j][4 * g + e] = 0.f;
              }
        if (more) { const int nbr = MG_BR(q + 1); MG_GATES(nbr); }
      }
      if (more) MG_STORE((q + 1) & 1);
      __syncthreads();
    }
#undef MG_BR
#undef MG_Q0
#undef MG_COFS
#undef MG_LOAD
#undef MG_STORE
#undef MG_GATES
    store_wave_bf16<2>(mg, merged + (size_t)(m0 + wm * 64) * 1024 + n0 + wn * 64, 1024, lds + wid * WAVE_LDS);
  }
}

__device__ __forceinline__ void phase_proj_res(const u16* Wt, const u16* act, int K, const float* resid, float* xout, char* lds) {
  pg8::Gemm g{act, Wt, CT, DM, K};
  pg8::StaticOrder S; S.init(CT, DM, gridDim.x, blockIdx.x);
  EpiRes E{resid, xout};
  __syncthreads();
  pg8::gemm_phase<EpiRes, pg8::StaticOrder, false>((PG8_LAS unsigned char*)lds, g, S, E, nullptr);
}

__device__ __forceinline__ void phase_ffn_up(const Params& p, int layer, char* lds) {
  char* const ws = lws(p.ws);
  pg8::Gemm g{(const u16*)(ws + OFF_XN), (const u16*)(ws + OFF_WGU) + (size_t)layer * NGU * 1024, CT, NGU, 1024};
  pg8::StaticOrder S; S.init(CT, NGU, gridDim.x, blockIdx.x);
  EpiSwiglu E{(u16*)(ws + OFF_ACT)};
  __syncthreads();
  pg8::gemm_phase<EpiSwiglu, pg8::StaticOrder, false>((PG8_LAS unsigned char*)lds, g, S, E, nullptr);
}

#define XB_TMO      128
#define XB_XCNT(j)  (256  + 64 * (j))
#define XB_XSUB(j)  (1280 + 64 * (j))
#define XB_XGEN(j)  (2304 + 64 * (j))
#define XB_TOP      3328
#define XB_TOPGEN   3392
#define XCD_BAR_WORDS 3456
#define XB_SPIN_CAP (1u << 20)
#define XB_LAS __attribute__((address_space(3)))
DI unsigned xb_ld(unsigned* p) { return __hip_atomic_load(p, __ATOMIC_RELAXED, __HIP_MEMORY_SCOPE_AGENT); }
DI unsigned xb_add(unsigned* p, unsigned v) { return __hip_atomic_fetch_add(p, v, __ATOMIC_RELAXED, __HIP_MEMORY_SCOPE_AGENT); }
DI unsigned xb_xcc_id() { return (unsigned)__builtin_amdgcn_s_getreg((3 << 11) | 20) & 0xFu; }
#define XB_SPIN(cond, bar) do { unsigned _sp = 0; while (cond) { __builtin_amdgcn_s_sleep(1); \
    if ((++_sp & 255u) == 0u) { if (xb_ld(&(bar)[XB_TMO])) break; if (_sp > XB_SPIN_CAP) { atomicAdd(&(bar)[XB_TMO], 1u); break; } } } } while (0)
struct XcdBarrier { unsigned* bar; unsigned x; volatile XB_LAS unsigned* st; };
DI XcdBarrier xcd_barrier_post(unsigned* bar, volatile XB_LAS unsigned* st) {
  XcdBarrier b; b.bar = bar; b.x = xb_xcc_id(); b.st = st;
  if (tidx() == 0) (void)xb_add(&bar[XB_XCNT(b.x)], 1u);
  return b;
}
DI void xcd_barrier_complete(unsigned* bar, unsigned x, unsigned& nloc, unsigned& nx) {
  const unsigned G = gridDim.x;
  unsigned sum, cnt, mine, sp = 0u;
  for (;;) {
    sum = 0u; cnt = 0u; mine = 0u;
#pragma unroll
    for (unsigned j = 0; j < 16; ++j) { const unsigned c = xb_ld(&bar[XB_XCNT(j)]); sum += c; cnt += (c > 0u) ? 1u : 0u; mine = (j == x) ? c : mine; }
    if (sum == G) break;
    __builtin_amdgcn_s_sleep(1);
    if ((++sp & 255u) == 0u) { if (xb_ld(&bar[XB_TMO])) break; if (sp > XB_SPIN_CAP) { atomicAdd(&bar[XB_TMO], 1u); break; } }
  }
  nloc = mine > 0u ? mine : 1u; nx = cnt > 0u ? cnt : 1u;
}
DI void xcd_barrier(const XcdBarrier& b) {
  asm volatile("s_waitcnt vmcnt(0)" ::: "memory");
  __syncthreads();
  if (tidx() == 0) {
    unsigned* bar = b.bar;
    __builtin_amdgcn_s_waitcnt(0);
    unsigned nloc = b.st[0], nx = b.st[1];
    if (nloc == 0u) { xcd_barrier_complete(bar, b.x, nloc, nx); b.st[0] = nloc; b.st[1] = nx; }
    const unsigned old = xb_add(&bar[XB_XSUB(b.x)], 1u);
    const unsigned gen = old / nloc;
    if (old + 1u == (gen + 1u) * nloc) {
      __builtin_amdgcn_fence(__ATOMIC_RELEASE, "agent");
      asm volatile("s_waitcnt vmcnt(0)" ::: "memory");
      const unsigned og = xb_add(&bar[XB_TOP], 1u);
      const unsigned tg = og / nx;
      if (og + 1u == (tg + 1u) * nx) xb_add(&bar[XB_TOPGEN], 1u);
      else XB_SPIN(xb_ld(&bar[XB_TOPGEN]) == tg, bar);
      __builtin_amdgcn_fence(__ATOMIC_ACQUIRE, "agent");
      xb_add(&bar[XB_XGEN(b.x)], 1u);
      asm volatile("s_waitcnt vmcnt(0)" ::: "memory");
    } else {
      XB_SPIN(xb_ld(&bar[XB_XGEN(b.x)]) == gen, bar);
      __builtin_amdgcn_fence(__ATOMIC_ACQUIRE, "agent");
      asm volatile("s_waitcnt vmcnt(0)" ::: "memory");
    }
  }
  __syncthreads();
}

DI void grid_barrier(unsigned* ctr, unsigned target) {
  asm volatile("s_waitcnt vmcnt(0)" ::: "memory");
  __syncthreads();
  if (threadIdx.x == 0) {
    __builtin_amdgcn_fence(__ATOMIC_RELEASE, "agent");
    asm volatile("s_waitcnt vmcnt(0)" ::: "memory");
    __hip_atomic_fetch_add(ctr, 1u, __ATOMIC_RELAXED, __HIP_MEMORY_SCOPE_AGENT);
    unsigned spins = 0;
    while (__hip_atomic_load(ctr, __ATOMIC_RELAXED, __HIP_MEMORY_SCOPE_AGENT) < target && ++spins < (1u << 26)) __builtin_amdgcn_s_sleep(2);
    __builtin_amdgcn_fence(__ATOMIC_ACQUIRE, "agent");
    asm volatile("s_waitcnt vmcnt(0)" ::: "memory");
  }
  __syncthreads();
}

extern "C" __global__ void __launch_bounds__(512, 2) mega(Params p) {
  extern __shared__ __attribute__((aligned(16))) char lds[];
  cg::grid_group grid = cg::this_grid();
  unsigned* const barp = (unsigned*)(p.ws + OFF_BAR);
  unsigned nbar = 0;
#define PWS lws(p.ws)
#define POUT ((float*)lws((char*)p.out))
  volatile XB_LAS unsigned* xst = (volatile XB_LAS unsigned*)(lds + (LDS_BYTES - 16));
  if (tidx() == 0) { xst[0] = 0u; xst[1] = 0u; }
  phase_w(p, lds);
  grid.sync();
  const XcdBarrier xb = xcd_barrier_post(barp, xst);
#pragma nounroll
  for (int ch = 0; ch < NCH; ++ch) {
#pragma nounroll
    for (int layer = 0; layer < DEPTH; ++layer) {
      {
        const float* xin = ch == 0 ? p.in[0] : p.in[1] + (size_t)(ch - 1) * CT * DM;
        const float* xcur = layer == 0 ? xin : POUT + (size_t)ch * CT * DM;
        phase_norm(xcur, p.in[2] + layer * DM, (u16*)(PWS + OFF_XN));
      }
      xcd_barrier(xb);
      phase_p1(p, layer, lds);
      xcd_barrier(xb);
      phase_p1c(p, layer, lds);
      xcd_barrier(xb);
#pragma nounroll
      for (int it = blockIdx.x; it < 1280; it += gridDim.x) {
        if (wave_id() >= 4) __builtin_amdgcn_s_setprio(1);
        if (it < 256) attn_A(p, layer, it, lds);
        else if (it < 512) attn_C(p, layer, it - 256, lds);
        else if (it < 768) attn_D(p, layer, it - 512, lds);
        else attn_B(p, layer, it - 768, lds);
        __builtin_amdgcn_s_setprio(0);
      }
      xcd_barrier(xb);
      phase_merge(p, layer, lds);
      xcd_barrier(xb);
      {
        const float* xin = ch == 0 ? p.in[0] : p.in[1] + (size_t)(ch - 1) * CT * DM;
        float* xo = POUT + (size_t)ch * CT * DM;
        const float* xcur = layer == 0 ? xin : xo;
        phase_proj_res((const u16*)(PWS + OFF_WO) + (size_t)layer * 1024 * 1024, (const u16*)(PWS + OFF_MERGED), 1024, xcur, xo, lds);
      }
      xcd_barrier(xb);
      {
        phase_norm(POUT + (size_t)ch * CT * DM, p.in[25] + layer * DM, (u16*)(PWS + OFF_XN));
      }
      xcd_barrier(xb);
      phase_ffn_up(p, layer, lds);
      xcd_barrier(xb);
      {
        float* xo = POUT + (size_t)ch * CT * DM;
        phase_proj_res((const u16*)(PWS + OFF_WDN) + (size_t)layer * 1024 * DFF, (const u16*)(PWS + OFF_ACT), DFF, xo, xo, lds);
      }
      xcd_barrier(xb);
    }
  }
}

extern "C" void kernel_launch(void* const* d_in, const int* in_sizes, int n_in, void* d_out, int out_size, void* d_ws, size_t ws_size, hipStream_t stream) {
  static int grid_blocks = 0;
  if (!grid_blocks) {
    int dev = 0, cus = 0, per_cu = 0;
    (void)hipGetDevice(&dev);
    (void)hipDeviceGetAttribute(&cus, hipDeviceAttributeMultiprocessorCount, dev);
    (void)hipFuncSetAttribute((const void*)mega, hipFuncAttributeMaxDynamicSharedMemorySize, (int)LDS_BYTES);
    (void)hipOccupancyMaxActiveBlocksPerMultiprocessor(&per_cu, mega, 512, LDS_BYTES);
    if (per_cu < 1) fprintf(stderr, "kernel_launch: occupancy query returned %d\n", per_cu);
    grid_blocks = cus > 0 ? cus : 256;
    if (ws_size < WS_END) fprintf(stderr, "kernel_launch: workspace too small: %zu < %zu\n", ws_size, (size_t)WS_END);
  }
  Params p{};
  for (int i = 0; i < 29; ++i) p.in[i] = (const float*)d_in[i];
  p.out = (float*)d_out;
  p.ws = (char*)d_ws;
  for (int i = 0; i < 32; ++i) p.inv64[i] = (float)pow(10000.0, -(double)i / 32.0);
  for (int i = 0; i < 16; ++i) p.inv32[i] = (float)pow(10000.0, -(double)i / 16.0);
  for (int l = 0; l < 2; ++l) {
    double li = 0.8 - 0.6 * exp(-0.3 * (double)l);
    p.lam_init[l] = (float)li;
    p.oml[l] = (float)(1.0 - li);
  }
  void* args[] = {&p};
  hipError_t e = hipLaunchCooperativeKernel((void*)mega, dim3(grid_blocks), dim3(512), args, LDS_BYTES, stream);
  if (e != hipSuccess) fprintf(stderr, "cooperative launch failed: %s (grid %d)\n", hipGetErrorString(e), grid_blocks);
}
```

```cpp
#include <hip/hip_runtime.h>
#include <hip/hip_cooperative_groups.h>
#include <cstdio>
#include <cmath>
namespace cg = cooperative_groups;

typedef unsigned short u16;
typedef short bf16x8 __attribute__((ext_vector_type(8)));
typedef short s16x4 __attribute__((ext_vector_type(4)));
typedef float f32x16 __attribute__((ext_vector_type(16)));
typedef float f32x4 __attribute__((ext_vector_type(4)));
typedef float f32x2 __attribute__((ext_vector_type(2)));
typedef unsigned u32x4 __attribute__((ext_vector_type(4)));
typedef unsigned u32x2 __attribute__((ext_vector_type(2)));
typedef __bf16 bf16x2_t __attribute__((ext_vector_type(2)));

#define DI __device__ __forceinline__
#define MFMA(a, b, c) __builtin_amdgcn_mfma_f32_32x32x16_bf16(a, b, c, 0, 0, 0)

constexpr int DM = 1024, SEQ = 4096, CT = 16384, NCH = 3, NINP = 5120, DFF = 2816, NGU = 5632, NIN2 = 9216;
constexpr int QKVC_LD = 2048, OUT_LD = 1792, DEPTH = 2;
constexpr float LOG2E = 1.4426950408889634f;
constexpr float QS64 = 0.125f * LOG2E, QS96 = 0.10206207261596575f * LOG2E;
constexpr float EPS = 1e-6f;
constexpr int PITCH = 144;
constexpr int WAVE_LDS = 17408;
constexpr size_t LDS_BYTES = 155648;

constexpr size_t al256(size_t x) { return (x + 255) / 256 * 256; }
constexpr size_t OFF_WIN = 0;
constexpr size_t OFF_WGATE = OFF_WIN + al256((size_t)DEPTH * NIN2 * 1024 * 2);
constexpr size_t OFF_WUQ = OFF_WGATE + 256;
constexpr size_t OFF_WUKV = OFF_WUQ + al256((size_t)DEPTH * 768 * 256 * 2);
constexpr size_t OFF_WBR = OFF_WUKV + al256((size_t)DEPTH * 1024 * 128 * 2);
constexpr size_t OFF_WO = OFF_WBR + al256((size_t)DEPTH * 1024 * 1792 * 2);
constexpr size_t OFF_WGU = OFF_WO + al256((size_t)DEPTH * 1024 * 1024 * 2);
constexpr size_t OFF_WDN = OFF_WGU + al256((size_t)DEPTH * NGU * 1024 * 2);
constexpr size_t OFF_COS64 = OFF_WDN + al256((size_t)DEPTH * 1024 * DFF * 2);
constexpr size_t OFF_SIN64 = OFF_COS64 + (size_t)SEQ * 32 * 4;
constexpr size_t OFF_COS32 = OFF_SIN64 + (size_t)SEQ * 32 * 4;
constexpr size_t OFF_SIN32 = OFF_COS32 + (size_t)SEQ * 16 * 4;
constexpr size_t OFF_LAM = OFF_SIN32 + (size_t)SEQ * 16 * 4;
constexpr size_t OFF_BAR = OFF_LAM + 256;
constexpr size_t OFF_XN = OFF_BAR + 16384;
constexpr size_t OFF_QKV = OFF_XN + (size_t)CT * 1024 * 2;
constexpr size_t OFF_QKVC = OFF_QKV + (size_t)CT * NINP * 2;
constexpr size_t OFF_OUTS = OFF_QKVC + (size_t)CT * QKVC_LD * 2;
constexpr size_t OFF_BO = OFF_OUTS + (size_t)CT * OUT_LD * 2;
constexpr size_t OFF_BLSE = OFF_BO + (size_t)3 * CT * 256 * 2;
constexpr size_t OFF_GATE = OFF_BLSE + (size_t)3 * CT * 4 * 4;
constexpr size_t WS_END = OFF_GATE + (size_t)CT * 4096;
constexpr size_t OFF_MERGED = OFF_QKV;
constexpr size_t OFF_ACT = OFF_QKV + (size_t)CT * 1024 * 2;

struct Params {
  const float* in[29];
  float* out;
  char* ws;
  float inv64[32];
  float inv32[16];
  float lam_init[2];
  float oml[2];
  int pad[2];
};

DI int crow(int reg, int h) { return (reg & 3) + 8 * (reg >> 2) + 4 * h; }
DI unsigned cvtpk(float lo, float hi) {
  f32x2 f = {lo, hi};
  bf16x2_t b = __builtin_convertvector(f, bf16x2_t);
  return __builtin_bit_cast(unsigned, b);
}
DI float bflo(unsigned u) { return __uint_as_float(u << 16); }
DI float bfhi(unsigned u) { return __uint_as_float(u & 0xffff0000u); }
DI float swapadd(float x) {
  auto rr = __builtin_amdgcn_permlane32_swap(__float_as_uint(x), __float_as_uint(x), false, false);
  return __uint_as_float(rr[0]) + __uint_as_float(rr[1]);
}
DI float swapmax(float x) {
  auto rr = __builtin_amdgcn_permlane32_swap(__float_as_uint(x), __float_as_uint(x), false, false);
  return fmaxf(__uint_as_float(rr[0]), __uint_as_float(rr[1]));
}
DI int opaque(int x) { asm volatile("" : "+v"(x)); return x; }
DI int tidx() { return opaque((int)threadIdx.x); }
DI int wave_id() { return __builtin_amdgcn_readfirstlane(tidx() >> 6); }
DI char* lws(char* w) { asm volatile("" : "+s"(w)); return w; }
DI void lds_fence() { asm volatile("s_waitcnt lgkmcnt(0)" ::: "memory"); }
DI void tile_map(int t, int& nt, int& mt) {
  int round = t >> 8, b = t & 255, xcd = b & 7, slot = b >> 3;
  nt = round * 2 + (slot & 1);
  mt = xcd * 16 + (slot >> 1);
}

template <int NB, int AN = NB, bool LOWREG = false>
DI void gemm_core(f32x16 (&acc)[AN][2], const u16* __restrict__ Ag, int lda, const u16* __restrict__ Bg, int ldb, int K, char* lds) {
  constexpr int AR = 128 * NB;
  constexpr int ACH = AR * 8 / 512;
  constexpr int STAGE = (AR + 128) * PITCH;
  const int tid = tidx(), lane = tid & 63, wid = wave_id(), r = lane & 31, h = lane >> 5;
  const int wn = wid & 3, wm = wid >> 2;
  const int crow0 = tid >> 3, ccol = tid & 7;
  const __amdgpu_buffer_rsrc_t arsrc = __builtin_amdgcn_make_buffer_rsrc((void*)Ag, 0, 0x7fffffff, 0x00020000);
  const __amdgpu_buffer_rsrc_t brsrc = __builtin_amdgcn_make_buffer_rsrc((void*)Bg, 0, 0x7fffffff, 0x00020000);
  const int avo = (crow0 * lda + ccol * 8) * 2, bvo = (crow0 * ldb + ccol * 8) * 2;
  const int astep = 64 * lda * 2, bstep = 64 * ldb * 2;
  const int wofs = crow0 * PITCH + ccol * 16;
  const int aoff = (wn * 32 * NB + r) * PITCH + h * 16;
  const int boff = AR * PITCH + (wm * 64 + r) * PITCH + h * 16;
  const int nk = K >> 6;
  u32x4 ra[ACH], rb[2];
#pragma unroll
  for (int i = 0; i < NB; ++i)
#pragma unroll
    for (int j = 0; j < 2; ++j)
#pragma unroll
      for (int e = 0; e < 16; ++e) acc[i][j][e] = 0.f;
  __syncthreads();
#pragma unroll
  for (int i = 0; i < ACH; ++i) ra[i] = __builtin_amdgcn_raw_buffer_load_b128(arsrc, avo + i * astep, 0, 0);
#pragma unroll
  for (int i = 0; i < 2; ++i) rb[i] = __builtin_amdgcn_raw_buffer_load_b128(brsrc, bvo + i * bstep, 0, 0);
#pragma unroll
  for (int i = 0; i < ACH; ++i) *(u32x4*)(lds + wofs + i * 64 * PITCH) = ra[i];
#pragma unroll
  for (int i = 0; i < 2; ++i) *(u32x4*)(lds + AR * PITCH + wofs + i * 64 * PITCH) = rb[i];
  __syncthreads();
#pragma nounroll
  for (int kt = 0; kt < nk; ++kt) {
    const bool more = kt + 1 < nk;
    if (more) {
#pragma unroll
      for (int i = 0; i < ACH; ++i) ra[i] = __builtin_amdgcn_raw_buffer_load_b128(arsrc, avo + i * astep, (kt + 1) * 128, 0);
#pragma unroll
      for (int i = 0; i < 2; ++i) rb[i] = __builtin_amdgcn_raw_buffer_load_b128(brsrc, bvo + i * bstep, (kt + 1) * 128, 0);
    }
    const char* base = lds + (kt & 1) * STAGE;
    if (LOWREG) {
#pragma unroll
      for (int s = 0; s < 4; ++s) {
        bf16x8 af[NB], bfr[2];
#pragma unroll
        for (int i = 0; i < NB; ++i) af[i] = *(const bf16x8*)(base + aoff + i * 32 * PITCH + s * 32);
#pragma unroll
        for (int j = 0; j < 2; ++j) bfr[j] = *(const bf16x8*)(base + boff + j * 32 * PITCH + s * 32);
#pragma unroll
        for (int i = 0; i < NB; ++i)
#pragma unroll
          for (int j = 0; j < 2; ++j) acc[i][j] = MFMA(af[i], bfr[j], acc[i][j]);
      }
    } else {
    bf16x8 afA[NB], bfA[2], afB[NB], bfB[2];
#pragma unroll
    for (int i = 0; i < NB; ++i) afA[i] = *(const bf16x8*)(base + aoff + i * 32 * PITCH);
#pragma unroll
    for (int j = 0; j < 2; ++j) bfA[j] = *(const bf16x8*)(base + boff + j * 32 * PITCH);
    __builtin_amdgcn_sched_barrier(0);
#pragma unroll
    for (int s = 0; s < 4; s += 2) {
#pragma unroll
      for (int i = 0; i < NB; ++i) afB[i] = *(const bf16x8*)(base + aoff + i * 32 * PITCH + (s + 1) * 32);
#pragma unroll
      for (int j = 0; j < 2; ++j) bfB[j] = *(const bf16x8*)(base + boff + j * 32 * PITCH + (s + 1) * 32);
      __builtin_amdgcn_sched_barrier(0);
#pragma unroll
      for (int i = 0; i < NB; ++i)
#pragma unroll
        for (int j = 0; j < 2; ++j) acc[i][j] = MFMA(afA[i], bfA[j], acc[i][j]);
      __builtin_amdgcn_sched_barrier(0);
      if (s + 2 < 4) {
#pragma unroll
        for (int i = 0; i < NB; ++i) afA[i] = *(const bf16x8*)(base + aoff + i * 32 * PITCH + (s + 2) * 32);
#pragma unroll
        for (int j = 0; j < 2; ++j) bfA[j] = *(const bf16x8*)(base + boff + j * 32 * PITCH + (s + 2) * 32);
      }
      __builtin_amdgcn_sched_barrier(0);
#pragma unroll
      for (int i = 0; i < NB; ++i)
#pragma unroll
        for (int j = 0; j < 2; ++j) acc[i][j] = MFMA(afB[i], bfB[j], acc[i][j]);
      __builtin_amdgcn_sched_barrier(0);
    }
    }
    if (more) {
      char* nb = lds + ((kt + 1) & 1) * STAGE;
#pragma unroll
      for (int i = 0; i < ACH; ++i) *(u32x4*)(nb + wofs + i * 64 * PITCH) = ra[i];
#pragma unroll
      for (int i = 0; i < 2; ++i) *(u32x4*)(nb + AR * PITCH + wofs + i * 64 * PITCH) = rb[i];
    }
    __syncthreads();
  }
}

template <int NB, int AN = NB>
DI void store_wave_bf16(const f32x16 (&v)[AN][2], u16* __restrict__ wdst, int ldd, char* wl) {
  constexpr int TP = NB * 64 + 16;
  const int lane = (tidx() & 63), r = lane & 31, h = lane >> 5;
#pragma unroll
  for (int i = 0; i < NB; ++i)
#pragma unroll
    for (int j = 0; j < 2; ++j)
#pragma unroll
      for (int g = 0; g < 4; ++g) {
        u32x2 w = {cvtpk(v[i][j][4 * g], v[i][j][4 * g + 1]), cvtpk(v[i][j][4 * g + 2], v[i][j][4 * g + 3])};
        *(u32x2*)(wl + (j * 32 + r) * TP + (i * 32 + 8 * g + 4 * h) * 2) = w;
      }
  lds_fence();
  constexpr int CPR = NB * 4;
#pragma unroll
  for (int it = 0; it < CPR; ++it) {
    int c = lane + 64 * it, row = c / CPR, ch = c % CPR;
    u32x4 d = *(const u32x4*)(wl + row * TP + ch * 16);
    *(u32x4*)(wdst + (size_t)row * ldd + ch * 8) = d;
  }
  lds_fence();
}

DI void store_wave_f32_res(const f32x16 (&v)[2][2], const float* __restrict__ res, float* __restrict__ wdst, char* wl) {
  constexpr int TP = 272;
  const int lane = (tidx() & 63), r = lane & 31, h = lane >> 5;
#pragma unroll
  for (int i = 0; i < 2; ++i)
#pragma unroll
    for (int j = 0; j < 2; ++j)
#pragma unroll
      for (int g = 0; g < 4; ++g) {
        f32x4 w = {v[i][j][4 * g], v[i][j][4 * g + 1], v[i][j][4 * g + 2], v[i][j][4 * g + 3]};
        *(f32x4*)(wl + (j * 32 + r) * TP + (i * 32 + 8 * g + 4 * h) * 4) = w;
      }
  lds_fence();
#pragma unroll
  for (int it = 0; it < 16; ++it) {
    int c = lane + 64 * it, row = c >> 4, ch = c & 15;
    f32x4 d = *(const f32x4*)(wl + row * TP + ch * 16);
    f32x4 x = *(const f32x4*)(res + (size_t)row * DM + ch * 4);
    d += x;
    *(f32x4*)(wdst + (size_t)row * DM + ch * 4) = d;
  }
  lds_fence();
}

DI void norm_rope64(f32x16 (&v)[2][2], const float* __restrict__ gain, float scale, int pos0, const float* __restrict__ cs, const float* __restrict__ sn) {
  const int lane = (tidx() & 63), r = lane & 31, h = lane >> 5;
#pragma unroll
  for (int j = 0; j < 2; ++j) {
    float ss = 0.f;
#pragma unroll
    for (int e = 0; e < 16; ++e) ss += v[0][j][e] * v[0][j][e] + v[1][j][e] * v[1][j][e];
    ss = swapadd(ss);
    const float rstd = __builtin_amdgcn_rsqf(ss * (1.f / 64.f) + EPS);
    const int pos = pos0 + j * 32 + r;
#pragma unroll
    for (int g = 0; g < 4; ++g) {
      const int d = 8 * g + 4 * h;
      f32x4 c4 = *(const f32x4*)(cs + pos * 32 + d), s4 = *(const f32x4*)(sn + pos * 32 + d);
      f32x4 g1 = *(const f32x4*)(gain + d), g2 = *(const f32x4*)(gain + 32 + d);
#pragma unroll
      for (int e = 0; e < 4; ++e) {
        float x1 = v[0][j][4 * g + e] * rstd * g1[e], x2 = v[1][j][4 * g + e] * rstd * g2[e];
        v[0][j][4 * g + e] = (x1 * c4[e] - x2 * s4[e]) * scale;
        v[1][j][4 * g + e] = (x2 * c4[e] + x1 * s4[e]) * scale;
      }
    }
  }
}

DI void norm96_rope_store(f32x16 (&v)[3][2], const float* __restrict__ gain, float scale, int pos0, const float* __restrict__ cs, const float* __restrict__ sn,
                          u16* __restrict__ wdst, char* wl) {
  const int lane = (tidx() & 63), r = lane & 31, h = lane >> 5;
#pragma unroll
  for (int j = 0; j < 2; ++j) {
    float ss = 0.f;
#pragma unroll
    for (int i = 0; i < 3; ++i)
#pragma unroll
      for (int e = 0; e < 16; ++e) ss += v[i][j][e] * v[i][j][e];
    ss = swapadd(ss);
    const float rstd = __builtin_amdgcn_rsqf(ss * (1.f / 96.f) + EPS);
    const int pos = pos0 + j * 32 + r;
#pragma unroll
    for (int i = 0; i < 3; ++i)
#pragma unroll
      for (int g = 0; g < 4; ++g) {
        f32x4 g4 = *(const f32x4*)(gain + i * 32 + 8 * g + 4 * h);
#pragma unroll
        for (int e = 0; e < 4; ++e) v[i][j][4 * g + e] *= rstd * g4[e];
      }
#pragma unroll
    for (int g = 0; g < 2; ++g) {
      f32x4 c4 = *(const f32x4*)(cs + pos * 16 + 8 * g + 4 * h), s4 = *(const f32x4*)(sn + pos * 16 + 8 * g + 4 * h);
#pragma unroll
      for (int e = 0; e < 4; ++e) {
        float a = v[2][j][4 * g + e], b = v[2][j][4 * g + e + 8];
        v[2][j][4 * g + e] = a * c4[e] - b * s4[e];
        v[2][j][4 * g + e + 8] = b * c4[e] + a * s4[e];
      }
    }
#pragma unroll
    for (int i = 0; i < 3; ++i)
#pragma unroll
      for (int e = 0; e < 16; ++e) v[i][j][e] *= scale;
  }
  store_wave_bf16<3>(v, wdst, QKVC_LD, wl);
}

DI float row_ssq(const u16* __restrict__ p, int nchunk) {
  float ss = 0.f;
#pragma unroll 2
  for (int c = 0; c < nchunk; ++c) {
    u32x4 d = *(const u32x4*)(p + c * 8);
    unsigned w[4] = {d[0], d[1], d[2], d[3]};
#pragma unroll
    for (int e = 0; e < 4; ++e) { float a = bflo(w[e]), b = bfhi(w[e]); ss += a * a + b * b; }
  }
  return ss;
}

namespace pg8 {
#define PG8_LAS __attribute__((address_space(3)))
typedef unsigned short bf16_t;
typedef short bf16x8 __attribute__((ext_vector_type(8)));
typedef float f32x4 __attribute__((ext_vector_type(4)));
typedef unsigned u32x4 __attribute__((ext_vector_type(4)));
constexpr int BM = 256, BK = 64, HALF = 128, HTB = HALF * BK * 2  , STAGE_BYTES = 8 * HTB, NXCD = 8, WGM = 8;

__host__ __device__ __forceinline__ int lds_byte(int r, int c) { const int st = (r >> 4) * 2 + (c >> 5), rr = r & 15, cc = c & 31, ob = rr * 64 + cc * 2; return st * 1024 + (ob ^ (((ob >> 9) & 1) << 5)); }
__host__ __device__ __forceinline__ void stage_rc(int b, int& R, int& C) { const int st = b / 1024, sb = b % 1024, swz = sb ^ (((sb >> 9) & 1) << 5); R = (st >> 1) * 16 + swz / 64; C = (st & 1) * 32 + (swz % 64) / 2; }
__host__ __device__ __forceinline__ int perm32(int rho) { const int n = rho >> 4, i = rho & 15; return 8 * (i >> 2) + 4 * n + (i & 3); }

struct Unit { int pm, pn; };
struct Gemm { const bf16_t* A; const bf16_t* Bt; int M, N, K; };
struct StaticOrder {
    int nM, nN, nwg, G, c;
    __host__ __device__ void init(int M, int N, int G_, int c_) { nM = M / BM; nN = N / BM; nwg = nM * nN; G = G_; c = c_; }
    __host__ __device__ bool next(int i, Unit& u) const {
        const long L = (long)i * G + c; if (L >= nwg) return false;
        int wgid = (int)L; { const int q = nwg / NXCD, r = nwg % NXCD, xcd = wgid % NXCD, off = wgid / NXCD; wgid = (xcd < r ? xcd * (q + 1) : r * (q + 1) + (xcd - r) * q) + off; }
        const int nig = WGM * nN, gid = wgid / nig, fm = gid * WGM, gsz = (nM - fm) < WGM ? (nM - fm) : WGM;
        u.pm = fm + ((wgid % nig) % gsz); u.pn = (wgid % nig) / gsz; return true;
    }
    __device__ __forceinline__ void a_ready(const Unit&) const {}
    __device__ __forceinline__ void done(const Unit&) const {}
};
template <class Epi, class Sched, bool STAMP = false>
__device__ __forceinline__ void gemm_phase(PG8_LAS unsigned char* lds, const Gemm g, const Sched& S, const Epi& E, unsigned long long* stamps) {
    const int tid = tidx(), wid = __builtin_amdgcn_readfirstlane(tid >> 6), lane = tid & 63, wr = wid >> 2, wc = wid & 3, fr = lane & 15, fq = lane >> 4;
    const int K = g.K, nt = K / BK;
    int ts_lo = 0, ts_hi = 0, nts = 0; const unsigned long long rt_entry = STAMP ? (unsigned long long)wall_clock64() : 0ull;
#define PG8_STAMP() do { if (STAMP && wid == 0 && nts < 64) { const unsigned long long _c = (unsigned long long)clock64(); \
        ts_lo = (lane == nts) ? (int)(unsigned)_c : ts_lo; ts_hi = (lane == nts) ? (int)(unsigned)(_c >> 32) : ts_hi; ++nts; } } while (0)
    PG8_STAMP();
    unsigned voffA[2], voffB[2];
#pragma unroll
    for (int i = 0; i < 2; ++i) { int R, C; stage_rc(tid * 16 + i * 8192, R, C); const int Rb = Epi::PERM ? ((R & ~31) + perm32(R & 31)) : R;
        voffA[i] = (unsigned)(R * K + C) * 2u; voffB[i] = (unsigned)(Rb * K + C) * 2u; }
    const size_t kstep = (size_t)(BK * 2);
    const size_t hstep = (size_t)HALF * K * 2;
    const size_t tstep = 2 * hstep;
    const unsigned ldsw = (unsigned)wid * 1024u;
    const int aoff = lds_byte(wr * 64 + fr, fq * 8), boff = lds_byte(wc * 32 + fr, fq * 8);
#define PG8_SA(b, h) (((b) * 2 + (h)) * HTB)
#define PG8_SB(b, h) ((4 + (b) * 2 + (h)) * HTB)
#define PG8_STAGE(bufoff, gbase, voff) do { _Pragma("unroll") for (int _i = 0; _i < 2; ++_i) \
        __builtin_amdgcn_global_load_lds((const unsigned*)((const char*)(gbase) + (voff)[_i]), (PG8_LAS unsigned*)(lds + (bufoff) + ldsw + _i * 8192), 16, 0, 0); } while (0)
#define PG8_LDA(dst, b, h) do { _Pragma("unroll") for (int m = 0; m < 4; ++m) _Pragma("unroll") for (int k = 0; k < 2; ++k) dst[m][k] = *(const PG8_LAS bf16x8*)(lds + PG8_SA(b, h) + aoff + m * 2048 + k * 1024); } while (0)
#define PG8_LDB(dst, b, h) do { _Pragma("unroll") for (int n = 0; n < 2; ++n) _Pragma("unroll") for (int k = 0; k < 2; ++k) dst[n][k] = *(const PG8_LAS bf16x8*)(lds + PG8_SB(b, h) + boff + n * 2048 + k * 1024); } while (0)
#define PG8_MMA(ai, bj, At, Bt) do { __builtin_amdgcn_s_setprio(1); _Pragma("unroll") for (int m = 0; m < 4; ++m) _Pragma("unroll") for (int n = 0; n < 2; ++n) _Pragma("unroll") for (int k = 0; k < 2; ++k) \
        acc[ai][bj][m][n] = __builtin_amdgcn_mfma_f32_16x16x32_bf16(Bt[n][k], At[m][k], acc[ai][bj][m][n], 0, 0, 0); __builtin_amdgcn_s_setprio(0); } while (0)
#define PG8_WAIT_V(n) asm volatile("s_waitcnt vmcnt(" #n ")" ::: "memory")
#define PG8_WAIT_L(n) asm volatile("s_waitcnt lgkmcnt(" #n ")" ::: "memory")
#define PG8_BAR __builtin_amdgcn_s_barrier()
#define PG8_SCHED __builtin_amdgcn_sched_barrier(0)
    Unit cur, nxt; int ui = 0;
    if (!S.next(0, cur)) return;
    f32x4 acc[2][2][4][2];
#pragma unroll
    for (int a = 0; a < 2; ++a)
#pragma unroll
        for (int b = 0; b < 2; ++b)
#pragma unroll
            for (int m = 0; m < 4; ++m)
#pragma unroll
                for (int n = 0; n < 2; ++n) acc[a][b][m][n] = (f32x4){0.f, 0.f, 0.f, 0.f};
    bf16x8 At[4][2], B0[2][2], B1[2][2];
    const char* cA = (const char*)g.A + (size_t)cur.pm * tstep; const char* cB = (const char*)g.Bt + (size_t)cur.pn * tstep;
    S.a_ready(cur);
    PG8_STAGE(PG8_SB(0, 0), cB, voffB); PG8_STAGE(PG8_SA(0, 0), cA, voffA); PG8_STAGE(PG8_SB(0, 1), cB + hstep, voffB); PG8_STAGE(PG8_SA(0, 1), cA + hstep, voffA);
    if (wr == 1) PG8_BAR;
    PG8_WAIT_V(4); PG8_BAR;
    PG8_STAGE(PG8_SB(1, 0), cB + kstep, voffB); PG8_STAGE(PG8_SA(1, 0), cA + kstep, voffA); PG8_STAGE(PG8_SB(1, 1), cB + hstep + kstep, voffB);
    PG8_WAIT_V(6); PG8_BAR;
    PG8_STAMP();
    for (;;) {
        const bool has_next = S.next(ui + 1, nxt);
        const char* nA = has_next ? (const char*)g.A + (size_t)nxt.pm * tstep : cA; const char* nB = has_next ? (const char*)g.Bt + (size_t)nxt.pn * tstep : cB;
        for (int t = 0; t < nt; t += 2) {
            const bool last = (t == nt - 2);
            const char* a1 = cA + (size_t)(t + 1) * kstep;
            const char* a2 = last ? nA : cA + (size_t)(t + 2) * kstep; const char* b2 = last ? nB : cB + (size_t)(t + 2) * kstep;
            const char* a3 = a2 + kstep; const char* b3 = b2 + kstep;
            if (last && has_next) S.a_ready(nxt);
            PG8_LDB(B0, 0, 0); PG8_SCHED; PG8_LDA(At, 0, 0); PG8_STAGE(PG8_SA(1, 1), a1 + hstep, voffA);
            PG8_WAIT_L(8); PG8_BAR; PG8_WAIT_L(0); PG8_MMA(0, 0, At, B0); PG8_BAR; PG8_SCHED;
            PG8_LDB(B1, 0, 1); PG8_STAGE(PG8_SB(0, 0), b2, voffB);
            PG8_BAR; PG8_WAIT_L(0); PG8_MMA(0, 1, At, B1); PG8_BAR;
            PG8_LDA(At, 0, 1); PG8_STAGE(PG8_SA(0, 0), a2, voffA);
            PG8_BAR; PG8_WAIT_L(0); PG8_MMA(1, 0, At, B0); PG8_BAR; PG8_SCHED;
            PG8_STAGE(PG8_SB(0, 1), b2 + hstep, voffB);
            PG8_WAIT_V(6); PG8_BAR; PG8_MMA(1, 1, At, B1); PG8_BAR;
            PG8_LDB(B0, 1, 0); PG8_SCHED; PG8_LDA(At, 1, 0); PG8_STAGE(PG8_SA(0, 1), a2 + hstep, voffA);
            PG8_WAIT_L(8); PG8_BAR; PG8_WAIT_L(0); PG8_MMA(0, 0, At, B0); PG8_BAR; PG8_SCHED;
            PG8_LDB(B1, 1, 1); PG8_STAGE(PG8_SB(1, 0), b3, voffB);
            PG8_BAR; PG8_WAIT_L(0); PG8_MMA(0, 1, At, B1); PG8_BAR;
            PG8_LDA(At, 1, 1); PG8_STAGE(PG8_SA(1, 0), a3, voffA);
            PG8_BAR; PG8_WAIT_L(0); PG8_MMA(1, 0, At, B0); PG8_BAR; PG8_SCHED;
            PG8_STAGE(PG8_SB(1, 1), b3 + hstep, voffB);
            PG8_WAIT_V(6); PG8_BAR; PG8_MMA(1, 1, At, B1); PG8_BAR;
        }
        PG8_STAMP();
        if constexpr (!Epi::AFTER_DRAIN) { E(acc, cur, wr, wc, fr, fq); S.done(cur); }
        PG8_STAMP();
        if (!has_next) break;
#pragma unroll
        for (int a = 0; a < 2; ++a)
#pragma unroll
            for (int b = 0; b < 2; ++b)
#pragma unroll
                for (int m = 0; m < 4; ++m)
#pragma unroll
                    for (int n = 0; n < 2; ++n) acc[a][b][m][n] = (f32x4){0.f, 0.f, 0.f, 0.f};
        cur = nxt; cA = nA; cB = nB; ++ui;
    }
    PG8_WAIT_V(0);
    if (wr == 0) PG8_BAR;
    PG8_BAR;
    if constexpr (Epi::AFTER_DRAIN) { E.fused(acc, cur, wr, wc, fr, fq, lds, wid, lane); S.done(cur); }
    PG8_STAMP();
    if (STAMP && wid == 0) { stamps[lane] = lane < nts ? (((unsigned long long)(unsigned)ts_hi << 32) | (unsigned)ts_lo) : 0ull;
        if (lane == 62) stamps[62] = rt_entry; if (lane == 63) stamps[63] = (unsigned long long)wall_clock64(); }
#undef PG8_STAMP
#undef PG8_SA
#undef PG8_SB
#undef PG8_STAGE
#undef PG8_LDA
#undef PG8_LDB
#undef PG8_MMA
#undef PG8_WAIT_V
#undef PG8_WAIT_L
#undef PG8_BAR
#undef PG8_SCHED
}
}

DI float quadsum(float x) {
  auto rr = __builtin_amdgcn_permlane16_swap(__float_as_uint(x), __float_as_uint(x), false, false);
  x = __uint_as_float(rr[0]) + __uint_as_float(rr[1]);
  return swapadd(x);
}
struct EpiP1 {
  static constexpr bool PERM = true, AFTER_DRAIN = false;
  u16* qkv; const float* cs; const float* sn; const float* const* in; int layer; unsigned char* gate;
  DI void operator()(const pg8::f32x4 (&acc)[2][2][4][2], const pg8::Unit& u, int wr, int wc, int fr_, int fq_) const {
    const int lane = tidx() & 63, fr = lane & 15, fq = lane >> 4;
    if (u.pn >= 20) {
#pragma unroll
      for (int ai = 0; ai < 2; ++ai)
#pragma unroll
        for (int m = 0; m < 4; ++m) {
          const int row = u.pm * 256 + ai * 128 + wr * 64 + m * 16 + fr;
          unsigned char* gp = gate + (size_t)row * 4096 + (u.pn - 20) * 256 + wc * 32 + 8 * fq;
#pragma unroll
          for (int bj = 0; bj < 2; ++bj) {
            unsigned w2[2];
#pragma unroll
            for (int n = 0; n < 2; ++n) {
              unsigned wv = 0u;
#pragma unroll
              for (int e = 0; e < 4; ++e) {
                const float sg = __builtin_amdgcn_rcpf(1.f + __builtin_amdgcn_exp2f(-acc[ai][bj][m][n][e] * LOG2E));
                wv |= ((unsigned)(sg * 255.f + 0.5f)) << (8 * e);
              }
              w2[n] = wv;
            }
            u32x2 wq = {w2[0], w2[1]};
            *(u32x2*)(gp + bj * 128) = wq;
          }
        }
      return;
    }
    const int n64 = u.pn * 4 + wc;
    const float* gain = nullptr; float scale = 1.f;
    if (n64 < 8) { gain = in[5] + layer * 64; scale = QS64; }
    else if (n64 < 16) { gain = in[6] + layer * 64; }
    else if (n64 < 24) {}
    else if (n64 < 60) {
      int tt = n64 - 24, g = tt / 12, jj = (tt % 12) >> 2;
      if (jj == 0) { gain = in[9] + (layer * 3 + g) * 64; scale = QS64; }
      else if (jj == 1) { gain = in[10] + (layer * 3 + g) * 64; }
    }
    else if (n64 < 68) { gain = in[17] + layer * 64; scale = QS64; }
    else if (n64 < 70) { gain = in[18] + layer * 64; }
#pragma unroll
    for (int ai = 0; ai < 2; ++ai)
#pragma unroll
      for (int m = 0; m < 4; ++m) {
        const int row = u.pm * 256 + ai * 128 + wr * 64 + m * 16 + fr;
        f32x4 v[2][2];
#pragma unroll
        for (int bj = 0; bj < 2; ++bj)
#pragma unroll
          for (int n = 0; n < 2; ++n) v[bj][n] = acc[ai][bj][m][n];
        if (gain) {
          float ss = 0.f;
#pragma unroll
          for (int bj = 0; bj < 2; ++bj)
#pragma unroll
            for (int n = 0; n < 2; ++n)
#pragma unroll
              for (int e = 0; e < 4; ++e) ss += v[bj][n][e] * v[bj][n][e];
          ss = quadsum(ss);
          const float rstd = __builtin_amdgcn_rsqf(ss * (1.f / 64.f) + EPS);
          const int pos = row & (SEQ - 1);
#pragma unroll
          for (int n = 0; n < 2; ++n) {
            const int d = 8 * fq + 4 * n;
            f32x4 c4 = *(const f32x4*)(cs + pos * 32 + d), s4 = *(const f32x4*)(sn + pos * 32 + d);
            f32x4 g1 = *(const f32x4*)(gain + d), g2 = *(const f32x4*)(gain + 32 + d);
#pragma unroll
            for (int e = 0; e < 4; ++e) {
              float x1 = v[0][n][e] * rstd * g1[e], x2 = v[1][n][e] * rstd * g2[e];
              v[0][n][e] = (x1 * c4[e] - x2 * s4[e]) * scale;
              v[1][n][e] = (x2 * c4[e] + x1 * s4[e]) * scale;
            }
          }
        }
        u16* rowp = qkv + (size_t)row * NINP + n64 * 64 + 8 * fq;
#pragma unroll
        for (int bj = 0; bj < 2; ++bj) {
          u32x4 w = {cvtpk(v[bj][0][0], v[bj][0][1]), cvtpk(v[bj][0][2], v[bj][0][3]), cvtpk(v[bj][1][0], v[bj][1][1]), cvtpk(v[bj][1][2], v[bj][1][3])};
          *(u32x4*)(rowp + bj * 32) = w;
        }
      }
  }
};
struct EpiRes {
  static constexpr bool PERM = false, AFTER_DRAIN = false;
  const float* resid; float* out;
  DI void operator()(const pg8::f32x4 (&acc)[2][2][4][2], const pg8::Unit& u, int wr, int wc, int fr_, int fq_) const {
    const int lane = tidx() & 63, fr = lane & 15, fq = lane >> 4;
#pragma unroll
    for (int ai = 0; ai < 2; ++ai)
#pragma unroll
      for (int m = 0; m < 4; ++m) {
        const size_t o = (size_t)(u.pm * 256 + ai * 128 + wr * 64 + m * 16 + fr) * DM + u.pn * 256 + wc * 32 + 4 * fq;
#pragma unroll
        for (int bj = 0; bj < 2; ++bj)
#pragma unroll
          for (int n = 0; n < 2; ++n) {
            f32x4 x = *(const f32x4*)(resid + o + bj * 128 + n * 16);
            *(f32x4*)(out + o + bj * 128 + n * 16) = x + acc[ai][bj][m][n];
          }
      }
  }
};
struct EpiSwiglu {
  static constexpr bool PERM = true, AFTER_DRAIN = false;
  u16* act;
  DI void operator()(const pg8::f32x4 (&acc)[2][2][4][2], const pg8::Unit& u, int wr, int wc, int fr_, int fq_) const {
    const int lane = tidx() & 63, fr = lane & 15, fq = lane >> 4;
#pragma unroll
    for (int ai = 0; ai < 2; ++ai)
#pragma unroll
      for (int m = 0; m < 4; ++m) {
        const int row = u.pm * 256 + ai * 128 + wr * 64 + m * 16 + fr;
        float a[8];
#pragma unroll
        for (int n = 0; n < 2; ++n)
#pragma unroll
          for (int e = 0; e < 4; ++e) {
            float gte = acc[ai][0][m][n][e];
            a[4 * n + e] = gte * __builtin_amdgcn_rcpf(1.f + __builtin_amdgcn_exp2f(-gte * LOG2E)) * acc[ai][1][m][n][e];
          }
        u32x4 w = {cvtpk(a[0], a[1]), cvtpk(a[2], a[3]), cvtpk(a[4], a[5]), cvtpk(a[6], a[7])};
        *(u32x4*)(act + (size_t)row * DFF + u.pn * 128 + wc * 32 + 8 * fq) = w;
      }
  }
};

DI void repack_tile(const float* __restrict__ src, const float* __restrict__ src2, int nsrc, u16* __restrict__ dst, int K, int n0, int k0, int mode,
                    const float* __restrict__ gain, char* lds) {
  float* tile = (float*)lds;
  const int tid = tidx();
  {
    const int nn = tid & 63, kk0 = tid >> 6;
    const int np = n0 + nn;
    const float* s = src; int col = np; bool valid = true;
    if (mode == 1) {
      const int rho = np & 255, lg = ((np >> 8) * 4 + ((rho >> 5) & 3)) * 64 + 32 * (rho >> 7) + (rho & 31);
      if (lg < 3840) col = lg; else if (lg < 4608) col = 4256 + (lg - 3840); else if (lg < 5024) col = 3840 + (lg - 4608); else valid = false;
    } else if (mode == 2) {
      const int rho = np & 255;
      col = (np >> 8) * 128 + (rho & 127);
      if (rho >= 128) s = src2;
    }
#pragma unroll
    for (int i = 0; i < 8; ++i) {
      int kk = kk0 + 8 * i;
      float v = valid ? s[(size_t)(k0 + kk) * nsrc + col] : 0.f;
      if (gain) v *= gain[k0 + kk];
      tile[kk * 65 + nn] = v;
    }
  }
  __syncthreads();
  {
    const int n = tid >> 3, kc = (tid & 7) * 8;
    float f[8];
#pragma unroll
    for (int i = 0; i < 8; ++i) f[i] = tile[(kc + i) * 65 + n];
    u32x4 w = {cvtpk(f[0], f[1]), cvtpk(f[2], f[3]), cvtpk(f[4], f[5]), cvtpk(f[6], f[7])};
    *(u32x4*)(dst + (size_t)(n0 + n) * K + k0 + kc) = w;
  }
  __syncthreads();
}

DI void sincos_acc(float ang, float& c, float& s) {
  double a = (double)ang;
  double t = a * 0.15915494309189535;
  double fr = t - rint(t);
  double x = fr * 6.283185307179586;
  double x2 = x * x;
  double ts = x, tc = 1.0, ssum = x, csum = 1.0;
  for (int n = 1; n <= 14; ++n) {
    tc *= -x2 / (double)((2 * n - 1) * (2 * n));
    ts *= -x2 / (double)((2 * n) * (2 * n + 1));
    csum += tc; ssum += ts;
  }
  c = (float)csum; s = (float)ssum;
}

__device__ __forceinline__ void phase_w(const Params& p, char* lds) {
  char* const ws = lws(p.ws);
  constexpr int PER_LAYER = 5200;
  for (int t = blockIdx.x; t < PER_LAYER * DEPTH; t += gridDim.x) {
    const int l = t / PER_LAYER; int u = t % PER_LAYER;
    if (u < 1280) {
      repack_tile(p.in[3] + (size_t)l * 1024 * 5024, nullptr, 5024, (u16*)(ws + OFF_WIN) + (size_t)l * NIN2 * 1024, 1024, (u >> 4) * 64, (u & 15) * 64, 1, nullptr, lds);
      continue;
    }
    u -= 1280;
    if (u < 1024) {
      repack_tile(p.in[4] + (size_t)l * 1024 * 4096, nullptr, 4096, (u16*)(ws + OFF_WIN) + ((size_t)l * NIN2 + NINP) * 1024, 1024, (u >> 4) * 64, (u & 15) * 64, 0, nullptr, lds);
      continue;
    }
    u -= 1024;
    if (u < 48) {
      repack_tile(p.in[13] + (size_t)l * 256 * 768, nullptr, 768, (u16*)(ws + OFF_WUQ) + (size_t)l * 768 * 256, 256, (u >> 2) * 64, (u & 3) * 64, 0, p.in[11] + l * 256, lds);
      continue;
    }
    u -= 48;
    if (u < 32) {
      repack_tile(p.in[14] + (size_t)l * 128 * 1024, nullptr, 1024, (u16*)(ws + OFF_WUKV) + (size_t)l * 1024 * 128, 128, (u >> 1) * 64, (u & 1) * 64, 0, p.in[12] + l * 128, lds);
      continue;
    }
    u -= 32;
    if (u < 448) {
      u16* wbr = (u16*)(ws + OFF_WBR) + (size_t)l * 1024 * 1792;
      if (u < 128) repack_tile(p.in[20] + (size_t)l * 512 * 1024, nullptr, 1024, wbr, 512, (u >> 3) * 64, (u & 7) * 64, 0, nullptr, lds);
      else if (u < 192) { u -= 128; repack_tile(p.in[21] + (size_t)l * 256 * 1024, nullptr, 1024, wbr + 1024 * 512, 256, (u >> 2) * 64, (u & 3) * 64, 0, nullptr, lds); }
      else if (u < 320) { u -= 192; repack_tile(p.in[22] + (size_t)l * 512 * 1024, nullptr, 1024, wbr + 1024 * 768, 512, (u >> 3) * 64, (u & 7) * 64, 0, nullptr, lds); }
      else { u -= 320; repack_tile(p.in[23] + (size_t)l * 512 * 1024, nullptr, 1024, wbr + 1024 * 1280, 512, (u >> 3) * 64, (u & 7) * 64, 0, nullptr, lds); }
      continue;
    }
    u -= 448;
    if (u < 256) {
      repack_tile(p.in[24] + (size_t)l * 1024 * 1024, nullptr, 1024, (u16*)(ws + OFF_WO) + (size_t)l * 1024 * 1024, 1024, (u >> 4) * 64, (u & 15) * 64, 0, nullptr, lds);
      continue;
    }
    u -= 256;
    if (u < 1408) {
      repack_tile(p.in[26] + (size_t)l * 1024 * DFF, p.in[27] + (size_t)l * 1024 * DFF, DFF, (u16*)(ws + OFF_WGU) + (size_t)l * NGU * 1024, 1024, (u >> 4) * 64, (u & 15) * 64, 2, nullptr, lds);
      continue;
    }
    u -= 1408;
    repack_tile(p.in[28] + (size_t)l * DFF * 1024, nullptr, 1024, (u16*)(ws + OFF_WDN) + (size_t)l * 1024 * DFF, DFF, (u / 44) * 64, (u % 44) * 64, 0, nullptr, lds);
  }
  const int gt = blockIdx.x * 512 + tidx(), ngt = gridDim.x * 512;
  float* c64 = (float*)(ws + OFF_COS64); float* s64 = (float*)(ws + OFF_SIN64);
  float* c32 = (float*)(ws + OFF_COS32); float* s32 = (float*)(ws + OFF_SIN32);
  for (int i = gt; i < SEQ * 32; i += ngt) {
    int pos = i >> 5, f = i & 31; float c, s;
    sincos_acc((float)pos * p.inv64[f], c, s);
    c64[i] = c; s64[i] = s;
  }
  for (int i = gt; i < SEQ * 16; i += ngt) {
    int pos = i >> 4, f = i & 15; float c, s;
    sincos_acc((float)pos * p.inv32[f], c, s);
    c32[i] = c; s32[i] = s;
  }
  if (blockIdx.x == 0)
    for (int i = tidx(); i < 3456; i += 512) __hip_atomic_store((unsigned*)(ws + OFF_BAR) + i, 0u, __ATOMIC_RELAXED, __HIP_MEMORY_SCOPE_AGENT);
  if (gt < DEPTH) {
    auto mxabs = [](const float* g_, int n_) { float m_ = 0.f; for (int i = 0; i < n_; ++i) m_ = fmaxf(m_, fabsf(g_[i])); return m_; };
    float* fl_ = (float*)(ws + OFF_LAM);
    const int l_ = gt;
    const float LIM = 60.f;
    fl_[2 + l_] = (8.f * LOG2E * mxabs(p.in[5] + l_ * 64, 64) * mxabs(p.in[6] + l_ * 64, 64) <= LIM) ? 1.f : 0.f;
    for (int g_ = 0; g_ < 3; ++g_)
      fl_[4 + l_ * 3 + g_] = (8.f * LOG2E * mxabs(p.in[9] + (l_ * 3 + g_) * 64, 64) * mxabs(p.in[10] + (l_ * 3 + g_) * 64, 64) <= LIM) ? 1.f : 0.f;
    fl_[10 + l_] = (9.7979590f * LOG2E * mxabs(p.in[15] + l_ * 96, 96) * mxabs(p.in[16] + l_ * 96, 96) <= LIM) ? 1.f : 0.f;
    fl_[12 + l_] = (8.f * LOG2E * mxabs(p.in[17] + l_ * 64, 64) * mxabs(p.in[18] + l_ * 64, 64) <= LIM) ? 1.f : 0.f;
    const float* lp = p.in[7] + gt * 256;
    float a = 0.f, b = 0.f;
    for (int i = 0; i < 64; ++i) { a += lp[i] * lp[64 + i]; b += lp[128 + i] * lp[192 + i]; }
    ((float*)(ws + OFF_LAM))[gt] = expf(a) - expf(b) + p.lam_init[gt];
  }
}

__device__ __forceinline__ void phase_norm(const float* __restrict__ x, const float* __restrict__ g, u16* __restrict__ xn) {
  const int lane = tidx() & 63, wid = wave_id();
  for (int row = blockIdx.x * 8 + wid; row < CT; row += gridDim.x * 8) {
    const f32x4* xr = (const f32x4*)(x + (size_t)row * DM);
    f32x4 v[4]; float ss = 0.f;
#pragma unroll
    for (int i = 0; i < 4; ++i) { v[i] = xr[lane + 64 * i]; ss += v[i][0] * v[i][0] + v[i][1] * v[i][1] + v[i][2] * v[i][2] + v[i][3] * v[i][3]; }
    ss = swapadd(ss);
#pragma unroll
    for (int o = 16; o >= 1; o >>= 1) ss += __int_as_float(__builtin_amdgcn_ds_bpermute((lane ^ o) << 2, __float_as_int(ss)));
    const float rstd = __builtin_amdgcn_rsqf(ss * (1.f / 1024.f) + EPS);
#pragma unroll
    for (int i = 0; i < 4; ++i) {
      f32x4 g4 = ((const f32x4*)g)[lane + 64 * i];
      u32x2 w = {cvtpk(v[i][0] * rstd * g4[0], v[i][1] * rstd * g4[1]), cvtpk(v[i][2] * rstd * g4[2], v[i][3] * rstd * g4[3])};
      *(u32x2*)(xn + (size_t)row * DM + (lane + 64 * i) * 4) = w;
    }
  }
}

__device__ __forceinline__ void phase_p1(const Params& p, int layer, char* lds) {
  char* const ws = lws(p.ws);
  pg8::Gemm g{(const u16*)(ws + OFF_XN), (const u16*)(ws + OFF_WIN) + (size_t)layer * NIN2 * 1024, CT, NIN2, 1024};
  pg8::StaticOrder S; S.init(CT, NIN2, gridDim.x, blockIdx.x);
  EpiP1 E{(u16*)(ws + OFF_QKV), (const float*)(ws + OFF_COS64), (const float*)(ws + OFF_SIN64), p.in, layer, (unsigned char*)(ws + OFF_GATE)};
  __syncthreads();
  pg8::gemm_phase<EpiP1, pg8::StaticOrder, false>((PG8_LAS unsigned char*)lds, g, S, E, nullptr);
}

__device__ __forceinline__ void phase_p1c(const Params& p, int layer, char* lds) {
  char* const ws = lws(p.ws);
  const u16* Wuq = (const u16*)(ws + OFF_WUQ) + (size_t)layer * 768 * 256;
  const u16* Wukv = (const u16*)(ws + OFF_WUKV) + (size_t)layer * 1024 * 128;
  const u16* qkv = (const u16*)(ws + OFF_QKV);
  u16* qc = (u16*)(ws + OFF_QKVC);
  const float* c32 = (const float*)(ws + OFF_COS32); const float* s32 = (const float*)(ws + OFF_SIN32);
  const int tid = tidx(), wid = wave_id(), wn = wid & 3, wm = wid >> 2;
  char* wl = lds + wid * WAVE_LDS;
  for (int t = blockIdx.x; t < 2 * 128; t += gridDim.x) {
    int nt, mt; tile_map(t, nt, mt);
    const int n0 = nt * 384, m0 = mt * 128;
    f32x16 acc[3][2];
    gemm_core<3>(acc, Wuq + (size_t)n0 * 256, 256, qkv + (size_t)m0 * NINP + 4608, NINP, 256, lds);
    const int lane2 = (tidx() & 63), r = lane2 & 31, h = lane2 >> 5;
#pragma unroll
    for (int j = 0; j < 2; ++j) {
      const int m = m0 + wm * 64 + j * 32 + r;
      float ss = swapadd(row_ssq(qkv + (size_t)m * NINP + 4608 + h * 128, 16));
      const float rq = __builtin_amdgcn_rsqf(ss * (1.f / 256.f) + EPS);
#pragma unroll
      for (int i = 0; i < 3; ++i)
#pragma unroll
        for (int e = 0; e < 16; ++e) acc[i][j][e] *= rq;
    }
    norm96_rope_store(acc, p.in[15] + layer * 96, QS96, (m0 + wm * 64) & (SEQ - 1), c32, s32, qc + (size_t)(m0 + wm * 64) * QKVC_LD + n0 + wn * 96, wl);
  }
  for (int t = blockIdx.x; t < 4 * 128; t += gridDim.x) {
    int nt, mt; tile_map(t, nt, mt);
    const int n0 = nt * 256, m0 = mt * 128;
    f32x16 acc[3][2];
    gemm_core<2, 3>(acc, Wukv + (size_t)n0 * 128, 128, qkv + (size_t)m0 * NINP + 4864, NINP, 128, lds);
    const int n64 = (n0 >> 6) + wn, head = n64 >> 1, isv = n64 & 1;
    const int lane2 = (tidx() & 63), r = lane2 & 31, h = lane2 >> 5;
#pragma unroll
    for (int j = 0; j < 2; ++j) {
      const int m = m0 + wm * 64 + j * 32 + r;
      float ss = swapadd(row_ssq(qkv + (size_t)m * NINP + 4864 + h * 64, 8));
      const float rk = __builtin_amdgcn_rsqf(ss * (1.f / 128.f) + EPS);
#pragma unroll
      for (int i = 0; i < 2; ++i)
#pragma unroll
        for (int e = 0; e < 16; ++e) acc[i][j][e] *= rk;
    }
    if (isv) {
      store_wave_bf16<2, 3>(acc, qc + (size_t)(m0 + wm * 64) * QKVC_LD + 1536 + head * 64, QKVC_LD, wl);
    } else {
      f32x16 (&y)[3][2] = acc;
#pragma unroll
      for (int j = 0; j < 2; ++j) {
        const int m = m0 + wm * 64 + j * 32 + r;
#pragma unroll
        for (int g = 0; g < 4; ++g) {
          u32x2 d = *(const u32x2*)(qkv + (size_t)m * NINP + 4992 + 8 * g + 4 * h);
          y[2][j][4 * g] = bflo(d[0]); y[2][j][4 * g + 1] = bfhi(d[0]); y[2][j][4 * g + 2] = bflo(d[1]); y[2][j][4 * g + 3] = bfhi(d[1]);
        }
      }
      norm96_rope_store(y, p.in[16] + layer * 96, 1.f, (m0 + wm * 64) & (SEQ - 1), c32, s32, qc + (size_t)(m0 + wm * 64) * QKVC_LD + 768 + head * 96, wl);
    }
  }
}

constexpr int QLDS_OFF = 77824, QLDS_WAVE = 64 * 144;
template <int DQK, int DV, int NKT, bool BANDED, bool QLDS = false, bool FAST = false>
DI void attn_loop(f32x16 (&O)[2][DV / 32], float (&mrun)[2], float (&lrun)[2], const bf16x8 (&qf)[2][DQK / 16],
                  const u16* __restrict__ k0p, const u16* __restrict__ k1p, size_t kld, const u16* __restrict__ vp, size_t vld,
                  int t0, int t1, bool wact, int qbase, int W, char* lds) {
  constexpr int KP = DQK * 2 + 16, VP = DV * 2 + 64;
  constexpr int KC = DQK / 8, VC = DV / 8;
  constexpr int KTOT = NKT * 64 * KC, VTOT = 64 * VC, TOT = KTOT + VTOT, NIT = (TOT + 511) / 512;
  constexpr int SB = NKT * 64 * KP + 64 * VP;
  constexpr float THR = 8.f;
  const int tid = tidx(), lane = tid & 63, r = lane & 31, h = lane >> 5;
  const int dk1 = NKT == 2 ? (int)(k1p - k0p) : 0, dvo = (int)(vp - k0p);
  const int ldi = (int)kld;
  int soff[NIT]; int doff[NIT]; bool sval[NIT];
#pragma unroll
  for (int it = 0; it < NIT; ++it) {
    const int c = tid + it * 512;
    const bool allK = (it + 1) * 512 <= KTOT, allV = it * 512 >= KTOT;
    const bool isK = allK ? true : (allV ? false : (c < KTOT));
    const int kt = c / (64 * KC), rem = c % (64 * KC), krow = rem / KC, kcol = rem % KC;
    const int c2 = c - KTOT, vrow = c2 / VC, vcol = c2 % VC;
    const int so_k = (kt ? dk1 : 0) + krow * ldi + kcol * 8, do_k = kt * 64 * KP + krow * KP + kcol * 16;
    const int so_v = dvo + vrow * ldi + vcol * 8, do_v = NKT * 64 * KP + vrow * VP + vcol * 16;
    soff[it] = isK ? so_k : so_v;
    doff[it] = isK ? do_k : do_v;
    sval[it] = ((it + 1) * 512 <= TOT) ? true : (c < TOT);
  }
  u32x4 rg[NIT];
#define SOFF_(it) ((NKT == 2 ? soff[(it) & ~1] : soff[it]) * 2)
#define SADD_(it) ((NKT == 2 && ((it) & 1)) ? ((it) == 1 ? dk1 * 2 : 32 * ldi * 2) : 0)
#define DOFF_(it) ((NKT == 2 && ((it) & 1)) ? doff[(it) & ~1] + ((it) == 1 ? 64 * KP : 32 * VP) : doff[it])
  const __amdgpu_buffer_rsrc_t krsrc = __builtin_amdgcn_make_buffer_rsrc((void*)k0p, 0, 0x7fffffff, 0x00020000);
  const int kaddr = r * KP + h * 16;
  const char* const qlds = lds + QLDS_OFF + wave_id() * QLDS_WAVE + r * 144 + h * 16;
  const int vaddr = NKT * 64 * KP + (4 * h + ((lane & 15) >> 2)) * VP + (((lane >> 4) & 1) * 16 + (lane & 3) * 4) * 2;
  if (t1 <= t0) return;
  __syncthreads();
#pragma unroll
  for (int it = 0; it < NIT; ++it) if (sval[it]) rg[it] = __builtin_amdgcn_raw_buffer_load_b128(krsrc, SOFF_(it), t0 * 128 * ldi + SADD_(it), 0);
#pragma unroll
  for (int it = 0; it < NIT; ++it) if (sval[it]) *(u32x4*)(lds + DOFF_(it)) = rg[it];
  __syncthreads();
#pragma nounroll
  for (int t = t0; t < t1; ++t) {
    const int buf = (t - t0) & 1;
    const bool more = t + 1 < t1;
    if (more && NKT == 1) {
#pragma unroll
      for (int it = 0; it < NIT; ++it) if (sval[it]) rg[it] = __builtin_amdgcn_raw_buffer_load_b128(krsrc, SOFF_(it), (t + 1) * 128 * ldi + SADD_(it), 0);
    }
    bool doit = wact;
    if (BANDED) doit = wact && (t * 64 + 63 >= qbase - W) && (t * 64 <= qbase + 63 + W);
    if (doit) {
      const char* base = lds + buf * SB;
      bf16x8 pf[2][4];
      if (NKT == 1) {
        f32x16 S[2][2];
#pragma unroll
        for (int j = 0; j < 2; ++j)
#pragma unroll
          for (int kb = 0; kb < 2; ++kb)
#pragma unroll
            for (int e = 0; e < 16; ++e) S[j][kb][e] = 0.f;
#pragma unroll
        for (int s = 0; s < DQK / 16; ++s)
#pragma unroll
          for (int kb = 0; kb < 2; ++kb) {
            bf16x8 kf = *(const bf16x8*)(base + kaddr + kb * 32 * KP + s * 32);
#pragma unroll
            for (int j = 0; j < 2; ++j) S[j][kb] = MFMA(kf, qf[j][s], S[j][kb]);
          }
#pragma unroll
        for (int j = 0; j < 2; ++j) {
          if (BANDED) {
            const int qi = qbase + j * 32 + r;
#pragma unroll
            for (int kb = 0; kb < 2; ++kb)
#pragma unroll
              for (int e = 0; e < 16; ++e) {
                int ki = t * 64 + kb * 32 + crow(e, h);
                int dd = qi - ki; dd = dd < 0 ? -dd : dd;
                if (dd > W) S[j][kb][e] = -1e30f;
              }
          }
          float ps = 0.f;
          if (FAST) {
#pragma unroll
            for (int kb = 0; kb < 2; ++kb)
#pragma unroll
              for (int e = 0; e < 16; ++e) { float pv = __builtin_amdgcn_exp2f(S[j][kb][e]); S[j][kb][e] = pv; ps += pv; }
          } else {
            float pmax = S[j][0][0];
#pragma unroll
            for (int e = 1; e < 16; ++e) pmax = fmaxf(pmax, S[j][0][e]);
#pragma unroll
            for (int e = 0; e < 16; ++e) pmax = fmaxf(pmax, S[j][1][e]);
            pmax = swapmax(pmax);
            if (!__all(pmax - mrun[j] <= THR)) {
              float mn = fmaxf(mrun[j], pmax);
              float alpha = __builtin_amdgcn_exp2f(mrun[j] - mn);
              mrun[j] = mn; lrun[j] *= alpha;
#pragma unroll
              for (int d = 0; d < DV / 32; ++d)
#pragma unroll
                for (int e = 0; e < 16; ++e) O[j][d][e] *= alpha;
            }
            const float mm = mrun[j];
#pragma unroll
            for (int kb = 0; kb < 2; ++kb)
#pragma unroll
              for (int e = 0; e < 16; ++e) { float pv = __builtin_amdgcn_exp2f(S[j][kb][e] - mm); S[j][kb][e] = pv; ps += pv; }
          }
          lrun[j] += ps;
#pragma unroll
          for (int ks = 0; ks < 4; ++ks) {
            const int kb = ks >> 1, b8 = (ks & 1) * 8;
            u32x4 w = {cvtpk(S[j][kb][b8], S[j][kb][b8 + 1]), cvtpk(S[j][kb][b8 + 2], S[j][kb][b8 + 3]),
                       cvtpk(S[j][kb][b8 + 4], S[j][kb][b8 + 5]), cvtpk(S[j][kb][b8 + 6], S[j][kb][b8 + 7])};
            pf[j][ks] = __builtin_bit_cast(bf16x8, w);
          }
        }
      } else {
#pragma unroll
        for (int j = 0; j < 2; ++j) {
          f32x16 S[2];
#pragma unroll
          for (int kb = 0; kb < 2; ++kb)
#pragma unroll
            for (int e = 0; e < 16; ++e) S[kb][e] = 0.f;
          {
            constexpr int NS = DQK / 16;
            const char* kbase = base + j * 64 * KP + kaddr;
            const char* qbase_l = qlds + j * 32 * 144;
#define A1_KF(s_, kb_) (*(const bf16x8*)(kbase + (kb_) * 32 * KP + (s_) * 32))
#define A1_QF(s_) (QLDS ? *(const bf16x8*)(qbase_l + (s_) * 32) : qf[j][(s_)])
            bf16x8 ka = A1_KF(0, 0), kb2 = A1_KF(0, 1), qa = A1_QF(0);
            __builtin_amdgcn_sched_barrier(0);
#pragma unroll
            for (int s2 = 0; s2 < NS; ++s2) {
              bf16x8 kn0, kn1, qn;
              if (s2 + 1 < NS) { kn0 = A1_KF(s2 + 1, 0); kn1 = A1_KF(s2 + 1, 1); qn = A1_QF(s2 + 1); }
              __builtin_amdgcn_sched_barrier(0);
              S[0] = MFMA(ka, qa, S[0]);
              S[1] = MFMA(kb2, qa, S[1]);
              __builtin_amdgcn_sched_barrier(0);
              if (s2 + 1 < NS) { ka = kn0; kb2 = kn1; qa = qn; }
            }
#undef A1_KF
#undef A1_QF
          }
          float ps = 0.f;
          if (FAST) {
#pragma unroll
            for (int kb = 0; kb < 2; ++kb)
#pragma unroll
              for (int e = 0; e < 16; ++e) { float pv = __builtin_amdgcn_exp2f(S[kb][e]); S[kb][e] = pv; ps += pv; }
          } else {
            float pmax = S[0][0];
#pragma unroll
            for (int e = 1; e < 16; ++e) pmax = fmaxf(pmax, S[0][e]);
#pragma unroll
            for (int e = 0; e < 16; ++e) pmax = fmaxf(pmax, S[1][e]);
            pmax = swapmax(pmax);
            if (!__all(pmax - mrun[j] <= THR)) {
              float mn = fmaxf(mrun[j], pmax);
              float alpha = __builtin_amdgcn_exp2f(mrun[j] - mn);
              mrun[j] = mn; lrun[j] *= alpha;
#pragma unroll
              for (int d = 0; d < DV / 32; ++d)
#pragma unroll
                for (int e = 0; e < 16; ++e) O[j][d][e] *= alpha;
            }
            const float mm = mrun[j];
#pragma unroll
            for (int kb = 0; kb < 2; ++kb)
#pragma unroll
              for (int e = 0; e < 16; ++e) { float pv = __builtin_amdgcn_exp2f(S[kb][e] - mm); S[kb][e] = pv; ps += pv; }
          }
          lrun[j] += ps;
#pragma unroll
          for (int ks = 0; ks < 4; ++ks) {
            const int kb = ks >> 1, b8 = (ks & 1) * 8;
            u32x4 w = {cvtpk(S[kb][b8], S[kb][b8 + 1]), cvtpk(S[kb][b8 + 2], S[kb][b8 + 3]),
                       cvtpk(S[kb][b8 + 4], S[kb][b8 + 5]), cvtpk(S[kb][b8 + 6], S[kb][b8 + 7])};
            pf[j][ks] = __builtin_bit_cast(bf16x8, w);
          }
          {
            constexpr int ND = DV / 32, NV = 4 * ND;
            const char* vbase = base + vaddr;
            auto vread = [&](int i) -> bf16x8 {
              const char* va = vbase + (i / ND) * 16 * VP + (i % ND) * 64;
              s16x4 lo = __builtin_amdgcn_ds_read_tr16_b64_v4i16((__attribute__((address_space(3))) s16x4*)(va));
              s16x4 hi = __builtin_amdgcn_ds_read_tr16_b64_v4i16((__attribute__((address_space(3))) s16x4*)(va + 8 * VP));
              bf16x8 vf = {lo[0], lo[1], lo[2], lo[3], hi[0], hi[1], hi[2], hi[3]};
              return vf;
            };
            bf16x8 v0 = vread(0), v1 = vread(1);
            __builtin_amdgcn_sched_barrier(0);
#pragma unroll
            for (int i = 0; i < NV; i += 2) {
              O[j][i % ND] = MFMA(v0, pf[j][i / ND], O[j][i % ND]);
              if (i + 2 < NV) v0 = vread(i + 2);
              __builtin_amdgcn_sched_barrier(0);
              O[j][(i + 1) % ND] = MFMA(v1, pf[j][(i + 1) / ND], O[j][(i + 1) % ND]);
              if (i + 3 < NV) v1 = vread(i + 3);
              __builtin_amdgcn_sched_barrier(0);
            }
            if (j == 0 && more) {
#pragma unroll
              for (int it = 0; it < NIT; ++it) if (sval[it]) rg[it] = __builtin_amdgcn_raw_buffer_load_b128(krsrc, SOFF_(it), (t + 1) * 128 * ldi + SADD_(it), 0);
              __builtin_amdgcn_sched_barrier(0);
            }
          }
        }
      }
      if (NKT == 1) {
#pragma unroll
        for (int ks = 0; ks < 4; ++ks)
#pragma unroll
          for (int d = 0; d < DV / 32; ++d) {
            const char* va = base + vaddr + ks * 16 * VP + d * 64;
            s16x4 lo = __builtin_amdgcn_ds_read_tr16_b64_v4i16((__attribute__((address_space(3))) s16x4*)(va));
            s16x4 hi = __builtin_amdgcn_ds_read_tr16_b64_v4i16((__attribute__((address_space(3))) s16x4*)(va + 8 * VP));
            bf16x8 vf = {lo[0], lo[1], lo[2], lo[3], hi[0], hi[1], hi[2], hi[3]};
#pragma unroll
            for (int j = 0; j < 2; ++j) O[j][d] = MFMA(vf, pf[j][ks], O[j][d]);
          }
      }
    }
    if (more) {
      char* nb = lds + (buf ^ 1) * SB;
#pragma unroll
      for (int it = 0; it < NIT; ++it) if (sval[it]) *(u32x4*)(nb + DOFF_(it)) = rg[it];
    }
    __syncthreads();
  }
}

template <int NS>
DI void load_qf(bf16x8 (&qf)[NS], const u16* __restrict__ qrow) {
#pragma unroll
  for (int s = 0; s < NS; ++s) qf[s] = *(const bf16x8*)(qrow + s * 16);
}

template <int ND>
DI void store_o(const f32x16 (&o)[ND], float scale, u16* __restrict__ dst, int h) {
#pragma unroll
  for (int d = 0; d < ND; ++d)
#pragma unroll
    for (int g = 0; g < 4; ++g) {
      u32x2 w = {cvtpk(o[d][4 * g] * scale, o[d][4 * g + 1] * scale), cvtpk(o[d][4 * g + 2] * scale, o[d][4 * g + 3] * scale)};
      *(u32x2*)(dst + d * 32 + 8 * g + 4 * h) = w;
    }
}

DI void item_map(int idx, int nqb, int& sh, int& qb) {
  int xcd = idx & 7, slot = idx >> 3;
  sh = xcd * (32 / nqb) + slot / nqb;
  qb = slot % nqb;
}

__device__ __forceinline__ void attn_A(const Params& p, int layer, int idx, char* lds) {
  char* const ws = lws(p.ws);
  const int tid = tidx(), lane = tid & 63, wid = wave_id(), r = lane & 31, h = lane >> 5;
  int sh, qb; item_map(idx, 16, sh, qb);
  const int seq = sh >> 2, head = sh & 3;
  const u16* qkv = (const u16*)(ws + OFF_QKV) + (size_t)seq * SEQ * NINP;
  u16* outs = (u16*)(ws + OFF_OUTS) + (size_t)seq * SEQ * OUT_LD;
  const int q0 = qb * 256 + wid * 32;
  bf16x8 qf[2][4];
  __syncthreads();
#pragma unroll
  for (int j = 0; j < 2; ++j) {
    load_qf<4>(qf[j], qkv + (size_t)(q0 + r) * NINP + (head * 2 + j) * 64 + h * 8);
#pragma unroll
    for (int s = 0; s < 4; ++s) *(bf16x8*)(lds + QLDS_OFF + wid * QLDS_WAVE + (j * 32 + r) * 144 + h * 16 + s * 32) = qf[j][s];
  }
  lds_fence();
  const bool fast = ((const float*)(ws + OFF_LAM))[2 + layer] != 0.f;
  const float m0_ = fast ? 0.f : -1e29f;
  f32x16 O[2][4]; float mrun[2] = {m0_, m0_}, lrun[2] = {0.f, 0.f};
#pragma unroll
  for (int j = 0; j < 2; ++j)
#pragma unroll
    for (int d = 0; d < 4; ++d)
#pragma unroll
      for (int e = 0; e < 16; ++e) O[j][d][e] = 0.f;
  if (fast) attn_loop<64, 128, 2, false, true, true>(O, mrun, lrun, qf, qkv + 512 + (head * 2) * 64, qkv + 512 + (head * 2 + 1) * 64, NINP, qkv + 1024 + head * 128, NINP,
                               0, 64, true, 0, 0, lds);
  else attn_loop<64, 128, 2, false, true, false>(O, mrun, lrun, qf, qkv + 512 + (head * 2) * 64, qkv + 512 + (head * 2 + 1) * 64, NINP, qkv + 1024 + head * 128, NINP,
                               0, 64, true, 0, 0, lds);
  const int lane2 = (tidx() & 63), r2 = lane2 & 31, h2 = lane2 >> 5;
  const float lam = ((const float*)(ws + OFF_LAM))[layer];
  const float i0 = 1.f / swapadd(lrun[0]), i1 = lam / swapadd(lrun[1]);
  float ss = 0.f;
#pragma unroll
  for (int d = 0; d < 4; ++d)
#pragma unroll
    for (int e = 0; e < 16; ++e) { float o = O[0][d][e] * i0 - O[1][d][e] * i1; O[0][d][e] = o; ss += o * o; }
  ss = swapadd(ss);
  const float rstd = __builtin_amdgcn_rsqf(ss * (1.f / 128.f) + EPS) * p.oml[layer];
  const float* sg = p.in[8] + layer * 128;
  u16* dst = outs + (size_t)(q0 + r2) * OUT_LD + head * 128;
#pragma unroll
  for (int d = 0; d < 4; ++d)
#pragma unroll
    for (int g = 0; g < 4; ++g) {
      f32x4 g4 = *(const f32x4*)(sg + d * 32 + 8 * g + 4 * h2);
      u32x2 w = {cvtpk(O[0][d][4 * g] * rstd * g4[0], O[0][d][4 * g + 1] * rstd * g4[1]), cvtpk(O[0][d][4 * g + 2] * rstd * g4[2], O[0][d][4 * g + 3] * rstd * g4[3])};
      *(u32x2*)(dst + d * 32 + 8 * g + 4 * h2) = w;
    }
}

__device__ __forceinline__ void attn_C(const Params& p, int layer, int idx, char* lds) {
  char* const ws = lws(p.ws);
  const int tid = tidx(), lane = tid & 63, wid = wave_id(), r = lane & 31, h = lane >> 5;
  int sh, qb; item_map(idx, 8, sh, qb);
  const int seq = sh >> 3, head = sh & 7;
  const u16* qc = (const u16*)(ws + OFF_QKVC) + (size_t)seq * SEQ * QKVC_LD;
  u16* outs = (u16*)(ws + OFF_OUTS) + (size_t)seq * SEQ * OUT_LD;
  const int q0 = qb * 512 + wid * 64;
  bf16x8 qf[2][6];
  load_qf<6>(qf[0], qc + (size_t)(q0 + r) * QKVC_LD + head * 96 + h * 8);
  load_qf<6>(qf[1], qc + (size_t)(q0 + 32 + r) * QKVC_LD + head * 96 + h * 8);
  const bool fast = ((const float*)(ws + OFF_LAM))[10 + layer] != 0.f;
  const float m0_ = fast ? 0.f : -1e29f;
  f32x16 O[2][2]; float mrun[2] = {m0_, m0_}, lrun[2] = {0.f, 0.f};
#pragma unroll
  for (int j = 0; j < 2; ++j)
#pragma unroll
    for (int d = 0; d < 2; ++d)
#pragma unroll
      for (int e = 0; e < 16; ++e) O[j][d][e] = 0.f;
  if (fast) attn_loop<96, 64, 1, false, false, true>(O, mrun, lrun, qf, qc + 768 + head * 96, nullptr, QKVC_LD, qc + 1536 + head * 64, QKVC_LD, 0, 64, true, 0, 0, lds);
  else attn_loop<96, 64, 1, false, false, false>(O, mrun, lrun, qf, qc + 768 + head * 96, nullptr, QKVC_LD, qc + 1536 + head * 64, QKVC_LD, 0, 64, true, 0, 0, lds);
  const int lane2 = (tidx() & 63), r2 = lane2 & 31, h2 = lane2 >> 5;
#pragma unroll
  for (int j = 0; j < 2; ++j) {
    const float inv = 1.f / swapadd(lrun[j]);
    store_o<2>(O[j], inv, outs + (size_t)(q0 + j * 32 + r2) * OUT_LD + 768 + head * 64, h2);
  }
}

__device__ __forceinline__ void attn_D(const Params& p, int layer, int idx, char* lds) {
  char* const ws = lws(p.ws);
  const int tid = tidx(), lane = tid & 63, wid = wave_id(), r = lane & 31, h = lane >> 5;
  const int xcd = idx & 7, qb = idx >> 3;
  const int seq = xcd >> 1, kvh = xcd & 1;
  const u16* qkv = (const u16*)(ws + OFF_QKV) + (size_t)seq * SEQ * NINP;
  u16* outs = (u16*)(ws + OFF_OUTS) + (size_t)seq * SEQ * OUT_LD;
  const int qhead = kvh * 4 + (wid >> 1);
  const int q0 = qb * 128 + (wid & 1) * 64;
  bf16x8 qf[2][4];
  load_qf<4>(qf[0], qkv + (size_t)(q0 + r) * NINP + 3840 + qhead * 64 + h * 8);
  load_qf<4>(qf[1], qkv + (size_t)(q0 + 32 + r) * NINP + 3840 + qhead * 64 + h * 8);
  const bool fast = ((const float*)(ws + OFF_LAM))[12 + layer] != 0.f;
  const float m0_ = fast ? 0.f : -1e29f;
  f32x16 O[2][2]; float mrun[2] = {m0_, m0_}, lrun[2] = {0.f, 0.f};
#pragma unroll
  for (int j = 0; j < 2; ++j)
#pragma unroll
    for (int d = 0; d < 2; ++d)
#pragma unroll
      for (int e = 0; e < 16; ++e) O[j][d][e] = 0.f;
  int t0 = qb * 2 - 2; if (t0 < 0) t0 = 0;
  int t1 = qb * 2 + 4; if (t1 > 64) t1 = 64;
  if (fast) attn_loop<64, 64, 1, true, false, true>(O, mrun, lrun, qf, qkv + 4352 + kvh * 64, nullptr, NINP, qkv + 4480 + kvh * 64, NINP, t0, t1, true, q0, 128, lds);
  else attn_loop<64, 64, 1, true, false, false>(O, mrun, lrun, qf, qkv + 4352 + kvh * 64, nullptr, NINP, qkv + 4480 + kvh * 64, NINP, t0, t1, true, q0, 128, lds);
  const float sink2 = p.in[19][layer * 8 + qhead] * LOG2E;
  const int lane2 = (tidx() & 63), r2 = lane2 & 31, h2 = lane2 >> 5;
#pragma unroll
  for (int j = 0; j < 2; ++j) {
    const float l = swapadd(lrun[j]);
    const float mf = fmaxf(mrun[j], sink2);
    const float a = __builtin_amdgcn_exp2f(mrun[j] - mf);
    const float lf = l * a + __builtin_amdgcn_exp2f(sink2 - mf);
    store_o<2>(O[j], a / lf, outs + (size_t)(q0 + j * 32 + r2) * OUT_LD + 1280 + qhead * 64, h2);
  }
}

__device__ __forceinline__ void attn_B(const Params& p, int layer, int idx, char* lds) {
  char* const ws = lws(p.ws);
  const int tid = tidx(), lane = tid & 63, wid = wave_id(), r = lane & 31, h = lane >> 5;
  const int sub = idx & 31, sh = idx >> 5, seq = sh >> 2, head = sh & 3;
  int g, res, m0;
  if (sub < 8) { g = 0; res = 0; m0 = sub * 512; }
  else if (sub < 16) { g = 1; res = (sub - 8) >> 1; m0 = ((sub - 8) & 1) * 512; }
  else { g = 2; res = sub - 16; m0 = 0; }
  const int dil = g == 0 ? 1 : (g == 1 ? 4 : 16);
  const int Lg = SEQ / dil;
  int nact = (Lg - m0) / 64; if (nact > 8) nact = 8;
  const bool wact = wid < nact;
  const size_t ld = (size_t)dil * NINP;
  const u16* base = (const u16*)(ws + OFF_QKV) + ((size_t)seq * SEQ + res) * NINP + 1536 + g * 768 + head * 64;
  int q0 = m0 + wid * 64; if (!wact) q0 = m0;
  bf16x8 qf[2][4];
  load_qf<4>(qf[0], base + (size_t)(q0 + r) * ld + h * 8);
  load_qf<4>(qf[1], base + (size_t)(q0 + 32 + r) * ld + h * 8);
  const bool fast = ((const float*)(ws + OFF_LAM))[4 + layer * 3 + g] != 0.f;
  const float m0_ = fast ? 0.f : -1e29f;
  f32x16 O[2][2]; float mrun[2] = {m0_, m0_}, lrun[2] = {0.f, 0.f};
#pragma unroll
  for (int j = 0; j < 2; ++j)
#pragma unroll
    for (int d = 0; d < 2; ++d)
#pragma unroll
      for (int e = 0; e < 16; ++e) O[j][d][e] = 0.f;
  int t0 = m0 / 64 - 1; if (t0 < 0) t0 = 0;
  int t1 = m0 / 64 + 9; if (t1 > Lg / 64) t1 = Lg / 64;
  if (fast) attn_loop<64, 64, 1, true, false, true>(O, mrun, lrun, qf, base + 256, nullptr, ld, base + 512, ld, t0, t1, wact, q0, 64, lds);
  else attn_loop<64, 64, 1, true, false, false>(O, mrun, lrun, qf, base + 256, nullptr, ld, base + 512, ld, t0, t1, wact, q0, 64, lds);
  if (wact) {
    const int lane2 = (tidx() & 63), r2 = lane2 & 31, h2 = lane2 >> 5;
    u16* bo = (u16*)(ws + OFF_BO) + (size_t)g * CT * 256;
    float* blse = (float*)(ws + OFF_BLSE) + (size_t)g * CT * 4;
#pragma unroll
    for (int j = 0; j < 2; ++j) {
      const float l = swapadd(lrun[j]);
      const size_t tok = (size_t)seq * SEQ + (size_t)(q0 + j * 32 + r2) * dil + res;
      store_o<2>(O[j], 1.f / l, bo + tok * 256 + head * 64, h2);
      if (h2 == 0) blse[tok * 4 + head] = mrun[j] + __builtin_amdgcn_logf(l);
    }
  }
}

DI void combine_rows(char* ws, int m0) {
  const u16* bo = (const u16*)(ws + OFF_BO);
  const float* blse = (const float*)(ws + OFF_BLSE);
  u16* outs = (u16*)(ws + OFF_OUTS);
  for (int i = tidx(); i < 128 * 32; i += 512) {
    const int tok = m0 + (i >> 5), ch = i & 31, head = ch >> 3;
    float l0 = blse[(size_t)tok * 4 + head], l1 = blse[((size_t)CT + tok) * 4 + head], l2 = blse[((size_t)2 * CT + tok) * 4 + head];
    float mx = fmaxf(l0, fmaxf(l1, l2));
    float w0 = __builtin_amdgcn_exp2f(l0 - mx), w1 = __builtin_amdgcn_exp2f(l1 - mx), w2 = __builtin_amdgcn_exp2f(l2 - mx);
    float inv = 1.f / (w0 + w1 + w2); w0 *= inv; w1 *= inv; w2 *= inv;
    u32x4 a = *(const u32x4*)(bo + (size_t)tok * 256 + ch * 8);
    u32x4 b = *(const u32x4*)(bo + ((size_t)CT + tok) * 256 + ch * 8);
    u32x4 c = *(const u32x4*)(bo + ((size_t)2 * CT + tok) * 256 + ch * 8);
    u32x4 o;
#pragma unroll
    for (int e = 0; e < 4; ++e) {
      float lo = w0 * bflo(a[e]) + w1 * bflo(b[e]) + w2 * bflo(c[e]);
      float hi = w0 * bfhi(a[e]) + w1 * bfhi(b[e]) + w2 * bfhi(c[e]);
      o[e] = cvtpk(lo, hi);
    }
    *(u32x4*)(outs + (size_t)tok * OUT_LD + 512 + ch * 8) = o;
  }
  asm volatile("s_waitcnt vmcnt(0)" ::: "memory");
}

__device__ __forceinline__ void phase_merge(const Params& p, int layer, char* lds) {
  constexpr int AR = 256, STAGE = (AR + 128) * PITCH;
  char* const ws = lws(p.ws);
  const u16* Wbr = (const u16*)(ws + OFF_WBR) + (size_t)layer * 1024 * 1792;
  const u16* outs = (const u16*)(ws + OFF_OUTS);
  u16* merged = (u16*)(ws + OFF_MERGED);
  const int wid = wave_id(), wn = wid & 3, wm = wid >> 2;
  const __amdgpu_buffer_rsrc_t arsrc = __builtin_amdgcn_make_buffer_rsrc((void*)Wbr, 0, 0x7fffffff, 0x00020000);
  for (int t = blockIdx.x; t < 4 * 128; t += gridDim.x) {
    int nt, mt; tile_map(t, nt, mt);
    const int n0 = nt * 256, m0 = mt * 128;
    combine_rows(ws, m0);
    const int tid = tidx(), lane = tid & 63, r = lane & 31, h = lane >> 5;
    const int crow0 = tid >> 3, ccol = tid & 7;
    const __amdgpu_buffer_rsrc_t brsrc = __builtin_amdgcn_make_buffer_rsrc((void*)(outs + (size_t)m0 * OUT_LD), 0, 0x7fffffff, 0x00020000);
    const int bvo = (crow0 * OUT_LD + ccol * 8) * 2, bstep = 64 * OUT_LD * 2;
    const int wofs = crow0 * PITCH + ccol * 16;
    const int aoff = (wn * 64 + r) * PITCH + h * 16;
    const int boff = AR * PITCH + (wm * 64 + r) * PITCH + h * 16;
    f32x16 mg[2][2], acc[2][2];
#pragma unroll
    for (int i = 0; i < 2; ++i)
#pragma unroll
      for (int j = 0; j < 2; ++j)
#pragma unroll
        for (int e = 0; e < 16; ++e) { mg[i][j][e] = 0.f; acc[i][j][e] = 0.f; }
    u32x4 ra[4], rb[2];
    unsigned gw[2][2][4];
#define MG_BR(q) ((q) < 8 ? 0 : ((q) < 12 ? 1 : ((q) < 20 ? 2 : 3)))
#define MG_Q0(br) ((br) == 0 ? 0 : ((br) == 1 ? 8 : ((br) == 2 ? 12 : 20)))
#define MG_COFS(br) ((br) == 0 ? 0 : ((br) == 1 ? 512 : ((br) == 2 ? 768 : 1280)))
#define MG_LOAD(q) do { const int br_ = MG_BR(q), kt_ = (q) - MG_Q0(br_), Kb_ = br_ == 1 ? 256 : 512, cf_ = MG_COFS(br_); \
      const int avo_ = (1024 * cf_ + (n0 + crow0) * Kb_ + ccol * 8) * 2, ast_ = 64 * Kb_ * 2; \
      _Pragma("unroll") for (int i = 0; i < 4; ++i) ra[i] = __builtin_amdgcn_raw_buffer_load_b128(arsrc, avo_ + i * ast_, kt_ * 128, 0); \
      _Pragma("unroll") for (int i = 0; i < 2; ++i) rb[i] = __builtin_amdgcn_raw_buffer_load_b128(brsrc, bvo + i * bstep, cf_ * 2 + kt_ * 128, 0); } while (0)
#define MG_STORE(buf) do { char* nb_ = lds + (buf) * STAGE; \
      _Pragma("unroll") for (int i = 0; i < 4; ++i) *(u32x4*)(nb_ + wofs + i * 64 * PITCH) = ra[i]; \
      _Pragma("unroll") for (int i = 0; i < 2; ++i) *(u32x4*)(nb_ + AR * PITCH + wofs + i * 64 * PITCH) = rb[i]; } while (0)
#define MG_GATES(br) do { const unsigned char* gb_ = (const unsigned char*)(ws + OFF_GATE) + (br) * 1024 + n0 + wn * 64 + 4 * h; \
      _Pragma("unroll") for (int j = 0; j < 2; ++j) { const unsigned char* gr_ = gb_ + (size_t)(m0 + wm * 64 + j * 32 + r) * 4096; \
        _Pragma("unroll") for (int i = 0; i < 2; ++i) _Pragma("unroll") for (int g = 0; g < 4; ++g) gw[i][j][g] = *(const unsigned*)(gr_ + i * 32 + 8 * g); } } while (0)
    __syncthreads();
    MG_LOAD(0); MG_STORE(0); MG_GATES(0);
    __syncthreads();
#pragma nounroll
    for (int q = 0; q < 28; ++q) {
      const bool more = q + 1 < 28;
      if (more) MG_LOAD(q + 1);
      const char* base = lds + (q & 1) * STAGE;
      bf16x8 afA[2], bfA[2], afB[2], bfB[2];
#pragma unroll
      for (int i = 0; i < 2; ++i) afA[i] = *(const bf16x8*)(base + aoff + i * 32 * PITCH);
#pragma unroll
      for (int j = 0; j < 2; ++j) bfA[j] = *(const bf16x8*)(base + boff + j * 32 * PITCH);
      __builtin_amdgcn_sched_barrier(0);
#pragma unroll
      for (int s2 = 0; s2 < 4; s2 += 2) {
#pragma unroll
        for (int i = 0; i < 2; ++i) afB[i] = *(const bf16x8*)(base + aoff + i * 32 * PITCH + (s2 + 1) * 32);
#pragma unroll
        for (int j = 0; j < 2; ++j) bfB[j] = *(const bf16x8*)(base + boff + j * 32 * PITCH + (s2 + 1) * 32);
        __builtin_amdgcn_sched_barrier(0);
#pragma unroll
        for (int i = 0; i < 2; ++i)
#pragma unroll
          for (int j = 0; j < 2; ++j) acc[i][j] = MFMA(afA[i], bfA[j], acc[i][j]);
        __builtin_amdgcn_sched_barrier(0);
        if (s2 + 2 < 4) {
#pragma unroll
          for (int i = 0; i < 2; ++i) afA[i] = *(const bf16x8*)(base + aoff + i * 32 * PITCH + (s2 + 2) * 32);
#pragma unroll
          for (int j = 0; j < 2; ++j) bfA[j] = *(const bf16x8*)(base + boff + j * 32 * PITCH + (s2 + 2) * 32);
        }
        __builtin_amdgcn_sched_barrier(0);
#pragma unroll
        for (int i = 0; i < 2; ++i)
#pragma unroll
          for (int j = 0; j < 2; ++j) acc[i][j] = MFMA(afB[i], bfB[j], acc[i][j]);
        __builtin_amdgcn_sched_barrier(0);
      }
      if (q == 7 || q == 11 || q == 19 || q == 27) {
#pragma unroll
        for (int j = 0; j < 2; ++j)
#pragma unroll
          for (int i = 0; i < 2; ++i)
#pragma unroll
            for (int g = 0; g < 4; ++g)
#pragma unroll
              for (int e = 0; e < 4; ++e) {
                mg[i][j][4 * g + e] += (float)((gw[i][j][g] >> (8 * e)) & 255u) * (1.f / 255.f) * acc[i][j][4 * g + e];
                acc[i][j][4 * g + e] = 0.f;
              }
        if (more) { const int nbr = MG_BR(q + 1); MG_GATES(nbr); }
      }
      if (more) MG_STORE((q + 1) & 1);
      __syncthreads();
    }
#undef MG_BR
#undef MG_Q0
#undef MG_COFS
#undef MG_LOAD
#undef MG_STORE
#undef MG_GATES
    store_wave_bf16<2>(mg, merged + (size_t)(m0 + wm * 64) * 1024 + n0 + wn * 64, 1024, lds + wid * WAVE_LDS);
  }
}

__device__ __forceinline__ void phase_proj_res(const u16* Wt, const u16* act, int K, const float* resid, float* xout, char* lds) {
  pg8::Gemm g{act, Wt, CT, DM, K};
  pg8::StaticOrder S; S.init(CT, DM, gridDim.x, blockIdx.x);
  EpiRes E{resid, xout};
  __syncthreads();
  pg8::gemm_phase<EpiRes, pg8::StaticOrder, false>((PG8_LAS unsigned char*)lds, g, S, E, nullptr);
}

__device__ __forceinline__ void phase_ffn_up(const Params& p, int layer, char* lds) {
  char* const ws = lws(p.ws);
  pg8::Gemm g{(const u16*)(ws + OFF_XN), (const u16*)(ws + OFF_WGU) + (size_t)layer * NGU * 1024, CT, NGU, 1024};
  pg8::StaticOrder S; S.init(CT, NGU, gridDim.x, blockIdx.x);
  EpiSwiglu E{(u16*)(ws + OFF_ACT)};
  __syncthreads();
  pg8::gemm_phase<EpiSwiglu, pg8::StaticOrder, false>((PG8_LAS unsigned char*)lds, g, S, E, nullptr);
}

#define XB_TMO      128
#define XB_XCNT(j)  (256  + 64 * (j))
#define XB_XSUB(j)  (1280 + 64 * (j))
#define XB_XGEN(j)  (2304 + 64 * (j))
#define XB_TOP      3328
#define XB_TOPGEN   3392
#define XCD_BAR_WORDS 3456
#define XB_SPIN_CAP (1u << 20)
#define XB_LAS __attribute__((address_space(3)))
DI unsigned xb_ld(unsigned* p) { return __hip_atomic_load(p, __ATOMIC_RELAXED, __HIP_MEMORY_SCOPE_AGENT); }
DI unsigned xb_add(unsigned* p, unsigned v) { return __hip_atomic_fetch_add(p, v, __ATOMIC_RELAXED, __HIP_MEMORY_SCOPE_AGENT); }
DI unsigned xb_xcc_id() { return (unsigned)__builtin_amdgcn_s_getreg((3 << 11) | 20) & 0xFu; }
#define XB_SPIN(cond, bar) do { unsigned _sp = 0; while (cond) { __builtin_amdgcn_s_sleep(1); \
    if ((++_sp & 255u) == 0u) { if (xb_ld(&(bar)[XB_TMO])) break; if (_sp > XB_SPIN_CAP) { atomicAdd(&(bar)[XB_TMO], 1u); break; } } } } while (0)
struct XcdBarrier { unsigned* bar; unsigned x; volatile XB_LAS unsigned* st; };
DI XcdBarrier xcd_barrier_post(unsigned* bar, volatile XB_LAS unsigned* st) {
  XcdBarrier b; b.bar = bar; b.x = xb_xcc_id(); b.st = st;
  if (tidx() == 0) (void)xb_add(&bar[XB_XCNT(b.x)], 1u);
  return b;
}
DI void xcd_barrier_complete(unsigned* bar, unsigned x, unsigned& nloc, unsigned& nx) {
  const unsigned G = gridDim.x;
  unsigned sum, cnt, mine, sp = 0u;
  for (;;) {
    sum = 0u; cnt = 0u; mine = 0u;
#pragma unroll
    for (unsigned j = 0; j < 16; ++j) { const unsigned c = xb_ld(&bar[XB_XCNT(j)]); sum += c; cnt += (c > 0u) ? 1u : 0u; mine = (j == x) ? c : mine; }
    if (sum == G) break;
    __builtin_amdgcn_s_sleep(1);
    if ((++sp & 255u) == 0u) { if (xb_ld(&bar[XB_TMO])) break; if (sp > XB_SPIN_CAP) { atomicAdd(&bar[XB_TMO], 1u); break; } }
  }
  nloc = mine > 0u ? mine : 1u; nx = cnt > 0u ? cnt : 1u;
}
DI void xcd_barrier(const XcdBarrier& b) {
  asm volatile("s_waitcnt vmcnt(0)" ::: "memory");
  __syncthreads();
  if (tidx() == 0) {
    unsigned* bar = b.bar;
    __builtin_amdgcn_s_waitcnt(0);
    unsigned nloc = b.st[0], nx = b.st[1];
    if (nloc == 0u) { xcd_barrier_complete(bar, b.x, nloc, nx); b.st[0] = nloc; b.st[1] = nx; }
    const unsigned old = xb_add(&bar[XB_XSUB(b.x)], 1u);
    const unsigned gen = old / nloc;
    if (old + 1u == (gen + 1u) * nloc) {
      __builtin_amdgcn_fence(__ATOMIC_RELEASE, "agent");
      asm volatile("s_waitcnt vmcnt(0)" ::: "memory");
      const unsigned og = xb_add(&bar[XB_TOP], 1u);
      const unsigned tg = og / nx;
      if (og + 1u == (tg + 1u) * nx) xb_add(&bar[XB_TOPGEN], 1u);
      else XB_SPIN(xb_ld(&bar[XB_TOPGEN]) == tg, bar);
      __builtin_amdgcn_fence(__ATOMIC_ACQUIRE, "agent");
      xb_add(&bar[XB_XGEN(b.x)], 1u);
      asm volatile("s_waitcnt vmcnt(0)" ::: "memory");
    } else {
      XB_SPIN(xb_ld(&bar[XB_XGEN(b.x)]) == gen, bar);
      __builtin_amdgcn_fence(__ATOMIC_ACQUIRE, "agent");
      asm volatile("s_waitcnt vmcnt(0)" ::: "memory");
    }
  }
  __syncthreads();
}

DI void grid_barrier(unsigned* ctr, unsigned target) {
  asm volatile("s_waitcnt vmcnt(0)" ::: "memory");
  __syncthreads();
  if (threadIdx.x == 0) {
    __builtin_amdgcn_fence(__ATOMIC_RELEASE, "agent");
    asm volatile("s_waitcnt vmcnt(0)" ::: "memory");
    __hip_atomic_fetch_add(ctr, 1u, __ATOMIC_RELAXED, __HIP_MEMORY_SCOPE_AGENT);
    unsigned spins = 0;
    while (__hip_atomic_load(ctr, __ATOMIC_RELAXED, __HIP_MEMORY_SCOPE_AGENT) < target && ++spins < (1u << 26)) __builtin_amdgcn_s_sleep(2);
    __builtin_amdgcn_fence(__ATOMIC_ACQUIRE, "agent");
    asm volatile("s_waitcnt vmcnt(0)" ::: "memory");
  }
  __syncthreads();
}

extern "C" __global__ void __launch_bounds__(512, 2) mega(Params p) {
  extern __shared__ __attribute__((aligned(16))) char lds[];
  cg::grid_group grid = cg::this_grid();
  unsigned* const barp = (unsigned*)(p.ws + OFF_BAR);
  unsigned nbar = 0;
#define PWS lws(p.ws)
#define POUT ((float*)lws((char*)p.out))
  volatile XB_LAS unsigned* xst = (volatile XB_LAS unsigned*)(lds + (LDS_BYTES - 16));
  if (tidx() == 0) { xst[0] = 0u; xst[1] = 0u; }
  phase_w(p, lds);
  phase_norm(p.in[0], p.in[2], (u16*)(PWS + OFF_XN));
  grid.sync();
  const XcdBarrier xb = xcd_barrier_post(barp, xst);
#pragma nounroll
  for (int ch = 0; ch < NCH; ++ch) {
#pragma nounroll
    for (int layer = 0; layer < DEPTH; ++layer) {
      {
        int l1 = layer; asm volatile("" : "+s"(l1));
        if (l1 > 0) {
          phase_norm(POUT + (size_t)ch * CT * DM, p.in[2] + layer * DM, (u16*)(PWS + OFF_XN));
          xcd_barrier(xb);
        }
      }
      phase_p1(p, layer, lds);
      xcd_barrier(xb);
      phase_p1c(p, layer, lds);
      xcd_barrier(xb);
#pragma nounroll
      for (int it = blockIdx.x; it < 1280; it += gridDim.x) {
        if (wave_id() >= 4) __builtin_amdgcn_s_setprio(1);
        if (it < 256) attn_A(p, layer, it, lds);
        else if (it < 512) attn_C(p, layer, it - 256, lds);
        else if (it < 768) attn_D(p, layer, it - 512, lds);
        else attn_B(p, layer, it - 768, lds);
        __builtin_amdgcn_s_setprio(0);
      }
      xcd_barrier(xb);
      phase_merge(p, layer, lds);
      xcd_barrier(xb);
      {
        const float* xin = ch == 0 ? p.in[0] : p.in[1] + (size_t)(ch - 1) * CT * DM;
        float* xo = POUT + (size_t)ch * CT * DM;
        const float* xcur = layer == 0 ? xin : xo;
        phase_proj_res((const u16*)(PWS + OFF_WO) + (size_t)layer * 1024 * 1024, (const u16*)(PWS + OFF_MERGED), 1024, xcur, xo, lds);
      }
      xcd_barrier(xb);
      {
        phase_norm(POUT + (size_t)ch * CT * DM, p.in[25] + layer * DM, (u16*)(PWS + OFF_XN));
      }
      xcd_barrier(xb);
      phase_ffn_up(p, layer, lds);
      xcd_barrier(xb);
      {
        float* xo = POUT + (size_t)ch * CT * DM;
        phase_proj_res((const u16*)(PWS + OFF_WDN) + (size_t)layer * 1024 * DFF, (const u16*)(PWS + OFF_ACT), DFF, xo, xo, lds);
      }
      {
        int l3 = layer, c3 = ch; asm volatile("" : "+s"(l3)); asm volatile("" : "+s"(c3));
        if (l3 == DEPTH - 1 && c3 + 1 < NCH) phase_norm(p.in[1] + (size_t)c3 * CT * DM, p.in[2], (u16*)(PWS + OFF_XN));
      }
      xcd_barrier(xb);
    }
  }
}

extern "C" void kernel_launch(void* const* d_in, const int* in_sizes, int n_in, void* d_out, int out_size, void* d_ws, size_t ws_size, hipStream_t stream) {
  static int grid_blocks = 0;
  if (!grid_blocks) {
    int dev = 0, cus = 0, per_cu = 0;
    (void)hipGetDevice(&dev);
    (void)hipDeviceGetAttribute(&cus, hipDeviceAttributeMultiprocessorCount, dev);
    (void)hipFuncSetAttribute((const void*)mega, hipFuncAttributeMaxDynamicSharedMemorySize, (int)LDS_BYTES);
    (void)hipOccupancyMaxActiveBlocksPerMultiprocessor(&per_cu, mega, 512, LDS_BYTES);
    if (per_cu < 1) fprintf(stderr, "kernel_launch: occupancy query returned %d\n", per_cu);
    grid_blocks = cus > 0 ? cus : 256;
    if (ws_size < WS_END) fprintf(stderr, "kernel_launch: workspace too small: %zu < %zu\n", ws_size, (size_t)WS_END);
  }
  Params p{};
  for (int i = 0; i < 29; ++i) p.in[i] = (const float*)d_in[i];
  p.out = (float*)d_out;
  p.ws = (char*)d_ws;
  for (int i = 0; i < 32; ++i) p.inv64[i] = (float)pow(10000.0, -(double)i / 32.0);
  for (int i = 0; i < 16; ++i) p.inv32[i] = (float)pow(10000.0, -(double)i / 16.0);
  for (int l = 0; l < 2; ++l) {
    double li = 0.8 - 0.6 * exp(-0.3 * (double)l);
    p.lam_init[l] = (float)li;
    p.oml[l] = (float)(1.0 - li);
  }
  void* args[] = {&p};
  hipError_t e = hipLaunchCooperativeKernel((void*)mega, dim3(grid_blocks), dim3(512), args, LDS_BYTES, stream);
  if (e != hipSuccess) fprintf(stderr, "cooperative launch failed: %s (grid %d)\n", hipGetErrorString(e), grid_blocks);
}
```
